# Optimizing an MI355X kernel written in HIP

```python
import jax, jax.numpy as jnp
from jax import lax
import numpy as np

D_MODEL = 2048
BATCH = 8
SEQ = 2048
DEPTH = 2

CHUNK = 64
Q_BLOCK = 2 * CHUNK
N_META = 16
N_HEADS = D_MODEL // 128
HEAD_DIM = 64
ATT_W = N_HEADS * HEAD_DIM
CONV_C = D_MODEL // 2
CONV_K = 31
N_GROUPS = 4
EXPERTS_PER_GROUP = 8
N_EXPERTS = N_GROUPS * EXPERTS_PER_GROUP
TOP_K = 2
D_EXPERT = (3 * D_MODEL) // 8
IN_COLS = 3 * ATT_W + N_HEADS + 2 * CONV_C + 2 * D_MODEL
RMS_EPS = 1e-6
LN_EPS = 1e-5

kernel_name = 'fox_conformer_hmoe_hybrid_block'


def rmsnorm(x, g):
    x32 = x.astype(jnp.float32)
    y = x32 * lax.rsqrt(jnp.mean(x32 * x32, axis=-1, keepdims=True) + RMS_EPS)
    return (y * g.astype(jnp.float32)).astype(x.dtype)


def forgetting_attention(q, k, v, log_f):
    B, L, H, Dh = q.shape
    Lp = -(-L // Q_BLOCK) * Q_BLOCK
    pad = Lp - L
    pad4 = ((0, 0), (0, pad), (0, 0), (0, 0))
    q = jnp.pad(q, pad4)
    k = jnp.pad(k, pad4)
    v = jnp.pad(v, pad4)
    cum = jnp.cumsum(jnp.pad(log_f, ((0, 0), (0, pad), (0, 0))), axis=1)
    cum = cum.transpose(0, 2, 1)
    scale = HEAD_DIM ** -0.5
    outs = []
    for i in range(Lp // Q_BLOCK):
        q0, q1 = i * Q_BLOCK, (i + 1) * Q_BLOCK
        s = jnp.einsum('bqhd,bkhd->bhqk', q[:, q0:q1], k[:, :q1]).astype(jnp.float32) * scale
        bias = cum[:, :, q0:q1, None] - cum[:, :, None, :q1]
        causal = (q0 + jnp.arange(Q_BLOCK))[:, None] >= jnp.arange(q1)[None, :]
        s = jnp.where(causal, s + bias, -jnp.inf)
        p = jax.nn.softmax(s, axis=-1)
        outs.append(jnp.einsum('bhqk,bkhd->bqhd', p.astype(v.dtype), v[:, :q1]))
    return jnp.concatenate(outs, axis=1)[:, :L]


def conformer_conv(u, conv_w, conv_b, ln_g, ln_b):
    a, b = jnp.split(u, 2, axis=-1)
    z = a * jax.nn.sigmoid(b)
    z = lax.conv_general_dilated(
        z, conv_w.astype(z.dtype)[:, None, :], window_strides=(1,),
        padding=[(CONV_K - 1, 0)], dimension_numbers=('NWC', 'WIO', 'NWC'),
        feature_group_count=CONV_C) + conv_b.astype(z.dtype)
    z32 = z.astype(jnp.float32)
    mu = jnp.mean(z32, axis=-1, keepdims=True)
    var = jnp.mean(jnp.square(z32 - mu), axis=-1, keepdims=True)
    zn = (z32 - mu) * lax.rsqrt(var + LN_EPS) * ln_g.astype(jnp.float32) + ln_b.astype(jnp.float32)
    return jax.nn.silu(zn).astype(u.dtype)


def hierarchical_moe(h, w_rg, b_rg, w_re, b_re, w_gu, w_dn):
    B, L, D = h.shape
    t = h.reshape(-1, D)
    g_logits = (t @ w_rg).astype(jnp.float32) + b_rg.astype(jnp.float32)
    g_prob = jax.nn.softmax(g_logits, axis=-1)
    g_idx = jnp.argmax(g_logits, axis=-1)
    g_w = jnp.take_along_axis(g_prob, g_idx[:, None], axis=-1)[:, 0]
    e_logits = ((t @ w_re).astype(jnp.float32) + b_re.astype(jnp.float32)).reshape(-1, N_GROUPS, EXPERTS_PER_GROUP)
    e_in_group = jnp.take_along_axis(e_logits, g_idx[:, None, None], axis=1)[:, 0]
    top_v, top_i = lax.top_k(e_in_group, TOP_K)
    w = g_w[:, None] * jax.nn.softmax(top_v, axis=-1)
    e_idx = g_idx[:, None] * EXPERTS_PER_GROUP + top_i
    combine = jnp.sum(jax.nn.one_hot(e_idx, N_EXPERTS, dtype=jnp.float32) * w[..., None], axis=1)
    combine = combine.astype(t.dtype)
    out = jnp.zeros_like(t)
    for e in range(N_EXPERTS):
        a, b = jnp.split(t @ w_gu[e], 2, axis=-1)
        out = out + combine[:, e:e + 1] * ((jax.nn.silu(a) * b) @ w_dn[e])
    return out.reshape(B, L, D)


def setup_inputs(seed: int = 0) -> dict:
    key = jax.random.key(seed)
    ks = jax.random.split(key, 20)
    f32 = jnp.float32
    nrm = lambda k, shape, fan_in: jax.random.normal(k, shape, f32) * (fan_in ** -0.5)
    gain = lambda k, shape: 1.0 + 0.02 * jax.random.normal(k, shape, f32)
    return {
        'x': jax.random.normal(ks[0], (BATCH, SEQ, D_MODEL), f32),
        'meta': jax.random.normal(ks[1], (N_META, D_MODEL), f32),
        'norm_mix': gain(ks[2], (DEPTH, D_MODEL)),
        'w_in': nrm(ks[3], (DEPTH, D_MODEL, IN_COLS), D_MODEL),
        'b_forget': jax.random.uniform(ks[4], (DEPTH, N_HEADS), f32, 1.0, 6.0),
        'w_attn_out': nrm(ks[5], (DEPTH, ATT_W, D_MODEL), ATT_W),
        'conv_w': nrm(ks[6], (DEPTH, CONV_K, CONV_C), CONV_K),
        'conv_b': 0.02 * jax.random.normal(ks[7], (DEPTH, CONV_C), f32),
        'conv_ln_g': gain(ks[8], (DEPTH, CONV_C)),
        'conv_ln_b': 0.02 * jax.random.normal(ks[9], (DEPTH, CONV_C), f32),
        'w_conv_out': nrm(ks[10], (DEPTH, CONV_C, D_MODEL), CONV_C),
        'w_out': nrm(ks[11], (DEPTH, D_MODEL, D_MODEL), D_MODEL),
        'norm_ffn': gain(ks[12], (DEPTH, D_MODEL)),
        'w_router_group': nrm(ks[13], (DEPTH, D_MODEL, N_GROUPS), D_MODEL),
        'b_router_group': 0.01 * jax.random.normal(ks[14], (DEPTH, N_GROUPS), f32),
        'w_router_expert': nrm(ks[15], (DEPTH, D_MODEL, N_EXPERTS), D_MODEL),
        'b_router_expert': 0.01 * jax.random.normal(ks[16], (DEPTH, N_EXPERTS), f32),
        'w_gate_up': nrm(ks[17], (DEPTH, N_EXPERTS, D_MODEL, 2 * D_EXPERT), D_MODEL),
        'w_down': nrm(ks[18], (DEPTH, N_EXPERTS, D_EXPERT, D_MODEL), D_EXPERT),
        'norm_final': gain(ks[19], (D_MODEL,)),
    }


def reference(x, meta, norm_mix, w_in, b_forget, w_attn_out, conv_w, conv_b, conv_ln_g, conv_ln_b,
              w_conv_out, w_out, norm_ffn, w_router_group, b_router_group, w_router_expert,
              b_router_expert, w_gate_up, w_down, norm_final):
    B, S, D = x.shape
    r = jnp.concatenate([jnp.broadcast_to(meta.astype(x.dtype)[None], (B, N_META, D)), x], axis=1)
    L = S + N_META
    cuts = [ATT_W, 2 * ATT_W, 3 * ATT_W, 3 * ATT_W + N_HEADS,
            3 * ATT_W + N_HEADS + 2 * CONV_C, 3 * ATT_W + N_HEADS + 2 * CONV_C + D_MODEL]
    for l in range(DEPTH):
        n = rmsnorm(r, norm_mix[l])
        z = n @ w_in[l]
        q, k, v, f_logit, u, g_att, g_conv = jnp.split(z, cuts, axis=-1)
        log_f = jax.nn.log_sigmoid(f_logit.astype(jnp.float32) + b_forget[l].astype(jnp.float32))
        att = forgetting_attention(q.reshape(B, L, N_HEADS, HEAD_DIM),
                                   k.reshape(B, L, N_HEADS, HEAD_DIM),
                                   v.reshape(B, L, N_HEADS, HEAD_DIM), log_f)
        br_att = att.reshape(B, L, ATT_W) @ w_attn_out[l]
        br_conv = conformer_conv(u, conv_w[l], conv_b[l], conv_ln_g[l], conv_ln_b[l]) @ w_conv_out[l]
        merged = jax.nn.sigmoid(g_att) * br_att + jax.nn.sigmoid(g_conv) * br_conv
        r = r + merged @ w_out[l]
        n = rmsnorm(r, norm_ffn[l])
        r = r + hierarchical_moe(n, w_router_group[l], b_router_group[l], w_router_expert[l],
                                 b_router_expert[l], w_gate_up[l], w_down[l])
    out = rmsnorm(r, norm_final)
    return out[:, N_META:]
```

```cpp
#include <hip/hip_runtime.h>
#include <hip/hip_bf16.h>
#include <cstdio>
#include <cstdint>
#include <cmath>

#ifndef MK_N_LAUNCHES
#define MK_N_LAUNCHES 1
#endif

#ifndef DBG_DUMP
#define DBG_DUMP 0
#endif
#ifndef DBG_STOP
#define DBG_STOP 100
#endif
#define LAS __attribute__((address_space(3)))
#define GAS __attribute__((address_space(1)))
typedef unsigned short bf16;
typedef unsigned v4u __attribute__((ext_vector_type(4)));
typedef unsigned v2u __attribute__((ext_vector_type(2)));
typedef float f32x4 __attribute__((ext_vector_type(4)));
typedef float f32x2 __attribute__((ext_vector_type(2)));
typedef short bf16x8 __attribute__((ext_vector_type(8)));
typedef float f32x16 __attribute__((ext_vector_type(16)));
typedef short s16x4 __attribute__((ext_vector_type(4)));
typedef GAS unsigned gu32;

constexpr int NB = 8, SEQ = 2048, DM = 2048, NMETA = 16, NH = 16, HD = 64, ATTW = 1024, CONVC = 1024, CONVK = 31;
constexpr int NGRP = 4, EPG = 8, NE = 32, DE = 768, INCOLS = 9232, DEPTH = 2;
constexpr int MR = NB * SEQ;
constexpr int MT = MR + NMETA;
constexpr int MALLOC = 16640;
constexpr int KSEQ = 64 + SEQ;
constexpr int ZSEQ = NMETA + SEQ;
constexpr int PCAP = MT;
constexpr int MAXT = 162;
constexpr float RMS_EPS = 1e-6f, LN_EPS = 1e-5f;
constexpr float LOG2E = 1.4426950408889634f;
constexpr float C2 = 0.125f * 1.4426950408889634f;

constexpr size_t MiB = 1u << 20;
constexpr size_t WS_CTL = 0, CTL_ZERO_BYTES = 64 * 1024;
constexpr size_t WS_WF = 1 * MiB, WS_WR = 2 * MiB, WS_LOGF = 3 * MiB, WS_PERM = 6 * MiB, WS_WTS = 9 * MiB;
constexpr size_t WS_W = 16 * MiB, W_LSTRIDE = 340 * MiB;
constexpr size_t WO_IN = 0, WO_AO = 36 * MiB, WO_CO = 40 * MiB, WO_O = 44 * MiB, WO_GU = 52 * MiB, WO_DN = 244 * MiB;
constexpr size_t WS_XN = 696 * MiB, WS_QO = 761 * MiB, WS_KB = 794 * MiB, WS_VB = 827 * MiB, WS_ZG = 860 * MiB, WS_SGA = 893 * MiB, WS_SGC = 958 * MiB;
constexpr size_t WS_CV = 1023 * MiB, WS_MG = 1056 * MiB, WS_RES = 1121 * MiB, WS_N2 = 1251 * MiB, WS_XS = 1316 * MiB, WS_H = 1478 * MiB, WS_Y0 = 1539 * MiB, WS_Y1 = 1604 * MiB;
constexpr size_t WS_END = 1669 * MiB;
constexpr int CW_TMO = 0, CW_BAR = 4096, CW_CNT = 8192;

#define RLX_AGENT __ATOMIC_RELAXED, __HIP_MEMORY_SCOPE_AGENT
#define LDS_WAIT() asm volatile("s_waitcnt lgkmcnt(0)" ::: "memory")
#define VM_WAIT() asm volatile("s_waitcnt vmcnt(0)" ::: "memory")
typedef __bf16 bf16x2_t __attribute__((ext_vector_type(2)));
__device__ __forceinline__ unsigned cvt_pk_bf16(float lo, float hi) { f32x2 v = {lo, hi}; bf16x2_t b = __builtin_convertvector(v, bf16x2_t); return __builtin_bit_cast(unsigned, b); }
__device__ __forceinline__ float bf_lo(unsigned u) { return __uint_as_float(u << 16); }
__device__ __forceinline__ float bf_hi(unsigned u) { return __uint_as_float(u & 0xffff0000u); }
__device__ __forceinline__ float sigmoidf_fast(float x) { return __builtin_amdgcn_rcpf(1.0f + __builtin_amdgcn_exp2f(-x * LOG2E)); }
template <int X> __device__ __forceinline__ float swz_xor(float v) { return __int_as_float(__builtin_amdgcn_ds_swizzle(__float_as_int(v), 0x1f | (X << 10))); }
__device__ __forceinline__ float xor32_sum(float v) { auto rr = __builtin_amdgcn_permlane32_swap(__float_as_uint(v), __float_as_uint(v), false, false); return __uint_as_float(rr[0]) + __uint_as_float(rr[1]); }
__device__ __forceinline__ float wave_sum(float v) {
    v += swz_xor<1>(v); v += swz_xor<2>(v); v += swz_xor<4>(v); v += swz_xor<8>(v); v += swz_xor<16>(v);
    return xor32_sum(v);
}
__device__ __forceinline__ float shfl_idx(float v, int src_lane) { return __int_as_float(__builtin_amdgcn_ds_bpermute(src_lane << 2, __float_as_int(v))); }
__device__ __forceinline__ int shfl_idx_i(int v, int src_lane) { return __builtin_amdgcn_ds_bpermute(src_lane << 2, v); }

namespace pg8 {
constexpr int BM = 256, BK = 64, HALF = 128, HTB = HALF * BK * 2, STAGE_BYTES = 8 * HTB, NXCD = 8, WGM = 8;
__host__ __device__ __forceinline__ int lds_byte(int r, int c) { const int st = (r >> 4) * 2 + (c >> 5), rr = r & 15, cc = c & 31, ob = rr * 64 + cc * 2; return st * 1024 + (ob ^ (((ob >> 9) & 1) << 5)); }
__host__ __device__ __forceinline__ void stage_rc(int b, int& R, int& C) { const int st = b / 1024, sb = b % 1024, swz = sb ^ (((sb >> 9) & 1) << 5); R = (st >> 1) * 16 + swz / 64; C = (st & 1) * 32 + (swz % 64) / 2; }
__host__ __device__ __forceinline__ int perm32(int rho) { const int n = rho >> 4, i = rho & 15; return 8 * (i >> 2) + 4 * n + (i & 3); }

struct Unit { int pm, pn, aux; };

struct GridOrder {
    int nM, nN, nwg, G, c;
    __device__ __forceinline__ void init(int nM_, int nN_, int G_, int c_) { nM = nM_; nN = nN_; nwg = nM * nN; G = G_; c = c_; }
    __device__ __forceinline__ bool tile(int i, int& pm, int& pn) const {
        const long L = (long)i * G + c; if (L >= nwg) return false;
        int wgid = (int)L; { const int q = nwg / NXCD, r = nwg % NXCD, xcd = wgid % NXCD, off = wgid / NXCD; wgid = (xcd < r ? xcd * (q + 1) : r * (q + 1) + (xcd - r) * q) + off; }
        const int nig = WGM * nN, gid = wgid / nig, fm = gid * WGM, gsz = (nM - fm) < WGM ? (nM - fm) : WGM;
        pm = fm + ((wgid % nig) % gsz); pn = (wgid % nig) / gsz; return true;
    }
};

template <class Epi, class Sched, bool ALIGN_EPI>
__device__ __forceinline__ void gemm_phase(LAS unsigned char* lds, const int K, const Sched& S, const Epi& E) {
    int tid = threadIdx.x; asm volatile("" : "+v"(tid));
    const int wid = __builtin_amdgcn_readfirstlane(tid >> 6), lane = tid & 63, wr = wid >> 2, wc = wid & 3, fr = lane & 15, fq = lane >> 4;
    const int nt = K / BK;
    unsigned voffA[2], voffB[2];
#pragma unroll
    for (int i = 0; i < 2; ++i) { int R, C; stage_rc(tid * 16 + i * 8192, R, C); const int Rb = Epi::PERM ? ((R & ~31) + perm32(R & 31)) : R;
        voffA[i] = (unsigned)(R * K + C) * 2u; voffB[i] = (unsigned)(Rb * K + C) * 2u; }
    const size_t kstep = (size_t)(BK * 2);
    const size_t hstep = (size_t)HALF * K * 2;
    const unsigned ldsw = (unsigned)wid * 1024u;
    const int aoff = lds_byte(wr * 64 + fr, fq * 8), boff = lds_byte(wc * 32 + fr, fq * 8);
#define PG8_SA(b, h) (((b) * 2 + (h)) * HTB)
#define PG8_SB(b, h) ((4 + (b) * 2 + (h)) * HTB)
#define PG8_STAGE(bufoff, gbase, voff) do { _Pragma("unroll") for (int _i = 0; _i < 2; ++_i) \
        __builtin_amdgcn_global_load_lds((const unsigned*)((const char*)(gbase) + (voff)[_i]), (LAS unsigned*)(lds + (bufoff) + ldsw + _i * 8192), 16, 0, 0); } while (0)
#define PG8_LDA(dst, b, h) do { _Pragma("unroll") for (int m = 0; m < 4; ++m) _Pragma("unroll") for (int k = 0; k < 2; ++k) dst[m][k] = *(const LAS bf16x8*)(lds + PG8_SA(b, h) + aoff + m * 2048 + k * 1024); } while (0)
#define PG8_LDB(dst, b, h) do { _Pragma("unroll") for (int n = 0; n < 2; ++n) _Pragma("unroll") for (int k = 0; k < 2; ++k) dst[n][k] = *(const LAS bf16x8*)(lds + PG8_SB(b, h) + boff + n * 2048 + k * 1024); } while (0)
#define PG8_MMA(ai, bj, At, Bt) do { __builtin_amdgcn_s_setprio(1); _Pragma("unroll") for (int m = 0; m < 4; ++m) _Pragma("unroll") for (int n = 0; n < 2; ++n) _Pragma("unroll") for (int k = 0; k < 2; ++k) \
        acc[ai][bj][m][n] = __builtin_amdgcn_mfma_f32_16x16x32_bf16(Bt[n][k], At[m][k], acc[ai][bj][m][n], 0, 0, 0); __builtin_amdgcn_s_setprio(0); } while (0)
#define PG8_WAIT_V(n) asm volatile("s_waitcnt vmcnt(" #n ")" ::: "memory")
#define PG8_WAIT_L(n) asm volatile("s_waitcnt lgkmcnt(" #n ")" ::: "memory")
#define PG8_BAR __builtin_amdgcn_s_barrier()
#define PG8_SCHED __builtin_amdgcn_sched_barrier(0)
#define PG8_ZERO() do { float zf_; asm volatile("v_mov_b32 %0, 0" : "=v"(zf_)); const f32x4 z4_ = {zf_, zf_, zf_, zf_}; _Pragma("unroll") for (int a = 0; a < 2; ++a) _Pragma("unroll") for (int b = 0; b < 2; ++b) _Pragma("unroll") for (int m = 0; m < 4; ++m) _Pragma("unroll") for (int n = 0; n < 2; ++n) acc[a][b][m][n] = z4_; } while (0)
    Unit cur, nxt; int ui = 0;
    if (!S.next(0, cur)) return;
    f32x4 acc[2][2][4][2];
    PG8_ZERO();
    bf16x8 At[4][2], B0[2][2], B1[2][2];
    const char* cA = S.opA(cur); const char* cB = S.opB(cur);
    PG8_STAGE(PG8_SB(0, 0), cB, voffB); PG8_STAGE(PG8_SB(0, 1), cB + hstep, voffB); PG8_STAGE(PG8_SA(0, 0), cA, voffA); PG8_STAGE(PG8_SA(0, 1), cA + hstep, voffA);
    if (wr == 1) PG8_BAR;
    PG8_WAIT_V(2); PG8_BAR;
    PG8_STAGE(PG8_SB(1, 0), cB + kstep, voffB); PG8_STAGE(PG8_SA(1, 0), cA + kstep, voffA); PG8_STAGE(PG8_SB(1, 1), cB + hstep + kstep, voffB);
    PG8_WAIT_V(6); PG8_BAR;
    for (;;) {
        const bool has_next = S.next(ui + 1, nxt);
        const char* nA = has_next ? S.opA(nxt) : cA; const char* nB = has_next ? S.opB(nxt) : cB;
        for (int t = 0; t < nt; t += 2) {
            const bool last = (t == nt - 2);
            const char* a1 = cA + (size_t)(t + 1) * kstep;
            const char* a2 = last ? nA : cA + (size_t)(t + 2) * kstep; const char* b2 = last ? nB : cB + (size_t)(t + 2) * kstep;
            const char* a3 = a2 + kstep; const char* b3 = b2 + kstep;
            PG8_LDB(B0, 0, 0); PG8_LDB(B1, 0, 1); PG8_SCHED; PG8_LDA(At, 0, 0); PG8_STAGE(PG8_SA(1, 1), a1 + hstep, voffA);
            PG8_WAIT_V(8); PG8_WAIT_L(0); PG8_BAR; PG8_MMA(0, 0, At, B0); PG8_MMA(0, 1, At, B1); PG8_BAR; PG8_SCHED;
            PG8_LDA(At, 0, 1); PG8_STAGE(PG8_SB(0, 0), b2, voffB); PG8_STAGE(PG8_SB(0, 1), b2 + hstep, voffB); PG8_STAGE(PG8_SA(0, 0), a2, voffA);
            PG8_WAIT_V(8); PG8_WAIT_L(0); PG8_BAR; PG8_MMA(1, 0, At, B0); PG8_MMA(1, 1, At, B1); PG8_BAR; PG8_SCHED;
            PG8_LDB(B0, 1, 0); PG8_LDB(B1, 1, 1); PG8_SCHED; PG8_LDA(At, 1, 0); PG8_STAGE(PG8_SA(0, 1), a2 + hstep, voffA);
            PG8_WAIT_V(8); PG8_WAIT_L(0); PG8_BAR; PG8_MMA(0, 0, At, B0); PG8_MMA(0, 1, At, B1); PG8_BAR; PG8_SCHED;
            PG8_LDA(At, 1, 1); PG8_STAGE(PG8_SB(1, 0), b3, voffB); PG8_STAGE(PG8_SB(1, 1), b3 + hstep, voffB); PG8_STAGE(PG8_SA(1, 0), a3, voffA);
            PG8_WAIT_V(8); PG8_WAIT_L(0); PG8_BAR; PG8_MMA(1, 0, At, B0); PG8_MMA(1, 1, At, B1); PG8_BAR; PG8_SCHED;
        }
        if constexpr (ALIGN_EPI) { if (wr == 0) PG8_BAR; }
        E(acc, cur, wr, wc, fr, fq);
        if (!has_next) break;
        if (!E.keep(cur)) PG8_ZERO();
        cur = nxt; cA = nA; cB = nB; ++ui;
        if constexpr (ALIGN_EPI) { if (wr == 1) PG8_BAR; }
    }
    PG8_WAIT_V(0);
    if constexpr (!ALIGN_EPI) { if (wr == 0) PG8_BAR; }
    PG8_BAR;
#undef PG8_SA
#undef PG8_SB
#undef PG8_STAGE
#undef PG8_LDA
#undef PG8_LDB
#undef PG8_MMA
#undef PG8_WAIT_V
#undef PG8_WAIT_L
#undef PG8_BAR
#undef PG8_SCHED
#undef PG8_ZERO
}
}

namespace attn_body {
constexpr int D = 64, DMA_ = NH * D;
constexpr int NW = 8, QBLK = 32, QB = QBLK * NW, KVBLK = 64;
__device__ __forceinline__ int crow(int r, int hi) { return (r & 3) + 8 * (r >> 2) + 4 * hi; }
#define SBAR() __builtin_amdgcn_sched_barrier(0)
__device__ __forceinline__ void cmask(f32x16& p0, f32x16& p1, int jb, int qrel, int hi) {
  const float NEG = -INFINITY; int kb = 64 * jb + 4 * hi;
  #pragma unroll
  for (int r = 0; r < 16; ++r) { int kv = kb + (r & 3) + 8 * (r >> 2); if (kv > qrel) p0[r] = NEG; if (kv + 32 > qrel) p1[r] = NEG; }
}
constexpr int NSLOT = 3, SLOTB = 8192;
constexpr int LDS_K = 0, LDS_V = NSLOT * SLOTB, LDS_WS = 2 * NSLOT * SLOTB, LDS_OST = LDS_WS + NW * 64 * 4, LDS_BYTES = LDS_OST + NW * 4096;
constexpr int LDS_CS = LDS_BYTES, LDS_TOT = LDS_CS + KSEQ * 4, LDS_ALL = LDS_TOT + 256;
__device__ __forceinline__ void glds16(const void* gsrc, unsigned lds_dst) { unsigned keep;
  asm volatile("s_mov_b32 %0, m0\n\ts_mov_b32 m0, %2\n\ts_nop 0\n\tglobal_load_lds_dwordx4 %1, off\n\ts_mov_b32 m0, %0" : "=&s"(keep) : "v"(gsrc), "s"(lds_dst) : "memory"); }
__device__ __forceinline__ float max3f(float a, float b, float c) { float r; asm("v_max3_f32 %0, %1, %2, %3" : "=v"(r) : "v"(a), "v"(b), "v"(c)); return r; }
__device__ __forceinline__ float max2f(float a, float b) { float r; asm("v_max_f32_e32 %0, %1, %2" : "=v"(r) : "v"(a), "v"(b)); return r; }
__device__ __forceinline__ float fadd_s(float a, float b) { float r; asm("v_add_f32_e32 %0, %1, %2" : "=v"(r) : "v"(a), "v"(b)); return r; }
__device__ __forceinline__ float fsub_s(float a, float b) { float r; asm("v_sub_f32_e32 %0, %1, %2" : "=v"(r) : "v"(a), "v"(b)); return r; }
__device__ __forceinline__ unsigned cvtpk_s(float lo, float hi) { f32x2 v = {lo, hi}; bf16x2_t b = __builtin_convertvector(v, bf16x2_t); return __builtin_bit_cast(unsigned, b); }
#define WAIT_BAR(N) asm volatile("s_waitcnt vmcnt(" #N ") lgkmcnt(0)\n\ts_barrier" ::: "memory")

__device__ __forceinline__ void qkt(f32x16& p0, f32x16& p1, const char* Kslot, const bf16x8* qr, const f32x16& negm, int r32, int hi) {
  const char* kb = Kslot + hi * 1024 + r32 * 16;
  #pragma unroll
  for (int d0 = 0; d0 < 4; ++d0) {
    const bf16x8 b0 = *reinterpret_cast<const bf16x8*>(kb + d0 * 2048);
    const bf16x8 b1 = *reinterpret_cast<const bf16x8*>(kb + d0 * 2048 + 512);
    if (d0 == 0) { p0 = __builtin_amdgcn_mfma_f32_32x32x16_bf16(b0, qr[0], negm, 0, 0, 0); p1 = __builtin_amdgcn_mfma_f32_32x32x16_bf16(b1, qr[0], negm, 0, 0, 0); }
    else { p0 = __builtin_amdgcn_mfma_f32_32x32x16_bf16(b0, qr[d0], p0, 0, 0, 0); p1 = __builtin_amdgcn_mfma_f32_32x32x16_bf16(b1, qr[d0], p1, 0, 0, 0); } }
}
typedef LAS const char* lds_cptr;
typedef short v4i16_t __attribute__((ext_vector_type(4)));
__device__ __forceinline__ void kload8(bf16x8* kf, lds_cptr kp) {
  kf[0] = *(const LAS bf16x8*)(kp);        kf[1] = *(const LAS bf16x8*)(kp + 512);
  kf[2] = *(const LAS bf16x8*)(kp + 2048); kf[3] = *(const LAS bf16x8*)(kp + 2560);
  kf[4] = *(const LAS bf16x8*)(kp + 4096); kf[5] = *(const LAS bf16x8*)(kp + 4608);
  kf[6] = *(const LAS bf16x8*)(kp + 6144); kf[7] = *(const LAS bf16x8*)(kp + 6656);
}
__device__ __forceinline__ void kload2(bf16x8* kf, lds_cptr kp, int j) { kf[2 * j] = *(const LAS bf16x8*)(kp + j * 2048); kf[2 * j + 1] = *(const LAS bf16x8*)(kp + j * 2048 + 512); }
__device__ __forceinline__ s16x4 vtr(lds_cptr p) { return __builtin_bit_cast(s16x4, __builtin_amdgcn_ds_read_tr16_b64_v4i16((LAS v4i16_t*)p)); }
__device__ __forceinline__ float rowmax(const f32x16& p0, const f32x16& p1) {
  float a = max3f(p0[0], p0[1], p1[0]), b = max3f(p0[2], p0[3], p1[1]); a = max3f(a, p1[2], p1[3]);
  #pragma unroll
  for (int r = 4; r < 16; r += 4) { a = max3f(a, p0[r], p0[r + 1]); b = max3f(b, p0[r + 2], p0[r + 3]); a = max3f(a, p1[r], p1[r + 1]); b = max3f(b, p1[r + 2], p1[r + 3]); }
  const float m = max2f(a, b);
  auto rr = __builtin_amdgcn_permlane32_swap(__float_as_uint(m), __float_as_uint(m), false, false);
  return max2f(__uint_as_float(rr[0]), __uint_as_float(rr[1]));
}
__device__ __forceinline__ void pv(f32x16* o, int vb, bf16x8 pa0, bf16x8 pa1, bf16x8 pa2, bf16x8 pa3) {
  #pragma unroll
  for (int d0 = 0; d0 < 2; ++d0) { s16x4 lo[4], hi[4];
    #pragma unroll
    for (int ks = 0; ks < 4; ++ks) {
      asm volatile("ds_read_b64_tr_b16 %0,%1 offset:%c2" : "=&v"(lo[ks]) : "v"(vb), "i"(d0 * 4096 + ks * 1024) : "memory");
      asm volatile("ds_read_b64_tr_b16 %0,%1 offset:%c2" : "=&v"(hi[ks]) : "v"(vb), "i"(d0 * 4096 + ks * 1024 + 512) : "memory"); }
    asm volatile("s_waitcnt lgkmcnt(0)" ::: "memory"); SBAR();
    #define PK(k) (bf16x8){lo[k][0], lo[k][1], lo[k][2], lo[k][3], hi[k][0], hi[k][1], hi[k][2], hi[k][3]}
    o[d0] = __builtin_amdgcn_mfma_f32_32x32x16_bf16(pa0, PK(0), o[d0], 0, 0, 0);
    o[d0] = __builtin_amdgcn_mfma_f32_32x32x16_bf16(pa1, PK(1), o[d0], 0, 0, 0);
    o[d0] = __builtin_amdgcn_mfma_f32_32x32x16_bf16(pa2, PK(2), o[d0], 0, 0, 0);
    o[d0] = __builtin_amdgcn_mfma_f32_32x32x16_bf16(pa3, PK(3), o[d0], 0, 0, 0);
    #undef PK
  }
}
__device__ __forceinline__ void kbias(f32x16& p0, f32x16& p1, const LAS float* csl, int t, int hi) {
  const LAS f32x4* cb = (const LAS f32x4*)(csl + 64 * t + 4 * hi);
  #pragma unroll
  for (int g = 0; g < 4; ++g) { const f32x4 u0 = cb[2 * g], u1 = cb[8 + 2 * g];
    p0[4 * g + 0] -= u0[0]; p0[4 * g + 1] -= u0[1]; p0[4 * g + 2] -= u0[2]; p0[4 * g + 3] -= u0[3];
    p1[4 * g + 0] -= u1[0]; p1[4 * g + 1] -= u1[1]; p1[4 * g + 2] -= u1[2]; p1[4 * g + 3] -= u1[3]; }
}

template <int THRL> __device__ __forceinline__ void attn_unit(int b, int h, int qb, const __hip_bfloat16* Q, const __hip_bfloat16* __restrict__ K, const __hip_bfloat16* __restrict__ V, __hip_bfloat16* O, char* shm) {
  using bf16h = __hip_bfloat16;
  int tid = threadIdx.x; asm volatile("" : "+v"(tid));
  const int lane = tid & 63, r32 = lane & 31, hi = lane >> 5; const int wid = __builtin_amdgcn_readfirstlane(tid >> 6);
  const long rowbaseQ = (long)b * SEQ, rowbaseK = (long)b * KSEQ; const int q0 = qb * QB;
  const bf16h* Qw = Q + (rowbaseQ + q0 + wid * QBLK) * DMA_ + h * D;
  const bf16h* Kh = K + rowbaseK * DMA_ + h * D, *Vh = V + rowbaseK * DMA_ + h * D;
  const unsigned lds0 = (unsigned)(uintptr_t)shm;
  float* wsf = (float*)(shm + LDS_WS) + wid * 64;
  const LAS float* csl = (const LAS float*)((LAS const char*)shm + LDS_CS);
  const bf16h* ksrc = Kh + (long)lane * DMA_ + wid * 8;
  const bf16h* vsrc = Vh + (long)(16 * (wid & 3) + (lane >> 2)) * DMA_ + (wid >> 2) * 32 + (lane & 3) * 8;
  const unsigned kdst = lds0 + LDS_K + wid * 1024, vdst = lds0 + LDS_V + wid * 1024;
  #define DMA_K(t, slot) glds16(ksrc + (long)(t) * KVBLK * DMA_, (unsigned)__builtin_amdgcn_readfirstlane(kdst + (slot)))
  #define DMA_V(t, slot) glds16(vsrc + (long)(t) * KVBLK * DMA_, (unsigned)__builtin_amdgcn_readfirstlane(vdst + (slot)))
  const int vb0 = (int)(lds0 + LDS_V) + ((lane >> 4) & 1) * 32 + (lane & 3) * 8 + (4 * hi + ((lane & 15) >> 2)) * 64;
  const char* Kbase = shm + LDS_K; bf16x8 kf[8];
  const lds_cptr shm3 = (lds_cptr)shm; const lds_cptr kp0 = shm3 + LDS_K + hi * 1024 + r32 * 16; const lds_cptr vp0 = shm3 + LDS_V + ((lane >> 4) & 1) * 32 + (lane & 3) * 8 + (4 * hi + ((lane & 15) >> 2)) * 64;
  const int NT = (q0 + QB) / KVBLK + 1;
  DMA_K(0, 0); DMA_V(0, 0); DMA_K(1, SLOTB);
  bf16x8 qr[4];
  #pragma unroll
  for (int d0 = 0; d0 < 4; ++d0) qr[d0] = *reinterpret_cast<const bf16x8*>(&Qw[(long)r32 * DMA_ + d0 * 16 + hi * 8]);
  const float cq = csl[64 + q0 + wid * QBLK + r32];
  float mhat = 0.f, l_reg = 0.f; f32x16 o[2]; o[0] = f32x16{}; o[1] = f32x16{}; f32x16 negm;
  #pragma unroll
  for (int r = 0; r < 16; ++r) negm[r] = cq;
  asm volatile("" : "+v"(negm));
  const int qrel = wid * QBLK + r32;
  #define CMASK(P0, P1, t) do { int jb_ = (t) - (NT - 4); if (jb_ >= 0) cmask(P0, P1, jb_, qrel, hi); } while (0)
  bool resc = false;
  #define START(P0, P1) do { const float rm = rowmax(P0, P1); resc = false; \
    { const float dl = rm; mhat = fadd_s(mhat, dl); \
      _Pragma("unroll") for (int r = 0; r < 16; ++r) { P0[r] = fsub_s(P0[r], dl); P1[r] = fsub_s(P1[r], dl); } \
      _Pragma("unroll") for (int r = 0; r < 16; ++r) negm[r] = cq - mhat; asm volatile("" : "+v"(negm)); } \
    _Pragma("unroll") for (int r = 0; r < 16; ++r) P0[r] = __builtin_amdgcn_exp2f(P0[r]); } while (0)
  #define RESC() do { if (resc) { asm volatile("s_waitcnt lgkmcnt(0)" ::: "memory"); \
      _Pragma("unroll") for (int d_ = 0; d_ < 2; ++d_) _Pragma("unroll") for (int r = 0; r < 16; ++r) o[d_][r] *= wsf[crow(r, hi)]; } } while (0)
  f32x16 pA0, pA1, pB0, pB1;
  int sl_prev = 0, sl_cur = 0, sl_next = SLOTB;
  #define ROT() do { sl_prev = sl_cur; sl_cur = sl_next; sl_next = (sl_next == (NSLOT - 1) * SLOTB) ? 0 : sl_next + SLOTB; } while (0)
  DMA_K(2, 2 * SLOTB);
  WAIT_BAR(3);
  qkt(pA0, pA1, Kbase, qr, negm, r32, hi); asm volatile("s_nop 15\n\ts_nop 7" : "+v"(pA0), "+v"(pA1)); kbias(pA0, pA1, csl, 0, hi);
  START(pA0, pA1);
  _Pragma("unroll") for (int r = 0; r < 16; ++r) pA1[r] = __builtin_amdgcn_exp2f(pA1[r]);
  WAIT_BAR(0);
  DMA_K(3, 0); DMA_V(1, SLOTB);
  ROT();
  kload8(kf, kp0 + sl_cur);
  WAIT_BAR(2);
  s16x4 vlo[8], vhi[8]; v4u pw0, pw1, pw2, pw3;
  #define PKW(P, B) cvtpk_s(P[B], P[B + 1])
  #define PAF(k) __builtin_bit_cast(bf16x8, pw##k)
  #define VFR(i) (bf16x8){vlo[i][0], vlo[i][1], vlo[i][2], vlo[i][3], vhi[i][0], vhi[i][1], vhi[i][2], vhi[i][3]}
  #define PIN(x) asm volatile("" : "+v"(x))
  #define MX3(a, b, c) __builtin_fmaxf(__builtin_fmaxf((a), (b)), (c))
  #define GAPA(MF, A0, A1, A2, A3, W0, W1, PW) do { MF; sacc += A0; sacc += A1; sacc += A2; sacc += A3; PIN(sacc); W0; W1; PIN(PW); SBAR(); } while (0)
  #define EX(v) __builtin_amdgcn_exp2f(v)
  #define GAPB(MF, X, B) do { MF; X[B] = EX(X[B]); X[B + 1] = EX(X[B + 1]); X[B + 2] = EX(X[B + 2]); X[B + 3] = EX(X[B + 3]); PIN(X); SBAR(); } while (0)
  #define VRD(i) do { vlo[i] = vtr(vp_ + (((i) >> 2) * 4096 + ((i) & 3) * 1024)); vhi[i] = vtr(vp_ + (((i) >> 2) * 4096 + ((i) & 3) * 1024 + 512)); } while (0)
  #define KRD(G, j) do { if (G) { kload2(kf, kp0 + sl_next, j); SBAR(); } } while (0)
  #define STEP(C0, C1, P0, P1, t, GK, GV, GL) do { SBAR(); \
    const lds_cptr vp_ = vp0 + sl_prev; \
    VRD(0); SBAR(); float sacc = (P0[0] + P0[1]); \
    GAPA(C0 = __builtin_amdgcn_mfma_f32_32x32x16_bf16(kf[0], qr[0], negm, 0, 0, 0), P0[2], P0[3], P0[4], P0[5],     pw0[0] = PKW(P0, 0), pw0[1] = PKW(P0, 2), pw0); \
    VRD(4); SBAR(); GAPA(C1 = __builtin_amdgcn_mfma_f32_32x32x16_bf16(kf[1], qr[0], negm, 0, 0, 0), P0[6], P0[7], P0[8], P0[9],     pw0[2] = PKW(P0, 4), pw0[3] = PKW(P0, 6), pw0); \
    VRD(1); SBAR(); GAPA(C0 = __builtin_amdgcn_mfma_f32_32x32x16_bf16(kf[2], qr[1], C0, 0, 0, 0),   P0[10], P0[11], P0[12], P0[13], pw1[0] = PKW(P0, 8), pw1[1] = PKW(P0, 10), pw1); \
    VRD(5); SBAR(); GAPA(C1 = __builtin_amdgcn_mfma_f32_32x32x16_bf16(kf[3], qr[1], C1, 0, 0, 0),   P0[14], P0[15], P1[0], P1[1],   pw1[2] = PKW(P0, 12), pw1[3] = PKW(P0, 14), pw1); \
    VRD(2); SBAR(); GAPA(C0 = __builtin_amdgcn_mfma_f32_32x32x16_bf16(kf[4], qr[2], C0, 0, 0, 0),   P1[2], P1[3], P1[4], P1[5],     pw2[0] = PKW(P1, 0), pw2[1] = PKW(P1, 2), pw2); \
    VRD(6); SBAR(); GAPA(C1 = __builtin_amdgcn_mfma_f32_32x32x16_bf16(kf[5], qr[2], C1, 0, 0, 0),   P1[6], P1[7], P1[8], P1[9],     pw2[2] = PKW(P1, 4), pw2[3] = PKW(P1, 6), pw2); \
    VRD(3); SBAR(); GAPA(C0 = __builtin_amdgcn_mfma_f32_32x32x16_bf16(kf[6], qr[3], C0, 0, 0, 0),   P1[10], P1[11], P1[12], P1[13], pw3[0] = PKW(P1, 8), pw3[1] = PKW(P1, 10), pw3); \
    VRD(7); SBAR(); GAPA(C1 = __builtin_amdgcn_mfma_f32_32x32x16_bf16(kf[7], qr[3], C1, 0, 0, 0),   P1[14], P1[15], 0.f, 0.f,       pw3[2] = PKW(P1, 12), pw3[3] = PKW(P1, 14), pw3); \
    l_reg += sacc; \
    if (GK) { DMA_K((t) + 3, sl_cur); } if (GV) { DMA_V((t) + 1, sl_next); } \
    kbias(C0, C1, csl, (t), hi); \
    CMASK(C0, C1, t); \
    { float a = MX3(C0[0], C0[1], C1[0]), b = MX3(C0[2], C0[3], C1[1]); a = MX3(a, C1[2], C1[3]); \
      _Pragma("unroll") for (int r = 4; r < 16; r += 4) { a = MX3(a, C0[r], C0[r + 1]); b = MX3(b, C0[r + 2], C0[r + 3]); a = MX3(a, C1[r], C1[r + 1]); b = MX3(b, C1[r + 2], C1[r + 3]); } \
      float rm = __builtin_fmaxf(a, b); { auto rr = __builtin_amdgcn_permlane32_swap(__float_as_uint(rm), __float_as_uint(rm), false, false); rm = __builtin_fmaxf(__uint_as_float(rr[0]), __uint_as_float(rr[1])); } \
      resc = false; \
      if (__builtin_expect(__any(rm > (float)THRL), 0)) { const float dl = __builtin_fmaxf(rm, 0.f); mhat += dl; \
        _Pragma("unroll") for (int r = 0; r < 16; ++r) { C0[r] -= dl; C1[r] -= dl; } \
        _Pragma("unroll") for (int r = 0; r < 16; ++r) negm[r] = cq - mhat; asm volatile("" : "+v"(negm)); \
        const float f = __builtin_amdgcn_exp2f(-dl); l_reg *= f; if (hi == 0) wsf[r32] = f; resc = true; } } \
    SBAR(); \
    GAPB(o[0] = __builtin_amdgcn_mfma_f32_32x32x16_bf16(PAF(0), VFR(0), o[0], 0, 0, 0), C0, 0); \
    GAPB(o[1] = __builtin_amdgcn_mfma_f32_32x32x16_bf16(PAF(0), VFR(4), o[1], 0, 0, 0), C0, 4); \
    KRD(GL, 0); GAPB(o[0] = __builtin_amdgcn_mfma_f32_32x32x16_bf16(PAF(1), VFR(1), o[0], 0, 0, 0), C0, 8); \
    KRD(GL, 1); GAPB(o[1] = __builtin_amdgcn_mfma_f32_32x32x16_bf16(PAF(1), VFR(5), o[1], 0, 0, 0), C0, 12); \
    KRD(GL, 2); GAPB(o[0] = __builtin_amdgcn_mfma_f32_32x32x16_bf16(PAF(2), VFR(2), o[0], 0, 0, 0), C1, 0); \
    KRD(GL, 3); GAPB(o[1] = __builtin_amdgcn_mfma_f32_32x32x16_bf16(PAF(2), VFR(6), o[1], 0, 0, 0), C1, 4); \
    GAPB(o[0] = __builtin_amdgcn_mfma_f32_32x32x16_bf16(PAF(3), VFR(3), o[0], 0, 0, 0), C1, 8); \
    GAPB(o[1] = __builtin_amdgcn_mfma_f32_32x32x16_bf16(PAF(3), VFR(7), o[1], 0, 0, 0), C1, 12); \
    } while (0)
  int t = 1;
  #undef CMASK
  #define CMASK(P0, P1, t) do {} while (0)
  for (; t + 5 < NT; t += 2) {
    STEP(pB0, pB1, pA0, pA1, t, true, true, true);     WAIT_BAR(2); RESC(); ROT();
    STEP(pA0, pA1, pB0, pB1, t + 1, true, true, true); WAIT_BAR(2); RESC(); ROT();
  }
  #undef CMASK
  #define CMASK(P0, P1, t) do { int jb_ = (t) - (NT - 4); if (jb_ >= 0) cmask(P0, P1, jb_, qrel, hi); } while (0)
  #define ENDW(tt) do { if ((tt) + 3 < NT) { WAIT_BAR(2); } else if ((tt) + 2 < NT) { WAIT_BAR(1); } else { WAIT_BAR(0); } } while (0)
  for (; t + 1 < NT; t += 2) {
    STEP(pB0, pB1, pA0, pA1, t, (t + 3 < NT), (t + 1 < NT), (t + 1 < NT));       ENDW(t);     RESC(); ROT();
    STEP(pA0, pA1, pB0, pB1, t + 1, (t + 4 < NT), (t + 2 < NT), (t + 2 < NT));   ENDW(t + 1); RESC(); ROT();
  }
  { float sacc = pA0[0] + pA0[1]; _Pragma("unroll") for (int r = 2; r < 16; ++r) sacc += pA0[r]; _Pragma("unroll") for (int r = 0; r < 16; ++r) sacc += pA1[r]; l_reg += sacc;
    pw0 = (v4u){PKW(pA0, 0), PKW(pA0, 2), PKW(pA0, 4), PKW(pA0, 6)}; pw1 = (v4u){PKW(pA0, 8), PKW(pA0, 10), PKW(pA0, 12), PKW(pA0, 14)}; pw2 = (v4u){PKW(pA1, 0), PKW(pA1, 2), PKW(pA1, 4), PKW(pA1, 6)}; pw3 = (v4u){PKW(pA1, 8), PKW(pA1, 10), PKW(pA1, 12), PKW(pA1, 14)};
    SBAR(); pv(o, vb0 + sl_prev, PAF(0), PAF(1), PAF(2), PAF(3)); }
  #undef PKW
  #undef PAF
  #undef VFR
  #undef PIN
  #undef MX3
  #undef GAPA
  #undef GAPB
  #undef EX
  #undef VRD
  #undef KRD
  #undef STEP
  #undef ENDW
  { auto rr = __builtin_amdgcn_permlane32_swap(__float_as_uint(l_reg), __float_as_uint(l_reg), false, false); l_reg = __uint_as_float(rr[0]) + __uint_as_float(rr[1]); }
  if (hi == 0) wsf[32 + r32] = l_reg; asm volatile("s_waitcnt lgkmcnt(0)" ::: "memory");
  float rli[16];
  #pragma unroll
  for (int r = 0; r < 16; ++r) rli[r] = __builtin_amdgcn_rcpf(wsf[32 + crow(r, hi)]);
  bf16h* Ow = O + (rowbaseQ + q0 + wid * QBLK) * DMA_ + h * D;
  { bf16h* stg = (bf16h*)(shm + LDS_OST) + wid * 2048;
    #pragma unroll
    for (int r = 0; r < 16; ++r) { const int orow = crow(r, hi);
      #pragma unroll
      for (int d0 = 0; d0 < 2; ++d0) stg[orow * 64 + d0 * 32 + r32] = __float2bfloat16(o[d0][r] * rli[r]); }
    asm volatile("s_waitcnt lgkmcnt(0)" ::: "memory");
    #pragma unroll
    for (int i = 0; i < 4; ++i) { const int row = i * 8 + (lane >> 3), ch = lane & 7; const v4u v = *(const v4u*)(stg + row * 64 + ch * 8); *(v4u*)(Ow + (long)row * DMA_ + ch * 8) = v; } }
  asm volatile("s_waitcnt lgkmcnt(0)\n\ts_barrier" ::: "memory");
  #undef DMA_K
  #undef DMA_V
  #undef CMASK
  #undef START
  #undef RESC
  #undef ROT
}
#undef SBAR
#undef WAIT_BAR
}

#define XB_TMO      128
#define XB_XCNT(j)  (256  + 64 * (j))
#define XB_XSUB(j)  (1280 + 64 * (j))
#define XB_XGEN(j)  (2304 + 64 * (j))
#define XB_TOP      3328
#define XB_TOPGEN   3392
#define XCD_BAR_WORDS 3456
#define XB_SPIN_CAP (1u << 18)
__device__ __forceinline__ unsigned xb_ld(unsigned* p)              { return __hip_atomic_load(p, __ATOMIC_RELAXED, __HIP_MEMORY_SCOPE_AGENT); }
__device__ __forceinline__ unsigned xb_add(unsigned* p, unsigned v) { return __hip_atomic_fetch_add(p, v, __ATOMIC_RELAXED, __HIP_MEMORY_SCOPE_AGENT); }
__device__ __forceinline__ unsigned xb_xcc_id() { return (unsigned)__builtin_amdgcn_s_getreg((3 << 11) | 20) & 0xFu; }
#define XB_SPIN(cond, bar) do { unsigned _sp = 0; while (cond) { __builtin_amdgcn_s_sleep(1); \
    if ((++_sp & 255u) == 0u) { if (xb_ld(&(bar)[XB_TMO])) break; if (_sp > XB_SPIN_CAP) { atomicAdd(&(bar)[XB_TMO], 1u); break; } } } } while (0)
struct XcdBarrier { unsigned* bar; unsigned x; volatile LAS unsigned* st; };
__device__ __forceinline__ XcdBarrier xcd_barrier_post(unsigned* bar, volatile LAS unsigned* st) {
    XcdBarrier b; b.bar = bar; b.x = xb_xcc_id(); b.st = st;
    if (threadIdx.x == 0) (void)xb_add(&bar[XB_XCNT(b.x)], 1u);
    return b;
}
__device__ __forceinline__ void xcd_barrier_complete(unsigned* bar, unsigned x, unsigned& nloc, unsigned& nx) {
    const unsigned G = gridDim.x * gridDim.y * gridDim.z;
    unsigned sum, cnt, mine, sp = 0u;
    for (;;) {
        sum = 0u; cnt = 0u; mine = 0u;
#pragma unroll
        for (unsigned j = 0; j < 16; ++j) { const unsigned c = xb_ld(&bar[XB_XCNT(j)]); sum += c; cnt += (c > 0u) ? 1u : 0u; mine = (j == x) ? c : mine; }
        if (sum == G) break;
        __builtin_amdgcn_s_sleep(1);
        if ((++sp & 255u) == 0u) { if (xb_ld(&bar[XB_TMO])) break; if (sp > XB_SPIN_CAP) { atomicAdd(&bar[XB_TMO], 1u); break; } }
    }
    nloc = mine > 0u ? mine : 1u; nx = cnt > 0u ? cnt : 1u;
}
__device__ __forceinline__ void xcd_barrier(const XcdBarrier& b) {
    asm volatile("s_waitcnt vmcnt(0)" ::: "memory");
    __syncthreads();
    if (threadIdx.x == 0) {
        unsigned* bar = b.bar;
        __builtin_amdgcn_s_waitcnt(0);
        unsigned nloc = b.st[0], nx = b.st[1];
        if (nloc == 0u) { xcd_barrier_complete(bar, b.x, nloc, nx); b.st[0] = nloc; b.st[1] = nx; }
        const unsigned old = xb_add(&bar[XB_XSUB(b.x)], 1u);
        const unsigned gen = old / nloc;
        if (old + 1u == (gen + 1u) * nloc) {
            __builtin_amdgcn_fence(__ATOMIC_RELEASE, "agent");
            asm volatile("s_waitcnt vmcnt(0)" ::: "memory");
            const unsigned og = xb_add(&bar[XB_TOP], 1u);
            const unsigned tg = og / nx;
            if (og + 1u == (tg + 1u) * nx) xb_add(&bar[XB_TOPGEN], 1u);
            else XB_SPIN(xb_ld(&bar[XB_TOPGEN]) == tg, bar);
            __builtin_amdgcn_fence(__ATOMIC_ACQUIRE, "agent");
            xb_add(&bar[XB_XGEN(b.x)], 1u);
            asm volatile("s_waitcnt vmcnt(0)" ::: "memory");
        } else {
            XB_SPIN(xb_ld(&bar[XB_XGEN(b.x)]) == gen, bar);
            __builtin_amdgcn_fence(__ATOMIC_ACQUIRE, "agent");
            asm volatile("s_waitcnt vmcnt(0)" ::: "memory");
        }
    }
    __syncthreads();
}

constexpr int RING_OFF = 0, RING_BYTES = 131072;
constexpr int MISC_OFF = RING_BYTES;
constexpr int TAB_OFF = MISC_OFF + 512;
constexpr int LDS_BYTES = RING_BYTES + 4096;
constexpr int NWAVES = 8;

struct Frame {
    LAS unsigned char* lds;
    volatile LAS unsigned* MISC;
    gu32* ctl;
    int tid, lane, wave, vcu, G, gw, NGW;
    unsigned char* ws;
    const float* const* in;
};
#define WSP(T, off) ((T*)(F.ws + (off)))
#define OPAQUE_IDS() int tid_ = F.tid; asm volatile("" : "+v"(tid_)); const int lane_ = tid_ & 63; const int wave_ = __builtin_amdgcn_readfirstlane(tid_ >> 6); (void)lane_; (void)wave_

__device__ __forceinline__ f32x4 mm16(const bf16* X, size_t ldx, const bf16* Y, size_t ldy, int K, f32x4 acc, int lane) {
    const int r = lane & 15, kg = lane >> 4;
    const GAS bf16* xp = (const GAS bf16*)X + (size_t)r * ldx + kg * 8; const GAS bf16* yp = (const GAS bf16*)Y + (size_t)r * ldy + kg * 8;
#pragma unroll 1
    for (int k = 0; k < K; k += 256) {
        bf16x8 xa[8], ya[8];
#pragma unroll
        for (int s = 0; s < 8; ++s) { xa[s] = *(const GAS bf16x8*)(xp + k + 32 * s); ya[s] = *(const GAS bf16x8*)(yp + k + 32 * s); }
#pragma unroll
        for (int s = 0; s < 8; ++s) acc = __builtin_amdgcn_mfma_f32_16x16x32_bf16(xa[s], ya[s], acc, 0, 0, 0);
    }
    return acc;
}

__device__ __forceinline__ void transpose_item(const float* W, size_t ldw, int K, bf16* WT, int csrc, int drow, int k0, LAS float* scr, int lane) {
    const GAS float* Wg = (const GAS float*)W;
#pragma unroll 8
    for (int i = 0; i < 32; ++i) { const int kk = 2 * i + (lane >> 5); scr[kk * 33 + (lane & 31)] = Wg[(size_t)(k0 + kk) * ldw + csrc + (lane & 31)]; }
    LDS_WAIT(); asm volatile("" ::: "memory");
    const int c = lane & 7;
#pragma unroll
    for (int j = 0; j < 4; ++j) { const int n = (lane >> 3) + 8 * j; const LAS float* s = scr + (8 * c) * 33 + n;
        v4u o; o.x = cvt_pk_bf16(s[0 * 33], s[1 * 33]); o.y = cvt_pk_bf16(s[2 * 33], s[3 * 33]); o.z = cvt_pk_bf16(s[4 * 33], s[5 * 33]); o.w = cvt_pk_bf16(s[6 * 33], s[7 * 33]);
        *(GAS v4u*)(WT + (size_t)(drow + n) * K + k0 + 8 * c) = o; }
    LDS_WAIT(); asm volatile("" ::: "memory");
}
constexpr int IT_INA = 32 * 96, IT_INB = 32 * 192, IT_AO = 16 * 64, IT_CO = 16 * 64, IT_O = 32 * 64, IT_GU1 = 32 * 48, IT_GU = NE * IT_GU1, IT_DN1 = 12 * 64, IT_DN = NE * IT_DN1;
constexpr int IT_LAYER = IT_INA + IT_INB + IT_AO + IT_CO + IT_O + IT_GU + IT_DN;
__device__ __forceinline__ void p0_convert(Frame& F) {
    OPAQUE_IDS();
    LAS float* scr = (LAS float*)(F.lds + RING_OFF + wave_ * 16384);
    for (int it = F.gw; it < DEPTH * IT_LAYER; it += F.NGW) {
        const int l = it / IT_LAYER; int r = it % IT_LAYER;
        unsigned char* wl = F.ws + WS_W + (size_t)l * W_LSTRIDE;
        if (r < IT_INA) { const int kb = r / 96, nb = r % 96; transpose_item(F.in[3] + (size_t)l * DM * INCOLS, INCOLS, DM, (bf16*)(wl + WO_IN), 32 * nb, 32 * nb, 64 * kb, scr, lane_); continue; } r -= IT_INA;
        if (r < IT_INB) { const int kb = r / 192, nb = r % 192, c = 32 * nb; int drow;
            if (c < 2048) drow = 3072 + ((c & 1023) >> 7) * 256 + (c >> 10) * 128 + (c & 127); else drow = 5120 + (c - 2048);
            transpose_item(F.in[3] + (size_t)l * DM * INCOLS, INCOLS, DM, (bf16*)(wl + WO_IN), 3088 + c, drow, 64 * kb, scr, lane_); continue; } r -= IT_INB;
        if (r < IT_AO) { const int kb = r / 64, nb = r % 64; transpose_item(F.in[5] + (size_t)l * ATTW * DM, DM, ATTW, (bf16*)(wl + WO_AO), 32 * nb, 32 * nb, 64 * kb, scr, lane_); continue; } r -= IT_AO;
        if (r < IT_CO) { const int kb = r / 64, nb = r % 64; transpose_item(F.in[10] + (size_t)l * CONVC * DM, DM, CONVC, (bf16*)(wl + WO_CO), 32 * nb, 32 * nb, 64 * kb, scr, lane_); continue; } r -= IT_CO;
        if (r < IT_O) { const int kb = r / 64, nb = r % 64; transpose_item(F.in[11] + (size_t)l * DM * DM, DM, DM, (bf16*)(wl + WO_O), 32 * nb, 32 * nb, 64 * kb, scr, lane_); continue; } r -= IT_O;
        if (r < IT_GU) { const int e = r / IT_GU1, q = r % IT_GU1, kb = q / 48, nb = q % 48, c = 32 * nb; int drow;
            if (c < DE) drow = (c >> 7) * 256 + (c & 127); else drow = ((c - DE) >> 7) * 256 + 128 + ((c - DE) & 127);
            transpose_item(F.in[17] + ((size_t)l * NE + e) * DM * (2 * DE), 2 * DE, DM, (bf16*)(wl + WO_GU) + (size_t)e * (2 * DE) * DM, c, drow, 64 * kb, scr, lane_); continue; } r -= IT_GU;
        { const int e = r / IT_DN1, q = r % IT_DN1, kb = q / 64, nb = q % 64;
            transpose_item(F.in[18] + ((size_t)l * NE + e) * DE * DM, DM, DE, (bf16*)(wl + WO_DN) + (size_t)e * DM * DE, 32 * nb, 32 * nb, 64 * kb, scr, lane_); }
    }
    const int gt = F.vcu * 512 + tid_, NGT = F.G * 512;
    bf16* WfT = WSP(bf16, WS_WF); bf16* WrT = WSP(bf16, WS_WR);
    for (int i = gt; i < DEPTH * 16 * DM; i += NGT) { const int l = i / (16 * DM), h = (i / DM) % 16, k = i % DM;
        WfT[i] = (bf16)(cvt_pk_bf16(F.in[3][((size_t)l * DM + k) * INCOLS + 3072 + h], 0.f) & 0xffffu); }
    for (int i = gt; i < DEPTH * 48 * DM; i += NGT) { const int l = i / (48 * DM), c = (i / DM) % 48, k = i % DM; float v = 0.f;
        if (c < NGRP) v = F.in[13][((size_t)l * DM + k) * NGRP + c]; else if (c < NGRP + NE) v = F.in[15][((size_t)l * DM + k) * NE + (c - NGRP)];
        WrT[i] = (bf16)(cvt_pk_bf16(v, 0.f) & 0xffffu); }
    { v4u* kb = WSP(v4u, WS_KB); v4u* vb = WSP(v4u, WS_VB);
        for (int i = gt; i < NB * 6144; i += NGT) { const int b = i / 6144, q = i % 6144; const size_t o = (size_t)b * KSEQ * 128 + q; kb[o] = (v4u){0u, 0u, 0u, 0u}; vb[o] = (v4u){0u, 0u, 0u, 0u}; } }
}

template <int MODE> __device__ __forceinline__ void norm_phase(Frame& F, const float* gain, bf16* dst, float* outf) {
    OPAQUE_IDS();
    float* RES = WSP(float, WS_RES); const bf16* Y0 = WSP(bf16, WS_Y0); const bf16* Y1 = WSP(bf16, WS_Y1);
    f32x4 g[8];
#pragma unroll
    for (int j = 0; j < 8; ++j) g[j] = ((const GAS f32x4*)gain)[lane_ + 64 * j];
    const int mend = (MODE == 3) ? MR : MT;
    for (int m = F.gw; m < mend; m += F.NGW) {
        const float* src = (MODE == 0) ? (m < MR ? F.in[0] + (size_t)m * DM : F.in[1] + (size_t)(m - MR) * DM) : RES + (size_t)m * DM;
        const GAS f32x4* sp = (const GAS f32x4*)src + lane_;
        f32x4 v[8]; float ss = 0.f;
#pragma unroll
        for (int j = 0; j < 8; ++j) v[j] = sp[64 * j];
        if (MODE == 1 || MODE == 3) {
            const GAS v2u* y0 = (const GAS v2u*)(Y0 + (size_t)m * DM) + lane_; const GAS v2u* y1 = (const GAS v2u*)(Y1 + (size_t)m * DM) + lane_;
#pragma unroll
            for (int j = 0; j < 8; ++j) { const v2u a = y0[64 * j], b = y1[64 * j];
                v[j].x += bf_lo(a.x) + bf_lo(b.x); v[j].y += bf_hi(a.x) + bf_hi(b.x); v[j].z += bf_lo(a.y) + bf_lo(b.y); v[j].w += bf_hi(a.y) + bf_hi(b.y); }
        }
#pragma unroll
        for (int j = 0; j < 8; ++j) ss += (v[j].x * v[j].x + v[j].y * v[j].y) + (v[j].z * v[j].z + v[j].w * v[j].w);
        const float rstd = 1.0f / sqrtf(wave_sum(ss) * (1.0f / DM) + RMS_EPS);
        if (MODE == 1) { GAS f32x4* rp = (GAS f32x4*)(RES + (size_t)m * DM) + lane_;
#pragma unroll
            for (int j = 0; j < 8; ++j) rp[64 * j] = v[j]; }
        if (MODE == 3) { GAS f32x4* op = (GAS f32x4*)(outf + (size_t)m * DM) + lane_;
#pragma unroll
            for (int j = 0; j < 8; ++j) op[64 * j] = v[j] * rstd * g[j];
        } else { GAS v2u* op = (GAS v2u*)(dst + (size_t)m * DM) + lane_;
#pragma unroll
            for (int j = 0; j < 8; ++j) { const f32x4 o = v[j] * rstd * g[j]; v2u w; w.x = cvt_pk_bf16(o.x, o.y); w.y = cvt_pk_bf16(o.z, o.w); op[64 * j] = w; } }
    }
}

__device__ __forceinline__ void pb_side(Frame& F, int l) {
    OPAQUE_IDS();
    const bf16* XN = WSP(bf16, WS_XN); const bf16* WinT = (const bf16*)(F.ws + WS_W + (size_t)l * W_LSTRIDE + WO_IN);
    const int g4 = (lane_ >> 4) * 4, y_ = lane_ & 15;
    if (F.gw < MT / 16) {
        const int rb = F.gw;
        const f32x4 a = mm16(WSP(bf16, WS_WF) + (size_t)l * 16 * DM, DM, XN + (size_t)rb * 16 * DM, DM, DM, (f32x4){0.f, 0.f, 0.f, 0.f}, lane_);
        float* LOGF = WSP(float, WS_LOGF); int y = y_; asm volatile("" : "+v"(y));
#pragma unroll 1
        for (int r = 0; r < 4; ++r) { const int h = g4 + r; const float x = a[r] + F.in[4][l * NH + h];
            const float lf = (fminf(x, 0.f) - log1pf(expf(-fabsf(x)))) * LOG2E;
            if (rb < MR / 16) { const int m = rb * 16 + y, b = m >> 11, t = m & 2047; LOGF[(size_t)(b * NH + h) * KSEQ + 64 + t] = lf; }
            else { float* lp = LOGF + (size_t)h * KSEQ + 48 + y;
_Pragma("unroll 1")
                for (int bb = 0; bb < NB; ++bb) { *lp = lf; lp += (size_t)NH * KSEQ; } } }
    }
    const int j = F.NGW - 1 - F.gw;
    if (j < 576) {
        const int tile = j >> 4, sub = j & 15;
        const bf16* Ym = XN + (size_t)MR * DM;
        if (tile >= 12 && tile < 20) {
            if (sub < 8) {
                const f32x4 a = mm16(WinT + (size_t)(tile * 256 + sub * 16) * DM, DM, Ym, DM, DM, (f32x4){0.f, 0.f, 0.f, 0.f}, lane_);
                const f32x4 bq = mm16(WinT + (size_t)(tile * 256 + 128 + sub * 16) * DM, DM, Ym, DM, DM, (f32x4){0.f, 0.f, 0.f, 0.f}, lane_);
                int y = y_; asm volatile("" : "+v"(y));
                v2u w; w.x = cvt_pk_bf16(a[0] * sigmoidf_fast(bq[0]), a[1] * sigmoidf_fast(bq[1])); w.y = cvt_pk_bf16(a[2] * sigmoidf_fast(bq[2]), a[3] * sigmoidf_fast(bq[3]));
                bf16* ZG = WSP(bf16, WS_ZG);
                bf16* zp = ZG + (size_t)y * CONVC + (tile - 12) * 128 + sub * 16 + g4;
_Pragma("unroll 1")
                for (int bb = 0; bb < NB; ++bb) { *(v2u*)zp = w; zp += (size_t)ZSEQ * CONVC; }
            }
        } else {
            f32x4 a = mm16(WinT + (size_t)(tile * 256 + sub * 16) * DM, DM, Ym, DM, DM, (f32x4){0.f, 0.f, 0.f, 0.f}, lane_);
            const int n = sub * 16 + g4;
            int y = y_; asm volatile("" : "+v"(y));
            if (tile < 4) { a = a * C2; v2u w; w.x = cvt_pk_bf16(a[0], a[1]); w.y = cvt_pk_bf16(a[2], a[3]); *(v2u*)(WSP(bf16, WS_QO) + (size_t)(MR + y) * ATTW + tile * 256 + n) = w; }
            else if (tile < 12) { v2u w; w.x = cvt_pk_bf16(a[0], a[1]); w.y = cvt_pk_bf16(a[2], a[3]); bf16* KV = (tile < 8) ? WSP(bf16, WS_KB) : WSP(bf16, WS_VB);
                bf16* kp = KV + (size_t)(48 + y) * ATTW + (tile & 3) * 256 + n;
_Pragma("unroll 1")
                for (int bb = 0; bb < NB; ++bb) { *(v2u*)kp = w; kp += (size_t)KSEQ * ATTW; } }
            else { v2u w; w.x = cvt_pk_bf16(sigmoidf_fast(a[0]), sigmoidf_fast(a[1])); w.y = cvt_pk_bf16(sigmoidf_fast(a[2]), sigmoidf_fast(a[3]));
                bf16* SG = (tile < 28) ? WSP(bf16, WS_SGA) : WSP(bf16, WS_SGC); *(v2u*)(SG + (size_t)(MR + y) * DM + ((tile - 20) & 7) * 256 + n) = w; }
        }
    }
}

struct GridSched {
    pg8::GridOrder go; const char* A; const char* B; size_t tstep;
    __device__ __forceinline__ bool next(int i, pg8::Unit& u) const { u.aux = 0; return go.tile(i, u.pm, u.pn); }
    __device__ __forceinline__ const char* opA(const pg8::Unit& u) const { return A + (size_t)u.pm * tstep; }
    __device__ __forceinline__ const char* opB(const pg8::Unit& u) const { return B + (size_t)u.pn * tstep; }
};
struct DualSched {
    pg8::GridOrder go; const char *A0, *B0, *A1, *B1; size_t tstep;
    __device__ __forceinline__ bool next(int i, pg8::Unit& u) const { u.aux = i & 1; return go.tile(i >> 1, u.pm, u.pn); }
    __device__ __forceinline__ const char* opA(const pg8::Unit& u) const { return (u.aux ? A1 : A0) + (size_t)u.pm * tstep; }
    __device__ __forceinline__ const char* opB(const pg8::Unit& u) const { return (u.aux ? B1 : B0) + (size_t)u.pn * tstep; }
};
struct MoeSched {
    const LAS int* tb; int npn, G, c; const char* A; const char* W; size_t a_tstep, w_estride, w_tstep;
    __device__ __forceinline__ bool next(int i, pg8::Unit& u) const {
        const int L = i * G + c, T = L / npn; if (T >= tb[32]) return false;
        int e = 0;
#pragma unroll 1
        for (int q = 1; q < 32; ++q) e += (tb[q] <= T) ? 1 : 0;
        u.pm = T; u.pn = L - T * npn; u.aux = e; return true; }
    __device__ __forceinline__ const char* opA(const pg8::Unit& u) const { return A + (size_t)u.pm * a_tstep; }
    __device__ __forceinline__ const char* opB(const pg8::Unit& u) const { return W + (size_t)u.aux * w_estride + (size_t)u.pn * w_tstep; }
};
typedef f32x4 Acc[2][2][4][2];
__device__ __forceinline__ v4u pack8(const f32x4 a, const f32x4 b) { v4u w; w.x = cvt_pk_bf16(a[0], a[1]); w.y = cvt_pk_bf16(a[2], a[3]); w.z = cvt_pk_bf16(b[0], b[1]); w.w = cvt_pk_bf16(b[2], b[3]); return w; }
__device__ __forceinline__ f32x4 sig4(const f32x4 a) { return (f32x4){sigmoidf_fast(a[0]), sigmoidf_fast(a[1]), sigmoidf_fast(a[2]), sigmoidf_fast(a[3])}; }
struct EpiIn {
    static constexpr bool PERM = true;
    bf16 *Q, *KB, *VB, *ZG, *SGA, *SGC;
    __device__ __forceinline__ bool keep(const pg8::Unit&) const { return false; }
    __device__ __forceinline__ void operator()(Acc& acc, const pg8::Unit& u, int wr, int wc, int fr, int fq) const {
        const int pn = u.pn, m0 = u.pm * 256, b = m0 >> 11, rl = wr * 64 + fr, cw = wc * 32 + 8 * fq;
        if (pn < 12) {
            const int which = pn >> 2; bf16* base; size_t row0; float sc = 1.f;
            if (which == 0) { base = Q; row0 = (size_t)m0; sc = C2; } else { base = (which == 1) ? KB : VB; row0 = (size_t)m0 + 64 * (b + 1); }
            base += (pn & 3) * 256 + cw;
#pragma unroll
            for (int ai = 0; ai < 2; ++ai)
#pragma unroll
                for (int m = 0; m < 4; ++m) { bf16* rowp = base + (row0 + rl + ai * 128 + m * 16) * ATTW;
#pragma unroll
                    for (int bj = 0; bj < 2; ++bj) *(GAS v4u*)(rowp + bj * 128) = pack8(acc[ai][bj][m][0] * sc, acc[ai][bj][m][1] * sc); }
        } else if (pn < 20) {
            bf16* base = ZG + (pn - 12) * 128 + cw; const size_t row0 = (size_t)m0 + 16 * (b + 1);
#pragma unroll
            for (int ai = 0; ai < 2; ++ai)
#pragma unroll
                for (int m = 0; m < 4; ++m) { bf16* rowp = base + (row0 + rl + ai * 128 + m * 16) * CONVC;
                    *(GAS v4u*)rowp = pack8(acc[ai][0][m][0] * sig4(acc[ai][1][m][0]), acc[ai][0][m][1] * sig4(acc[ai][1][m][1])); }
        } else {
            bf16* base = ((pn < 28) ? SGA : SGC) + ((pn - 20) & 7) * 256 + cw;
#pragma unroll
            for (int ai = 0; ai < 2; ++ai)
#pragma unroll
                for (int m = 0; m < 4; ++m) { bf16* rowp = base + (size_t)(m0 + rl + ai * 128 + m * 16) * DM;
#pragma unroll
                    for (int bj = 0; bj < 2; ++bj) *(GAS v4u*)(rowp + bj * 128) = pack8(sig4(acc[ai][bj][m][0]), sig4(acc[ai][bj][m][1])); }
        }
    }
};
struct EpiDual {
    static constexpr bool PERM = true;
    const bf16 *SGA, *SGC; bf16* MG;
    __device__ __forceinline__ bool keep(const pg8::Unit& u) const { return u.aux == 0; }
    __device__ __forceinline__ void operator()(Acc& acc, const pg8::Unit& u, int wr, int wc, int fr, int fq) const {
        const size_t off0 = (size_t)(u.pm * 256 + wr * 64 + fr) * DM + u.pn * 256 + wc * 32 + 8 * fq;
#pragma unroll
        for (int ai = 0; ai < 2; ++ai)
#pragma unroll
            for (int m = 0; m < 4; ++m)
#pragma unroll
                for (int bj = 0; bj < 2; ++bj) { const size_t off = off0 + (size_t)(ai * 128 + m * 16) * DM + bj * 128;
                    const v4u c = *(const GAS v4u*)(SGC + off);
                    const f32x4 c0 = {bf_lo(c.x), bf_hi(c.x), bf_lo(c.y), bf_hi(c.y)}, c1 = {bf_lo(c.z), bf_hi(c.z), bf_lo(c.w), bf_hi(c.w)};
                    if (u.aux == 0) { const v4u a = *(const GAS v4u*)(SGA + off);
                        const f32x4 a0 = {bf_lo(a.x), bf_hi(a.x), bf_lo(a.y), bf_hi(a.y)}, a1 = {bf_lo(a.z), bf_hi(a.z), bf_lo(a.w), bf_hi(a.w)};
#pragma unroll
                        for (int q = 0; q < 4; ++q) { acc[ai][bj][m][0][q] *= a0[q] * __builtin_amdgcn_rcpf(c0[q]); acc[ai][bj][m][1][q] *= a1[q] * __builtin_amdgcn_rcpf(c1[q]); }
                    } else *(GAS v4u*)(MG + off) = pack8(acc[ai][bj][m][0] * c0, acc[ai][bj][m][1] * c1);
                }
    }
};
struct EpiRes {
    static constexpr bool PERM = false;
    const float* base; float* out;
    __device__ __forceinline__ bool keep(const pg8::Unit&) const { return false; }
    __device__ __forceinline__ void operator()(Acc& acc, const pg8::Unit& u, int wr, int wc, int fr, int fq) const {
        const size_t off0 = (size_t)(u.pm * 256 + wr * 64 + fr) * DM + u.pn * 256 + wc * 32 + 4 * fq;
#pragma unroll
        for (int ai = 0; ai < 2; ++ai)
#pragma unroll
            for (int m = 0; m < 4; ++m)
#pragma unroll
                for (int bj = 0; bj < 2; ++bj)
#pragma unroll
                    for (int n = 0; n < 2; ++n) { const size_t off = off0 + (size_t)(ai * 128 + m * 16) * DM + bj * 128 + n * 16;
                        *(GAS f32x4*)(out + off) = *(const GAS f32x4*)(base + off) + acc[ai][bj][m][n]; }
    }
};
struct EpiGlu {
    static constexpr bool PERM = true;
    bf16* H;
    __device__ __forceinline__ bool keep(const pg8::Unit&) const { return false; }
    __device__ __forceinline__ void operator()(Acc& acc, const pg8::Unit& u, int wr, int wc, int fr, int fq) const {
        bf16* base = H + (size_t)(u.pm * 256 + wr * 64 + fr) * DE + u.pn * 128 + wc * 32 + 8 * fq;
#pragma unroll
        for (int ai = 0; ai < 2; ++ai)
#pragma unroll
            for (int m = 0; m < 4; ++m) { const f32x4 g0 = acc[ai][0][m][0], g1 = acc[ai][0][m][1];
                *(GAS v4u*)(base + (size_t)(ai * 128 + m * 16) * DE) = pack8(g0 * sig4(g0) * acc[ai][1][m][0], g1 * sig4(g1) * acc[ai][1][m][1]); }
    }
};
struct EpiDown {
    static constexpr bool PERM = true;
    const LAS int* tb; const LAS int* cn; const int* perm; const float* wts; bf16 *Y0, *Y1;
    __device__ __forceinline__ bool keep(const pg8::Unit&) const { return false; }
    __device__ __forceinline__ void operator()(Acc& acc, const pg8::Unit& u, int wr, int wc, int fr, int fq) const {
        const int e = u.aux, r0 = (u.pm - tb[e]) * 256 + wr * 64 + fr, cnt = cn[e], col = u.pn * 256 + wc * 32 + 8 * fq;
#pragma unroll
        for (int ai = 0; ai < 2; ++ai)
#pragma unroll
            for (int m = 0; m < 4; ++m) { const int r = r0 + ai * 128 + m * 16;
                if (r < cnt) { const int id = perm[(size_t)e * PCAP + r]; const float w = wts[id]; bf16* rowp = ((id & 1) ? Y1 : Y0) + (size_t)(id >> 1) * DM + col;
#pragma unroll
                    for (int bj = 0; bj < 2; ++bj) *(GAS v4u*)(rowp + bj * 128) = pack8(acc[ai][bj][m][0] * w, acc[ai][bj][m][1] * w); } }
    }
};

__device__ __forceinline__ void cum_table(Frame& F, int bh) {
    int tid_ = F.tid; asm volatile("" : "+v"(tid_)); const int lane = tid_ & 63, wave = __builtin_amdgcn_readfirstlane(tid_ >> 6);
    LAS float* cs = (LAS float*)(F.lds + RING_OFF + attn_body::LDS_CS); LAS float* tot = (LAS float*)(F.lds + RING_OFF + attn_body::LDS_TOT);
    const GAS float* lf = (const GAS float*)WSP(float, WS_LOGF) + (size_t)bh * KSEQ;
    constexpr int NCH = KSEQ / 64;
    for (int c = wave; c < NCH; c += NWAVES) { const int row = 64 * c + lane; float v = (row >= 48) ? lf[row] : 0.f;
#pragma unroll
        for (int o = 1; o < 64; o <<= 1) { const float t = shfl_idx(v, lane - o); if (lane >= o) v += t; }
        cs[row] = v; if (lane == 63) tot[c] = v; }
    LDS_WAIT(); __syncthreads();
    float tv = (lane < NCH) ? tot[lane] : 0.f, inc = tv;
#pragma unroll
    for (int o = 1; o < 64; o <<= 1) { const float t = shfl_idx(inc, lane - o); if (lane >= o) inc += t; }
    const float exc = inc - tv;
    for (int c = wave; c < NCH; c += NWAVES) { const int row = 64 * c + lane; const float off = __int_as_float(__builtin_amdgcn_readlane(__float_as_int(exc), c));
        cs[row] = (row >= 48) ? cs[row] + off : INFINITY; }
    LDS_WAIT(); __syncthreads();
}
__device__ __forceinline__ void meta_attn_head(Frame& F, int h) {
    OPAQUE_IDS();
    const bf16* Qm = WSP(bf16, WS_QO) + (size_t)MR * ATTW + h * HD; const bf16* Km = WSP(bf16, WS_KB) + (size_t)48 * ATTW + h * HD; const bf16* Vm = WSP(bf16, WS_VB) + (size_t)48 * ATTW + h * HD;
    const float* lf = WSP(float, WS_LOGF) + (size_t)h * KSEQ + 48;
    const int i = lane_ & 15, qd = (lane_ >> 4) * 16;
    float q[16];
#pragma unroll
    for (int d = 0; d < 16; ++d) q[d] = bf_lo((unsigned)Qm[(size_t)i * ATTW + qd + d]);
    float cum[16]; { float c = 0.f;
#pragma unroll
        for (int j = 0; j < 16; ++j) { c += lf[j]; cum[j] = c; } }
    float ci = 0.f;
#pragma unroll
    for (int j = 0; j < 16; ++j) ci = (j == i) ? cum[j] : ci;
    float s[16], mx = -INFINITY;
#pragma unroll
    for (int j = 0; j < 16; ++j) { float p = 0.f;
#pragma unroll
        for (int d = 0; d < 16; ++d) p += q[d] * bf_lo((unsigned)Km[(size_t)j * ATTW + qd + d]);
        p += swz_xor<16>(p); p = xor32_sum(p);
        s[j] = (j <= i) ? p + ci - cum[j] : -INFINITY; mx = fmaxf(mx, s[j]); }
    float den = 0.f, o[16];
#pragma unroll
    for (int d = 0; d < 16; ++d) o[d] = 0.f;
#pragma unroll
    for (int j = 0; j < 16; ++j) { const float p = __builtin_amdgcn_exp2f(s[j] - mx); den += p;
#pragma unroll
        for (int d = 0; d < 16; ++d) o[d] += p * bf_lo((unsigned)Vm[(size_t)j * ATTW + qd + d]); }
    const float inv = 1.0f / den;
    bf16* Om = WSP(bf16, WS_QO) + (size_t)(MR + i) * ATTW + h * HD + qd;
#pragma unroll
    for (int d = 0; d < 16; d += 2) *(unsigned*)(Om + d) = cvt_pk_bf16(o[d] * inv, o[d + 1] * inv);
}
__device__ __forceinline__ void conv_item(Frame& F, int l, int b, int p0, int out_row0) {
    int tid_ = F.tid; asm volatile("" : "+v"(tid_));
    const int c2 = tid_ * 2;
    const float* cw = F.in[6] + (size_t)l * CONVK * CONVC; const float cb0 = F.in[7][l * CONVC + c2], cb1 = F.in[7][l * CONVC + c2 + 1];
    LAS float* zb = (LAS float*)(F.lds + RING_OFF);
    f32x2 w[CONVK];
#pragma unroll
    for (int j = 0; j < CONVK; ++j) w[j] = *(const GAS f32x2*)(cw + (size_t)j * CONVC + c2);
    LAS unsigned char* win = F.lds + RING_OFF;
    { const GAS char* zsrc = (const GAS char*)WSP(bf16, WS_ZG) + ((size_t)b * ZSEQ + p0 - 30) * (CONVC * 2);
#pragma unroll
      for (int k = 0; k < 12; ++k) { const int q = tid_ + 512 * k; if (q < 46 * 128) { v4u v = {0u, 0u, 0u, 0u}; if (p0 - 30 + (q >> 7) >= 0) v = *(const GAS v4u*)(zsrc + (size_t)q * 16); *(LAS v4u*)(win + q * 16) = v; } } }
    LDS_WAIT(); __syncthreads();
    f32x2 a[16];
#pragma unroll
    for (int o = 0; o < 16; ++o) a[o] = (f32x2){cb0, cb1};
#pragma unroll
    for (int i = 0; i < 46; ++i) { const unsigned u = *(const LAS unsigned*)(win + i * (CONVC * 2) + tid_ * 4);
        const f32x2 x = {bf_lo(u), bf_hi(u)};
#pragma unroll
        for (int o = 0; o < 16; ++o) if (i - o >= 0 && i - o < CONVK) a[o] += w[i - o] * x; }
    LDS_WAIT(); __syncthreads();
#pragma unroll
    for (int o = 0; o < 16; ++o) *(LAS f32x2*)(zb + o * CONVC + c2) = a[o];
    LDS_WAIT(); __syncthreads();
    const int ln = tid_ & 63, wv_ = tid_ >> 6;
    const float* lg = F.in[8] + (size_t)l * CONVC; const float* lb = F.in[9] + (size_t)l * CONVC;
#pragma unroll
    for (int rr = 0; rr < 2; ++rr) { const int o = wv_ * 2 + rr;
        f32x4 v[4]; float s = 0.f;
#pragma unroll
        for (int j = 0; j < 4; ++j) { v[j] = *(const LAS f32x4*)(zb + o * CONVC + 4 * (ln + 64 * j)); s += (v[j].x + v[j].y) + (v[j].z + v[j].w); }
        const float mu = wave_sum(s) * (1.0f / CONVC); float q = 0.f;
#pragma unroll
        for (int j = 0; j < 4; ++j) { v[j] = v[j] - mu; q += (v[j].x * v[j].x + v[j].y * v[j].y) + (v[j].z * v[j].z + v[j].w * v[j].w); }
        const float rstd = 1.0f / sqrtf(wave_sum(q) * (1.0f / CONVC) + LN_EPS);
        bf16* op = WSP(bf16, WS_CV) + (size_t)(out_row0 + o) * CONVC;
#pragma unroll
        for (int j = 0; j < 4; ++j) { const int c = 4 * (ln + 64 * j); const f32x4 gg = *(const GAS f32x4*)(lg + c), bb = *(const GAS f32x4*)(lb + c);
            f32x4 z = v[j] * rstd * gg + bb; z = z * sig4(z); v2u wv; wv.x = cvt_pk_bf16(z.x, z.y); wv.y = cvt_pk_bf16(z.z, z.w); *(GAS v2u*)(op + c) = wv; } }
    __syncthreads();
}
__device__ __forceinline__ void pc_phase(Frame& F, int l, char* ldsg) {
    for (int v = F.vcu; v < 2 * NB * NH; v += F.G) {
        const int bh = v >> 1, s0 = 2 * (v & 1);
        cum_table(F, bh);
        const __hip_bfloat16* Q = (const __hip_bfloat16*)WSP(bf16, WS_QO); const __hip_bfloat16* K = (const __hip_bfloat16*)WSP(bf16, WS_KB); const __hip_bfloat16* V = (const __hip_bfloat16*)WSP(bf16, WS_VB);
#pragma unroll 1
        for (int i = 0; i < 4; ++i) { const int qb = (i == 0) ? s0 : (i == 1) ? 7 - s0 : (i == 2) ? s0 + 1 : 6 - s0;
#ifndef NO_ATTN
            attn_body::attn_unit<8>(bh / NH, bh % NH, qb, Q, K, V, (__hip_bfloat16*)WSP(bf16, WS_QO), ldsg + RING_OFF);
#endif
        }
        __syncthreads();
    }
#ifndef NO_MATTN
    if (F.vcu >= F.G - 2) meta_attn_head(F, (F.vcu - (F.G - 2)) * 8 + F.wave);
#endif
    __syncthreads();
#ifndef NO_CONV
    for (int it = F.vcu; it < MR / 16 + 1; it += F.G) {
        const bool real = it < MR / 16; const int b = real ? it >> 7 : 0, t0 = (it & 127) * 16;
        conv_item(F, l, b, real ? NMETA + t0 : 0, real ? b * SEQ + t0 : MR);
    }
#endif
}
__device__ __forceinline__ void pd_side(Frame& F, int l) {
    OPAQUE_IDS();
    const int j = F.NGW - 1 - F.gw; if (j >= DM / 16) return;
    const unsigned char* wl = F.ws + WS_W + (size_t)l * W_LSTRIDE; const int g4 = (lane_ >> 4) * 4, y = lane_ & 15;
    const f32x4 a1 = mm16((const bf16*)(wl + WO_AO) + (size_t)j * 16 * ATTW, ATTW, WSP(bf16, WS_QO) + (size_t)MR * ATTW, ATTW, ATTW, (f32x4){0.f, 0.f, 0.f, 0.f}, lane_);
    const f32x4 a2 = mm16((const bf16*)(wl + WO_CO) + (size_t)j * 16 * CONVC, CONVC, WSP(bf16, WS_CV) + (size_t)MR * CONVC, CONVC, CONVC, (f32x4){0.f, 0.f, 0.f, 0.f}, lane_);
    const size_t off = (size_t)(MR + y) * DM + j * 16 + g4;
    const v2u ga = *(const GAS v2u*)(WSP(bf16, WS_SGA) + off), gc = *(const GAS v2u*)(WSP(bf16, WS_SGC) + off);
    v2u w; w.x = cvt_pk_bf16(bf_lo(ga.x) * a1[0] + bf_lo(gc.x) * a2[0], bf_hi(ga.x) * a1[1] + bf_hi(gc.x) * a2[1]);
    w.y = cvt_pk_bf16(bf_lo(ga.y) * a1[2] + bf_lo(gc.y) * a2[2], bf_hi(ga.y) * a1[3] + bf_hi(gc.y) * a2[3]);
    *(GAS v2u*)(WSP(bf16, WS_MG) + off) = w;
}
__device__ __forceinline__ void pe_side(Frame& F, int l) {
    OPAQUE_IDS();
    const int j = F.NGW - 1 - F.gw; if (j >= DM / 16) return;
    const unsigned char* wl = F.ws + WS_W + (size_t)l * W_LSTRIDE; const int g4 = (lane_ >> 4) * 4, y = lane_ & 15;
    const f32x4 a = mm16((const bf16*)(wl + WO_O) + (size_t)j * 16 * DM, DM, WSP(bf16, WS_MG) + (size_t)MR * DM, DM, DM, (f32x4){0.f, 0.f, 0.f, 0.f}, lane_);
    const float* base = (l == 0) ? F.in[1] + (size_t)y * DM + j * 16 + g4 : WSP(float, WS_RES) + (size_t)(MR + y) * DM + j * 16 + g4;
    const f32x4 bv = *(const GAS f32x4*)base;
    *(GAS f32x4*)(WSP(float, WS_RES) + (size_t)(MR + y) * DM + j * 16 + g4) = bv + a;
}
__device__ __forceinline__ void pg_router(Frame& F, int l) {
    OPAQUE_IDS();
    if (F.gw >= MT / 16) return;
    const int rb = F.gw, g4 = (lane_ >> 4) * 4, y = lane_ & 15;
    LAS float* scr = (LAS float*)(F.lds + RING_OFF) + wave_ * (16 * 49);
    const bf16* Yp = WSP(bf16, WS_N2) + (size_t)rb * 16 * DM; const bf16* WrT = WSP(bf16, WS_WR) + (size_t)l * 48 * DM;
#pragma unroll
    for (int blk = 0; blk < 3; ++blk) { const f32x4 a = mm16(WrT + (size_t)blk * 16 * DM, DM, Yp, DM, DM, (f32x4){0.f, 0.f, 0.f, 0.f}, lane_);
#pragma unroll
        for (int r = 0; r < 4; ++r) scr[y * 49 + blk * 16 + g4 + r] = a[r]; }
    LDS_WAIT(); asm volatile("" ::: "memory");
    if (lane_ < 16) {
        const LAS float* lg = scr + lane_ * 49; const int m = rb * 16 + lane_;
        float gl[NGRP]; int gi = 0;
#pragma unroll
        for (int g = 0; g < NGRP; ++g) gl[g] = lg[g] + F.in[14][l * NGRP + g];
#pragma unroll
        for (int g = 1; g < NGRP; ++g) if (gl[g] > gl[gi]) gi = g;
        float gmax = gl[0];
#pragma unroll
        for (int g = 1; g < NGRP; ++g) gmax = fmaxf(gmax, gl[g]);
        float den = 0.f;
#pragma unroll
        for (int g = 0; g < NGRP; ++g) den += expf(gl[g] - gmax);
        const float gw = 1.0f / den;
        float ev[EPG];
#pragma unroll
        for (int i = 0; i < EPG; ++i) ev[i] = lg[NGRP + gi * EPG + i] + F.in[16][l * NE + gi * EPG + i];
        int i0 = 0;
#pragma unroll
        for (int i = 1; i < EPG; ++i) if (ev[i] > ev[i0]) i0 = i;
        float v0 = ev[0];
#pragma unroll
        for (int i = 1; i < EPG; ++i) v0 = fmaxf(v0, ev[i]);
        int i1 = (i0 == 0) ? 1 : 0; float v1 = -INFINITY;
#pragma unroll
        for (int i = 0; i < EPG; ++i) if (i != i0 && ev[i] > v1) { v1 = ev[i]; i1 = i; }
        const float w0 = gw / (1.0f + expf(v1 - v0)), w1 = gw - w0;
        unsigned* cnt = (unsigned*)(F.ctl + CW_CNT + l * 64); int* perm = WSP(int, WS_PERM); float* wts = WSP(float, WS_WTS);
        const int e0 = gi * EPG + i0, e1 = gi * EPG + i1;
        const unsigned q0 = __hip_atomic_fetch_add(cnt + e0, 1u, RLX_AGENT), q1 = __hip_atomic_fetch_add(cnt + e1, 1u, RLX_AGENT);
        perm[(size_t)e0 * PCAP + q0] = 2 * m; perm[(size_t)e1 * PCAP + q1] = 2 * m + 1; wts[2 * m] = w0; wts[2 * m + 1] = w1;
    }
}
__device__ __forceinline__ void moe_tables(Frame& F, int l) {
    OPAQUE_IDS();
    LAS int* tb = (LAS int*)(F.lds + TAB_OFF); LAS int* cn = tb + 40;
    if (wave_ == 0) { const int c = (lane_ < NE) ? (int)__hip_atomic_load((unsigned*)(F.ctl + CW_CNT + l * 64 + lane_), RLX_AGENT) : 0; int nt = (c + 255) >> 8, inc = nt;
#pragma unroll
        for (int o = 1; o < 64; o <<= 1) { const int t = shfl_idx_i(inc, lane_ - o); if (lane_ >= o) inc += t; }
        if (lane_ < NE) { tb[lane_] = inc - nt; cn[lane_] = c; } if (lane_ == NE) tb[NE] = inc; }
    LDS_WAIT(); __syncthreads();
}
__device__ __forceinline__ void ph0_gather(Frame& F) {
    OPAQUE_IDS();
    const LAS int* tb = (const LAS int*)(F.lds + TAB_OFF); const LAS int* cn = tb + 40;
    const int nrows = tb[NE] * 256; const int* perm = WSP(int, WS_PERM);
    for (int row = F.gw; row < nrows; row += F.NGW) {
        const int T = row >> 8; int e = 0;
#pragma unroll 1
        for (int q = 1; q < NE; ++q) e += (tb[q] <= T) ? 1 : 0;
        const int r = row - tb[e] * 256;
        GAS v4u* dp = (GAS v4u*)(WSP(bf16, WS_XS) + (size_t)row * DM) + lane_;
        if (r < cn[e]) { const int tok = perm[(size_t)e * PCAP + r] >> 1; const GAS v4u* sp = (const GAS v4u*)(WSP(bf16, WS_N2) + (size_t)tok * DM) + lane_;
#pragma unroll
            for (int j = 0; j < 4; ++j) dp[64 * j] = sp[64 * j];
        } else {
#pragma unroll
            for (int j = 0; j < 4; ++j) dp[64 * j] = (v4u){0u, 0u, 0u, 0u}; }
    }
}

struct Args { const float* in[20]; float* out; unsigned char* ws; int ph_lo, ph_hi; };
constexpr int N_PHASES = 22;
__global__ void __launch_bounds__(NWAVES * 64, 2) fox_fwd(Args args) {
    extern __shared__ __attribute__((aligned(16))) unsigned char lds[];
    Frame F;
    F.lds = (LAS unsigned char*)lds; F.MISC = (volatile LAS unsigned*)(F.lds + MISC_OFF);
    F.tid = threadIdx.x; F.lane = F.tid & 63; F.wave = __builtin_amdgcn_readfirstlane(F.tid >> 6);
    F.G = gridDim.x; { const int bx = blockIdx.x; F.vcu = (F.G % 8 == 0) ? (bx % 8) * (F.G / 8) + bx / 8 : bx; }
    F.gw = F.vcu * NWAVES + F.wave; F.NGW = F.G * NWAVES;
    F.ws = args.ws; F.in = args.in; F.ctl = (gu32*)(args.ws + WS_CTL);
    for (int u = F.tid; u < (LDS_BYTES - MISC_OFF) / 4; u += NWAVES * 64) ((LAS unsigned*)(F.lds + MISC_OFF))[u] = 0u;
    __syncthreads();
    const int lo = args.ph_lo, hi = args.ph_hi;
    const bool one_launch = (hi - lo) > 1;
    XcdBarrier bar; bar.bar = (unsigned*)(F.ctl + CW_BAR); bar.x = 0; bar.st = nullptr;
    if (one_launch) bar = xcd_barrier_post((unsigned*)(F.ctl + CW_BAR), F.MISC + 8);
#ifndef PH_MASK
#define PH_MASK 0xffffffffu
#endif
#define IN(k) (((PH_MASK >> ((k) > 10 ? (k) - 10 : (k))) & 1u) && lo <= (k) && (k) < hi)
#define SEAM(k) do { if (IN(k) && IN((k) + 1)) xcd_barrier(bar); } while (0)
    LAS unsigned char* ring = F.lds + RING_OFF;
    const int bx = (int)blockIdx.x;

    if (IN(0)) { p0_convert(F); norm_phase<0>(F, F.in[2], WSP(bf16, WS_XN), nullptr); }
    SEAM(0);
#pragma unroll 1
    for (int l = 0; l < DEPTH; ++l) {
        const int P = 1 + 10 * l;
        const unsigned char* wl = F.ws + WS_W + (size_t)l * W_LSTRIDE;
        if (l > 0) { if (IN(P)) norm_phase<1>(F, F.in[2] + (size_t)l * DM, WSP(bf16, WS_XN), nullptr); SEAM(P); }
        if (IN(P + 1)) {
#ifndef NO_PBSIDE
            pb_side(F, l); VM_WAIT(); __syncthreads();
#endif
            GridSched S; S.go.init(MR / 256, 36, F.G, bx); S.A = (const char*)WSP(bf16, WS_XN); S.B = (const char*)(wl + WO_IN); S.tstep = (size_t)256 * DM * 2;
            EpiIn E{WSP(bf16, WS_QO), WSP(bf16, WS_KB), WSP(bf16, WS_VB), WSP(bf16, WS_ZG), WSP(bf16, WS_SGA), WSP(bf16, WS_SGC)};
#ifndef NO_PBGEMM
            pg8::gemm_phase<EpiIn, GridSched, true>(ring, DM, S, E);
#endif
        }
        SEAM(P + 1);
        if (IN(P + 2)) pc_phase(F, l, (char*)lds);
        SEAM(P + 2);
        if (IN(P + 3)) {
            pd_side(F, l); VM_WAIT(); __syncthreads();
            DualSched S; S.go.init(MR / 256, DM / 256, F.G, bx); S.A0 = (const char*)WSP(bf16, WS_QO); S.B0 = (const char*)(wl + WO_AO); S.A1 = (const char*)WSP(bf16, WS_CV); S.B1 = (const char*)(wl + WO_CO); S.tstep = (size_t)256 * ATTW * 2;
            EpiDual E{WSP(bf16, WS_SGA), WSP(bf16, WS_SGC), WSP(bf16, WS_MG)};
            pg8::gemm_phase<EpiDual, DualSched, true>(ring, ATTW, S, E);
        }
        SEAM(P + 3);
        if (IN(P + 4)) {
            pe_side(F, l); VM_WAIT(); __syncthreads();
            GridSched S; S.go.init(MR / 256, DM / 256, F.G, bx); S.A = (const char*)WSP(bf16, WS_MG); S.B = (const char*)(wl + WO_O); S.tstep = (size_t)256 * DM * 2;
            EpiRes E{(l == 0) ? F.in[0] : WSP(float, WS_RES), WSP(float, WS_RES)};
            pg8::gemm_phase<EpiRes, GridSched, true>(ring, DM, S, E);
        }
        SEAM(P + 4);
        if (IN(P + 5)) norm_phase<2>(F, F.in[12] + (size_t)l * DM, WSP(bf16, WS_N2), nullptr);
        SEAM(P + 5);
        if (IN(P + 6)) pg_router(F, l);
        SEAM(P + 6);
        if (IN(P + 7)) { moe_tables(F, l); ph0_gather(F); }
        SEAM(P + 7);
        if (IN(P + 8)) {
            moe_tables(F, l);
            MoeSched S; S.tb = (const LAS int*)(F.lds + TAB_OFF); S.npn = DE / 128; S.G = F.G; S.c = bx; S.A = (const char*)WSP(bf16, WS_XS); S.W = (const char*)(wl + WO_GU);
            S.a_tstep = (size_t)256 * DM * 2; S.w_estride = (size_t)(2 * DE) * DM * 2; S.w_tstep = (size_t)256 * DM * 2;
            EpiGlu E{WSP(bf16, WS_H)};
            pg8::gemm_phase<EpiGlu, MoeSched, true>(ring, DM, S, E);
        }
        SEAM(P + 8);
        if (IN(P + 9)) {
            moe_tables(F, l);
            MoeSched S; S.tb = (const LAS int*)(F.lds + TAB_OFF); S.npn = DM / 256; S.G = F.G; S.c = bx; S.A = (const char*)WSP(bf16, WS_H); S.W = (const char*)(wl + WO_DN);
            S.a_tstep = (size_t)256 * DE * 2; S.w_estride = (size_t)DM * DE * 2; S.w_tstep = (size_t)256 * DE * 2;
            EpiDown E{(const LAS int*)(F.lds + TAB_OFF), (const LAS int*)(F.lds + TAB_OFF) + 40, WSP(int, WS_PERM), WSP(float, WS_WTS), WSP(bf16, WS_Y0), WSP(bf16, WS_Y1)};
            pg8::gemm_phase<EpiDown, MoeSched, true>(ring, DE, S, E);
        }
        SEAM(P + 9);
    }
#if DBG_DUMP == 0
    if (IN(21)) norm_phase<3>(F, F.in[19], nullptr, args.out);
#else
    if (IN(21)) {
        for (size_t i = (size_t)blockIdx.x * 512 + threadIdx.x; i < (size_t)MR * DM; i += (size_t)gridDim.x * 512) { const size_t m = i / DM, c = i % DM; float v = 0.f;
            if (DBG_DUMP == 1) v = WSP(float, WS_RES)[i];
            else if (DBG_DUMP == 2) v = bf_lo(WSP(bf16, WS_Y0)[i]) + bf_lo(WSP(bf16, WS_Y1)[i]);
            else if (DBG_DUMP == 3) v = bf_lo(WSP(bf16, WS_MG)[i]);
            else if (DBG_DUMP == 4) v = (c < 1024) ? bf_lo(WSP(bf16, WS_QO)[m * 1024 + c]) : bf_lo(WSP(bf16, WS_CV)[m * 1024 + c - 1024]);
            else if (DBG_DUMP == 5) v = bf_lo(WSP(bf16, WS_XN)[i]);
            else if (DBG_DUMP == 6) v = bf_lo(WSP(bf16, WS_SGA)[i]) + bf_lo(WSP(bf16, WS_SGC)[i]);
            else if (DBG_DUMP == 7) v = bf_lo(WSP(bf16, WS_N2)[i]);
            else if (DBG_DUMP == 8) { const size_t b = m >> 11, t = m & 2047; v = (c < 1024) ? bf_lo(WSP(bf16, WS_KB)[(b * KSEQ + 64 + t) * 1024 + c]) : bf_lo(WSP(bf16, WS_ZG)[(b * ZSEQ + 16 + t) * 1024 + c - 1024]); }
            args.out[i] = v; }
    }
#endif
#undef IN
#undef SEAM
}

extern "C" void kernel_launch(void* const* d_in, const int* in_sizes, int n_in, void* d_out, int out_size, void* d_ws, size_t ws_size, hipStream_t stream) {
    static int grid = 0;
    if (grid == 0) {
        if (n_in != 20 || out_size != MR * DM || ws_size < WS_END) { fprintf(stderr, "kernel_launch: unexpected problem (n_in %d, out %d, ws %zu); nothing launched\n", n_in, out_size, ws_size); grid = -1; return; }
        int dev = 0, cus = 0, per_cu = 0;
        if (hipGetDevice(&dev) != hipSuccess || hipDeviceGetAttribute(&cus, hipDeviceAttributeMultiprocessorCount, dev) != hipSuccess) { grid = -1; return; }
        if (hipFuncSetAttribute((const void*)fox_fwd, hipFuncAttributeMaxDynamicSharedMemorySize, LDS_BYTES) != hipSuccess) { fprintf(stderr, "kernel_launch: hipFuncSetAttribute failed\n"); grid = -1; return; }
        if (hipOccupancyMaxActiveBlocksPerMultiprocessor(&per_cu, (const void*)fox_fwd, NWAVES * 64, LDS_BYTES) != hipSuccess || per_cu < 1) { fprintf(stderr, "kernel_launch: occupancy query says %d\n", per_cu); }
        (void)hipGetLastError();
        grid = cus;
    }
    if (grid < 0) return;
    if (hipMemsetAsync((char*)d_ws + WS_CTL, 0, CTL_ZERO_BYTES, stream) != hipSuccess) return;
    Args a{};
    for (int i = 0; i < 20; ++i) a.in[i] = (const float*)d_in[i];
    a.out = (float*)d_out; a.ws = (unsigned char*)d_ws;
#if MK_N_LAUNCHES == 1
    a.ph_lo = 0; a.ph_hi = N_PHASES;
    hipLaunchKernelGGL(fox_fwd, dim3(grid), dim3(NWAVES * 64), LDS_BYTES, stream, a);
#else
    for (int p = 0; p < N_PHASES; ++p) { if (p == 1 || (p > DBG_STOP && p != N_PHASES - 1)) continue; a.ph_lo = p; a.ph_hi = p + 1; hipLaunchKernelGGL(fox_fwd, dim3(grid), dim3(NWAVES * 64), LDS_BYTES, stream, a); }
#endif
}
```

```cpp
#include <hip/hip_runtime.h>
#include <hip/hip_bf16.h>
#include <cstdio>
#include <cstdint>
#include <cmath>

#ifndef MK_N_LAUNCHES
#define MK_N_LAUNCHES 1
#endif

#ifndef DBG_DUMP
#define DBG_DUMP 0
#endif
#ifndef DBG_STOP
#define DBG_STOP 100
#endif
#define LAS __attribute__((address_space(3)))
#define GAS __attribute__((address_space(1)))
typedef unsigned short bf16;
typedef unsigned v4u __attribute__((ext_vector_type(4)));
typedef unsigned v2u __attribute__((ext_vector_type(2)));
typedef float f32x4 __attribute__((ext_vector_type(4)));
typedef float f32x2 __attribute__((ext_vector_type(2)));
typedef short bf16x8 __attribute__((ext_vector_type(8)));
typedef float f32x16 __attribute__((ext_vector_type(16)));
typedef short s16x4 __attribute__((ext_vector_type(4)));
typedef GAS unsigned gu32;

constexpr int NB = 8, SEQ = 2048, DM = 2048, NMETA = 16, NH = 16, HD = 64, ATTW = 1024, CONVC = 1024, CONVK = 31;
constexpr int NGRP = 4, EPG = 8, NE = 32, DE = 768, INCOLS = 9232, DEPTH = 2;
constexpr int MR = NB * SEQ;
constexpr int MT = MR + NMETA;
constexpr int MALLOC = 16640;
constexpr int KSEQ = 64 + SEQ;
constexpr int ZSEQ = NMETA + SEQ;
constexpr int PCAP = MT;
constexpr int MAXT = 162;
constexpr float RMS_EPS = 1e-6f, LN_EPS = 1e-5f;
constexpr float LOG2E = 1.4426950408889634f;
constexpr float C2 = 0.125f * 1.4426950408889634f;
constexpr float W8S = 32.0f, W8I = 1.0f / 32.0f;

constexpr size_t MiB = 1u << 20;
constexpr size_t WS_CTL = 0, CTL_ZERO_BYTES = 64 * 1024;
constexpr size_t WS_WF = 1 * MiB, WS_WR = 2 * MiB, WS_LOGF = 3 * MiB, WS_PERM = 6 * MiB, WS_WTS = 9 * MiB;
constexpr size_t WS_W = 16 * MiB, W_LSTRIDE = 340 * MiB;
constexpr size_t WO_IN = 0, WO_AO = 36 * MiB, WO_CO = 40 * MiB, WO_O = 44 * MiB, WO_GU = 52 * MiB, WO_DN = 244 * MiB;
constexpr size_t WS_XN = 696 * MiB, WS_QO = 761 * MiB, WS_KB = 794 * MiB, WS_VB = 827 * MiB, WS_ZG = 860 * MiB, WS_SGA = 893 * MiB, WS_SGC = 958 * MiB;
constexpr size_t WS_CV = 1023 * MiB, WS_MG = 1056 * MiB, WS_RES = 1121 * MiB, WS_N2 = 1251 * MiB, WS_XS = 1316 * MiB, WS_H = 1478 * MiB, WS_Y0 = 1539 * MiB, WS_Y1 = 1604 * MiB;
constexpr size_t WS_XN8 = 1669 * MiB;
constexpr size_t WS_END = 1702 * MiB;
constexpr int CW_TMO = 0, CW_BAR = 4096, CW_CNT = 8192;

#define RLX_AGENT __ATOMIC_RELAXED, __HIP_MEMORY_SCOPE_AGENT
#define LDS_WAIT() asm volatile("s_waitcnt lgkmcnt(0)" ::: "memory")
#define VM_WAIT() asm volatile("s_waitcnt vmcnt(0)" ::: "memory")
typedef __bf16 bf16x2_t __attribute__((ext_vector_type(2)));
__device__ __forceinline__ unsigned cvt_pk_bf16(float lo, float hi) { f32x2 v = {lo, hi}; bf16x2_t b = __builtin_convertvector(v, bf16x2_t); return __builtin_bit_cast(unsigned, b); }
__device__ __forceinline__ float bf_lo(unsigned u) { return __uint_as_float(u << 16); }
__device__ __forceinline__ float bf_hi(unsigned u) { return __uint_as_float(u & 0xffff0000u); }
__device__ __forceinline__ float sigmoidf_fast(float x) { return __builtin_amdgcn_rcpf(1.0f + __builtin_amdgcn_exp2f(-x * LOG2E)); }
template <int X> __device__ __forceinline__ float swz_xor(float v) { return __int_as_float(__builtin_amdgcn_ds_swizzle(__float_as_int(v), 0x1f | (X << 10))); }
__device__ __forceinline__ float xor32_sum(float v) { auto rr = __builtin_amdgcn_permlane32_swap(__float_as_uint(v), __float_as_uint(v), false, false); return __uint_as_float(rr[0]) + __uint_as_float(rr[1]); }
__device__ __forceinline__ float wave_sum(float v) {
    v += swz_xor<1>(v); v += swz_xor<2>(v); v += swz_xor<4>(v); v += swz_xor<8>(v); v += swz_xor<16>(v);
    return xor32_sum(v);
}
__device__ __forceinline__ float shfl_idx(float v, int src_lane) { return __int_as_float(__builtin_amdgcn_ds_bpermute(src_lane << 2, __float_as_int(v))); }
__device__ __forceinline__ int shfl_idx_i(int v, int src_lane) { return __builtin_amdgcn_ds_bpermute(src_lane << 2, v); }

namespace pg8 {
constexpr int BM = 256, BK = 64, HALF = 128, HTB = HALF * BK * 2, STAGE_BYTES = 8 * HTB, NXCD = 8, WGM = 8;
__host__ __device__ __forceinline__ int lds_byte(int r, int c) { const int st = (r >> 4) * 2 + (c >> 5), rr = r & 15, cc = c & 31, ob = rr * 64 + cc * 2; return st * 1024 + (ob ^ (((ob >> 9) & 1) << 5)); }
__host__ __device__ __forceinline__ void stage_rc(int b, int& R, int& C) { const int st = b / 1024, sb = b % 1024, swz = sb ^ (((sb >> 9) & 1) << 5); R = (st >> 1) * 16 + swz / 64; C = (st & 1) * 32 + (swz % 64) / 2; }
__host__ __device__ __forceinline__ int perm32(int rho) { const int n = rho >> 4, i = rho & 15; return 8 * (i >> 2) + 4 * n + (i & 3); }

struct Unit { int pm, pn, aux; };

struct GridOrder {
    int nM, nN, nwg, G, c;
    __device__ __forceinline__ void init(int nM_, int nN_, int G_, int c_) { nM = nM_; nN = nN_; nwg = nM * nN; G = G_; c = c_; }
    __device__ __forceinline__ bool tile(int i, int& pm, int& pn) const {
        const long L = (long)i * G + c; if (L >= nwg) return false;
        int wgid = (int)L; { const int q = nwg / NXCD, r = nwg % NXCD, xcd = wgid % NXCD, off = wgid / NXCD; wgid = (xcd < r ? xcd * (q + 1) : r * (q + 1) + (xcd - r) * q) + off; }
        const int nig = WGM * nN, gid = wgid / nig, fm = gid * WGM, gsz = (nM - fm) < WGM ? (nM - fm) : WGM;
        pm = fm + ((wgid % nig) % gsz); pn = (wgid % nig) / gsz; return true;
    }
};

typedef int v8i_t __attribute__((ext_vector_type(8)));
template <class Epi, class Sched, bool ALIGN_EPI, bool FP8 = false>
__device__ __forceinline__ void gemm_phase(LAS unsigned char* lds, const int KB, const Sched& S, const Epi& E) {
    int tid = threadIdx.x; asm volatile("" : "+v"(tid));
    const int wid = __builtin_amdgcn_readfirstlane(tid >> 6), lane = tid & 63, wr = wid >> 2, wc = wid & 3, fr = lane & 15, fq = lane >> 4;
    const int nt = KB / (BK * 2);
    unsigned voffA[2], voffB[2];
#pragma unroll
    for (int i = 0; i < 2; ++i) { int R, C; stage_rc(tid * 16 + i * 8192, R, C); const int Rb = Epi::PERM ? ((R & ~31) + perm32(R & 31)) : R;
        voffA[i] = (unsigned)(R * KB + C * 2); voffB[i] = (unsigned)(Rb * KB + C * 2); }
    const size_t kstep = (size_t)(BK * 2);
    const size_t hstep = (size_t)HALF * KB;
    const unsigned ldsw = (unsigned)wid * 1024u;
    const int aoff = lds_byte(wr * 64 + fr, fq * 8), boff = lds_byte(wc * 32 + fr, fq * 8);
#define PG8_SA(b, h) (((b) * 2 + (h)) * HTB)
#define PG8_SB(b, h) ((4 + (b) * 2 + (h)) * HTB)
#define PG8_STAGE(bufoff, gbase, voff) do { _Pragma("unroll") for (int _i = 0; _i < 2; ++_i) \
        __builtin_amdgcn_global_load_lds((const unsigned*)((const char*)(gbase) + (voff)[_i]), (LAS unsigned*)(lds + (bufoff) + ldsw + _i * 8192), 16, 0, 0); } while (0)
#define PG8_LD32(off) __builtin_shufflevector(*(const LAS v4u*)(lds + (off)), *(const LAS v4u*)(lds + (off) + 1024), 0, 1, 2, 3, 4, 5, 6, 7)
#define PG8_LDA(dst, b, h) do { _Pragma("unroll") for (int m = 0; m < 4; ++m) { if constexpr (FP8) dst##8[m] = __builtin_bit_cast(v8i_t, PG8_LD32(PG8_SA(b, h) + aoff + m * 2048)); else { _Pragma("unroll") for (int k = 0; k < 2; ++k) dst[m][k] = *(const LAS bf16x8*)(lds + PG8_SA(b, h) + aoff + m * 2048 + k * 1024); } } } while (0)
#define PG8_LDB(dst, b, h) do { _Pragma("unroll") for (int n = 0; n < 2; ++n) { if constexpr (FP8) dst##8[n] = __builtin_bit_cast(v8i_t, PG8_LD32(PG8_SB(b, h) + boff + n * 2048)); else { _Pragma("unroll") for (int k = 0; k < 2; ++k) dst[n][k] = *(const LAS bf16x8*)(lds + PG8_SB(b, h) + boff + n * 2048 + k * 1024); } } } while (0)
#define PG8_CAT(x) __builtin_shufflevector(__builtin_bit_cast(v4u, (x)[0]), __builtin_bit_cast(v4u, (x)[1]), 0, 1, 2, 3, 4, 5, 6, 7)
#define PG8_MMA(ai, bj, At, Bt) do { __builtin_amdgcn_s_setprio(1); _Pragma("unroll") for (int m = 0; m < 4; ++m) _Pragma("unroll") for (int n = 0; n < 2; ++n) { \
        if constexpr (FP8) asm volatile("v_mfma_scale_f32_16x16x128_f8f6f4 %0, %1, %2, %0, %3, %3 op_sel_hi:[0,0,0]" : "+v"(acc[ai][bj][m][n]) : "v"(Bt##8[n]), "v"(At##8[m]), "v"(sc1_)); \
        else { _Pragma("unroll") for (int k = 0; k < 2; ++k) acc[ai][bj][m][n] = __builtin_amdgcn_mfma_f32_16x16x32_bf16(Bt[n][k], At[m][k], acc[ai][bj][m][n], 0, 0, 0); } } \
        __builtin_amdgcn_s_setprio(0); } while (0)
#define PG8_WAIT_V(n) asm volatile("s_waitcnt vmcnt(" #n ")" ::: "memory")
#define PG8_WAIT_L(n) asm volatile("s_waitcnt lgkmcnt(" #n ")" ::: "memory")
#define PG8_BAR __builtin_amdgcn_s_barrier()
#define PG8_SCHED __builtin_amdgcn_sched_barrier(0)
#define PG8_ZERO() do { float zf_; asm volatile("v_mov_b32 %0, 0" : "=v"(zf_)); const f32x4 z4_ = {zf_, zf_, zf_, zf_}; _Pragma("unroll") for (int a = 0; a < 2; ++a) _Pragma("unroll") for (int b = 0; b < 2; ++b) _Pragma("unroll") for (int m = 0; m < 4; ++m) _Pragma("unroll") for (int n = 0; n < 2; ++n) acc[a][b][m][n] = z4_; } while (0)
    Unit cur, nxt; int ui = 0;
    if (!S.next(0, cur)) return;
    f32x4 acc[2][2][4][2];
    PG8_ZERO();
    bf16x8 At[4][2], B0[2][2], B1[2][2]; v8i_t At8[4], B08[2], B18[2];
    int sc1_ = 0x7f7f7f7f; asm volatile("" : "+v"(sc1_));
    const char* cA = S.opA(cur); const char* cB = S.opB(cur);
    PG8_STAGE(PG8_SB(0, 0), cB, voffB); PG8_STAGE(PG8_SB(0, 1), cB + hstep, voffB); PG8_STAGE(PG8_SA(0, 0), cA, voffA); PG8_STAGE(PG8_SA(0, 1), cA + hstep, voffA);
    if (wr == 1) PG8_BAR;
    PG8_WAIT_V(2); PG8_BAR;
    PG8_STAGE(PG8_SB(1, 0), cB + kstep, voffB); PG8_STAGE(PG8_SA(1, 0), cA + kstep, voffA); PG8_STAGE(PG8_SB(1, 1), cB + hstep + kstep, voffB);
    PG8_WAIT_V(6); PG8_BAR;
    for (;;) {
        const bool has_next = S.next(ui + 1, nxt);
        const char* nA = has_next ? S.opA(nxt) : cA; const char* nB = has_next ? S.opB(nxt) : cB;
        for (int t = 0; t < nt; t += 2) {
            const bool last = (t == nt - 2);
            const char* a1 = cA + (size_t)(t + 1) * kstep;
            const char* a2 = last ? nA : cA + (size_t)(t + 2) * kstep; const char* b2 = last ? nB : cB + (size_t)(t + 2) * kstep;
            const char* a3 = a2 + kstep; const char* b3 = b2 + kstep;
            PG8_LDB(B0, 0, 0); PG8_LDB(B1, 0, 1); PG8_SCHED; PG8_LDA(At, 0, 0); PG8_STAGE(PG8_SA(1, 1), a1 + hstep, voffA);
            PG8_WAIT_V(8); PG8_WAIT_L(0); PG8_BAR; PG8_MMA(0, 0, At, B0); PG8_MMA(0, 1, At, B1); PG8_BAR; PG8_SCHED;
            PG8_LDA(At, 0, 1); PG8_STAGE(PG8_SB(0, 0), b2, voffB); PG8_STAGE(PG8_SB(0, 1), b2 + hstep, voffB); PG8_STAGE(PG8_SA(0, 0), a2, voffA);
            PG8_WAIT_V(8); PG8_WAIT_L(0); PG8_BAR; PG8_MMA(1, 0, At, B0); PG8_MMA(1, 1, At, B1); PG8_BAR; PG8_SCHED;
            PG8_LDB(B0, 1, 0); PG8_LDB(B1, 1, 1); PG8_SCHED; PG8_LDA(At, 1, 0); PG8_STAGE(PG8_SA(0, 1), a2 + hstep, voffA);
            PG8_WAIT_V(8); PG8_WAIT_L(0); PG8_BAR; PG8_MMA(0, 0, At, B0); PG8_MMA(0, 1, At, B1); PG8_BAR; PG8_SCHED;
            PG8_LDA(At, 1, 1); PG8_STAGE(PG8_SB(1, 0), b3, voffB); PG8_STAGE(PG8_SB(1, 1), b3 + hstep, voffB); PG8_STAGE(PG8_SA(1, 0), a3, voffA);
            PG8_WAIT_V(8); PG8_WAIT_L(0); PG8_BAR; PG8_MMA(1, 0, At, B0); PG8_MMA(1, 1, At, B1); PG8_BAR; PG8_SCHED;
        }
        if constexpr (ALIGN_EPI) { if (wr == 0) PG8_BAR; }
        if constexpr (FP8) asm volatile("s_nop 15\n\ts_nop 15" ::: "memory");
        E(acc, cur, wr, wc, fr, fq);
        if (!has_next) break;
        if (!E.keep(cur)) PG8_ZERO();
        cur = nxt; cA = nA; cB = nB; ++ui;
        if constexpr (ALIGN_EPI) { if (wr == 1) PG8_BAR; }
    }
    PG8_WAIT_V(0);
    if constexpr (!ALIGN_EPI) { if (wr == 0) PG8_BAR; }
    PG8_BAR;
#undef PG8_SA
#undef PG8_SB
#undef PG8_STAGE
#undef PG8_LDA
#undef PG8_LD32
#undef PG8_LDB
#undef PG8_MMA
#undef PG8_CAT
#undef PG8_WAIT_V
#undef PG8_WAIT_L
#undef PG8_BAR
#undef PG8_SCHED
#undef PG8_ZERO
}
}

namespace attn_body {
constexpr int D = 64, DMA_ = NH * D;
constexpr int NW = 8, QBLK = 32, QB = QBLK * NW, KVBLK = 64;
__device__ __forceinline__ int crow(int r, int hi) { return (r & 3) + 8 * (r >> 2) + 4 * hi; }
#define SBAR() __builtin_amdgcn_sched_barrier(0)
__device__ __forceinline__ void cmask(f32x16& p0, f32x16& p1, int jb, int qrel, int hi) {
  const float NEG = -INFINITY; int kb = 64 * jb + 4 * hi;
  #pragma unroll
  for (int r = 0; r < 16; ++r) { int kv = kb + (r & 3) + 8 * (r >> 2); if (kv > qrel) p0[r] = NEG; if (kv + 32 > qrel) p1[r] = NEG; }
}
constexpr int NSLOT = 3, SLOTB = 8192;
constexpr int LDS_K = 0, LDS_V = NSLOT * SLOTB, LDS_WS = 2 * NSLOT * SLOTB, LDS_OST = LDS_WS + NW * 64 * 4, LDS_BYTES = LDS_OST + NW * 4096;
constexpr int LDS_CS = LDS_BYTES, LDS_TOT = LDS_CS + KSEQ * 4, LDS_ALL = LDS_TOT + 256;
__device__ __forceinline__ void glds16(const void* gsrc, unsigned lds_dst) { unsigned keep;
  asm volatile("s_mov_b32 %0, m0\n\ts_mov_b32 m0, %2\n\ts_nop 0\n\tglobal_load_lds_dwordx4 %1, off\n\ts_mov_b32 m0, %0" : "=&s"(keep) : "v"(gsrc), "s"(lds_dst) : "memory"); }
__device__ __forceinline__ float max3f(float a, float b, float c) { float r; asm("v_max3_f32 %0, %1, %2, %3" : "=v"(r) : "v"(a), "v"(b), "v"(c)); return r; }
__device__ __forceinline__ float max2f(float a, float b) { float r; asm("v_max_f32_e32 %0, %1, %2" : "=v"(r) : "v"(a), "v"(b)); return r; }
__device__ __forceinline__ float fadd_s(float a, float b) { float r; asm("v_add_f32_e32 %0, %1, %2" : "=v"(r) : "v"(a), "v"(b)); return r; }
__device__ __forceinline__ float fsub_s(float a, float b) { float r; asm("v_sub_f32_e32 %0, %1, %2" : "=v"(r) : "v"(a), "v"(b)); return r; }
__device__ __forceinline__ unsigned cvtpk_s(float lo, float hi) { f32x2 v = {lo, hi}; bf16x2_t b = __builtin_convertvector(v, bf16x2_t); return __builtin_bit_cast(unsigned, b); }
#define WAIT_BAR(N) asm volatile("s_waitcnt vmcnt(" #N ") lgkmcnt(0)\n\ts_barrier" ::: "memory")

__device__ __forceinline__ void qkt(f32x16& p0, f32x16& p1, const char* Kslot, const bf16x8* qr, const f32x16& negm, int r32, int hi) {
  const char* kb = Kslot + hi * 1024 + r32 * 16;
  #pragma unroll
  for (int d0 = 0; d0 < 4; ++d0) {
    const bf16x8 b0 = *reinterpret_cast<const bf16x8*>(kb + d0 * 2048);
    const bf16x8 b1 = *reinterpret_cast<const bf16x8*>(kb + d0 * 2048 + 512);
    if (d0 == 0) { p0 = __builtin_amdgcn_mfma_f32_32x32x16_bf16(b0, qr[0], negm, 0, 0, 0); p1 = __builtin_amdgcn_mfma_f32_32x32x16_bf16(b1, qr[0], negm, 0, 0, 0); }
    else { p0 = __builtin_amdgcn_mfma_f32_32x32x16_bf16(b0, qr[d0], p0, 0, 0, 0); p1 = __builtin_amdgcn_mfma_f32_32x32x16_bf16(b1, qr[d0], p1, 0, 0, 0); } }
}
typedef LAS const char* lds_cptr;
typedef short v4i16_t __attribute__((ext_vector_type(4)));
__device__ __forceinline__ void kload8(bf16x8* kf, lds_cptr kp) {
  kf[0] = *(const LAS bf16x8*)(kp);        kf[1] = *(const LAS bf16x8*)(kp + 512);
  kf[2] = *(const LAS bf16x8*)(kp + 2048); kf[3] = *(const LAS bf16x8*)(kp + 2560);
  kf[4] = *(const LAS bf16x8*)(kp + 4096); kf[5] = *(const LAS bf16x8*)(kp + 4608);
  kf[6] = *(const LAS bf16x8*)(kp + 6144); kf[7] = *(const LAS bf16x8*)(kp + 6656);
}
__device__ __forceinline__ void kload2(bf16x8* kf, lds_cptr kp, int j) { kf[2 * j] = *(const LAS bf16x8*)(kp + j * 2048); kf[2 * j + 1] = *(const LAS bf16x8*)(kp + j * 2048 + 512); }
__device__ __forceinline__ s16x4 vtr(lds_cptr p) { return __builtin_bit_cast(s16x4, __builtin_amdgcn_ds_read_tr16_b64_v4i16((LAS v4i16_t*)p)); }
__device__ __forceinline__ float rowmax(const f32x16& p0, const f32x16& p1) {
  float a = max3f(p0[0], p0[1], p1[0]), b = max3f(p0[2], p0[3], p1[1]); a = max3f(a, p1[2], p1[3]);
  #pragma unroll
  for (int r = 4; r < 16; r += 4) { a = max3f(a, p0[r], p0[r + 1]); b = max3f(b, p0[r + 2], p0[r + 3]); a = max3f(a, p1[r], p1[r + 1]); b = max3f(b, p1[r + 2], p1[r + 3]); }
  const float m = max2f(a, b);
  auto rr = __builtin_amdgcn_permlane32_swap(__float_as_uint(m), __float_as_uint(m), false, false);
  return max2f(__uint_as_float(rr[0]), __uint_as_float(rr[1]));
}
__device__ __forceinline__ void pv(f32x16* o, int vb, bf16x8 pa0, bf16x8 pa1, bf16x8 pa2, bf16x8 pa3) {
  #pragma unroll
  for (int d0 = 0; d0 < 2; ++d0) { s16x4 lo[4], hi[4];
    #pragma unroll
    for (int ks = 0; ks < 4; ++ks) {
      asm volatile("ds_read_b64_tr_b16 %0,%1 offset:%c2" : "=&v"(lo[ks]) : "v"(vb), "i"(d0 * 4096 + ks * 1024) : "memory");
      asm volatile("ds_read_b64_tr_b16 %0,%1 offset:%c2" : "=&v"(hi[ks]) : "v"(vb), "i"(d0 * 4096 + ks * 1024 + 512) : "memory"); }
    asm volatile("s_waitcnt lgkmcnt(0)" ::: "memory"); SBAR();
    #define PK(k) (bf16x8){lo[k][0], lo[k][1], lo[k][2], lo[k][3], hi[k][0], hi[k][1], hi[k][2], hi[k][3]}
    o[d0] = __builtin_amdgcn_mfma_f32_32x32x16_bf16(pa0, PK(0), o[d0], 0, 0, 0);
    o[d0] = __builtin_amdgcn_mfma_f32_32x32x16_bf16(pa1, PK(1), o[d0], 0, 0, 0);
    o[d0] = __builtin_amdgcn_mfma_f32_32x32x16_bf16(pa2, PK(2), o[d0], 0, 0, 0);
    o[d0] = __builtin_amdgcn_mfma_f32_32x32x16_bf16(pa3, PK(3), o[d0], 0, 0, 0);
    #undef PK
  }
}
__device__ __forceinline__ void kbias(f32x16& p0, f32x16& p1, const LAS float* csl, int t, int hi) {
  const LAS f32x4* cb = (const LAS f32x4*)(csl + 64 * t + 4 * hi);
  #pragma unroll
  for (int g = 0; g < 4; ++g) { const f32x4 u0 = cb[2 * g], u1 = cb[8 + 2 * g];
    p0[4 * g + 0] -= u0[0]; p0[4 * g + 1] -= u0[1]; p0[4 * g + 2] -= u0[2]; p0[4 * g + 3] -= u0[3];
    p1[4 * g + 0] -= u1[0]; p1[4 * g + 1] -= u1[1]; p1[4 * g + 2] -= u1[2]; p1[4 * g + 3] -= u1[3]; }
}

template <int THRL> __device__ __forceinline__ void attn_unit(int b, int h, int qb, const __hip_bfloat16* Q, const __hip_bfloat16* __restrict__ K, const __hip_bfloat16* __restrict__ V, __hip_bfloat16* O, char* shm) {
  using bf16h = __hip_bfloat16;
  int tid = threadIdx.x; asm volatile("" : "+v"(tid));
  const int lane = tid & 63, r32 = lane & 31, hi = lane >> 5; const int wid = __builtin_amdgcn_readfirstlane(tid >> 6);
  const long rowbaseQ = (long)b * SEQ, rowbaseK = (long)b * KSEQ; const int q0 = qb * QB;
  const bf16h* Qw = Q + (rowbaseQ + q0 + wid * QBLK) * DMA_ + h * D;
  const bf16h* Kh = K + rowbaseK * DMA_ + h * D, *Vh = V + rowbaseK * DMA_ + h * D;
  const unsigned lds0 = (unsigned)(uintptr_t)shm;
  float* wsf = (float*)(shm + LDS_WS) + wid * 64;
  const LAS float* csl = (const LAS float*)((LAS const char*)shm + LDS_CS);
  const bf16h* ksrc = Kh + (long)lane * DMA_ + wid * 8;
  const bf16h* vsrc = Vh + (long)(16 * (wid & 3) + (lane >> 2)) * DMA_ + (wid >> 2) * 32 + (lane & 3) * 8;
  const unsigned kdst = lds0 + LDS_K + wid * 1024, vdst = lds0 + LDS_V + wid * 1024;
  #define DMA_K(t, slot) glds16(ksrc + (long)(t) * KVBLK * DMA_, (unsigned)__builtin_amdgcn_readfirstlane(kdst + (slot)))
  #define DMA_V(t, slot) glds16(vsrc + (long)(t) * KVBLK * DMA_, (unsigned)__builtin_amdgcn_readfirstlane(vdst + (slot)))
  const int vb0 = (int)(lds0 + LDS_V) + ((lane >> 4) & 1) * 32 + (lane & 3) * 8 + (4 * hi + ((lane & 15) >> 2)) * 64;
  const char* Kbase = shm + LDS_K; bf16x8 kf[8];
  const lds_cptr shm3 = (lds_cptr)shm; const lds_cptr kp0 = shm3 + LDS_K + hi * 1024 + r32 * 16; const lds_cptr vp0 = shm3 + LDS_V + ((lane >> 4) & 1) * 32 + (lane & 3) * 8 + (4 * hi + ((lane & 15) >> 2)) * 64;
  const int NT = (q0 + QB) / KVBLK + 1;
  DMA_K(0, 0); DMA_V(0, 0); DMA_K(1, SLOTB);
  bf16x8 qr[4];
  #pragma unroll
  for (int d0 = 0; d0 < 4; ++d0) qr[d0] = *reinterpret_cast<const bf16x8*>(&Qw[(long)r32 * DMA_ + d0 * 16 + hi * 8]);
  const float cq = csl[64 + q0 + wid * QBLK + r32];
  float mhat = 0.f, l_reg = 0.f; f32x16 o[2]; o[0] = f32x16{}; o[1] = f32x16{}; f32x16 negm;
  #pragma unroll
  for (int r = 0; r < 16; ++r) negm[r] = cq;
  asm volatile("" : "+v"(negm));
  const int qrel = wid * QBLK + r32;
  #define CMASK(P0, P1, t) do { int jb_ = (t) - (NT - 4); if (jb_ >= 0) cmask(P0, P1, jb_, qrel, hi); } while (0)
  bool resc = false;
  #define START(P0, P1) do { const float rm = rowmax(P0, P1); resc = false; \
    { const float dl = rm; mhat = fadd_s(mhat, dl); \
      _Pragma("unroll") for (int r = 0; r < 16; ++r) { P0[r] = fsub_s(P0[r], dl); P1[r] = fsub_s(P1[r], dl); } \
      _Pragma("unroll") for (int r = 0; r < 16; ++r) negm[r] = cq - mhat; asm volatile("" : "+v"(negm)); } \
    _Pragma("unroll") for (int r = 0; r < 16; ++r) P0[r] = __builtin_amdgcn_exp2f(P0[r]); } while (0)
  #define RESC() do { if (resc) { asm volatile("s_waitcnt lgkmcnt(0)" ::: "memory"); \
      _Pragma("unroll") for (int d_ = 0; d_ < 2; ++d_) _Pragma("unroll") for (int r = 0; r < 16; ++r) o[d_][r] *= wsf[crow(r, hi)]; } } while (0)
  f32x16 pA0, pA1, pB0, pB1;
  int sl_prev = 0, sl_cur = 0, sl_next = SLOTB;
  #define ROT() do { sl_prev = sl_cur; sl_cur = sl_next; sl_next = (sl_next == (NSLOT - 1) * SLOTB) ? 0 : sl_next + SLOTB; } while (0)
  DMA_K(2, 2 * SLOTB);
  WAIT_BAR(3);
  qkt(pA0, pA1, Kbase, qr, negm, r32, hi); asm volatile("s_nop 15\n\ts_nop 7" : "+v"(pA0), "+v"(pA1)); kbias(pA0, pA1, csl, 0, hi);
  START(pA0, pA1);
  _Pragma("unroll") for (int r = 0; r < 16; ++r) pA1[r] = __builtin_amdgcn_exp2f(pA1[r]);
  WAIT_BAR(0);
  DMA_K(3, 0); DMA_V(1, SLOTB);
  ROT();
  kload8(kf, kp0 + sl_cur);
  WAIT_BAR(2);
  s16x4 vlo[8], vhi[8]; v4u pw0, pw1, pw2, pw3;
  #define PKW(P, B) cvtpk_s(P[B], P[B + 1])
  #define PAF(k) __builtin_bit_cast(bf16x8, pw##k)
  #define VFR(i) (bf16x8){vlo[i][0], vlo[i][1], vlo[i][2], vlo[i][3], vhi[i][0], vhi[i][1], vhi[i][2], vhi[i][3]}
  #define PIN(x) asm volatile("" : "+v"(x))
  #define MX3(a, b, c) __builtin_fmaxf(__builtin_fmaxf((a), (b)), (c))
  #define GAPA(MF, A0, A1, A2, A3, W0, W1, PW) do { MF; sacc += A0; sacc += A1; sacc += A2; sacc += A3; PIN(sacc); W0; W1; PIN(PW); SBAR(); } while (0)
  #define EX(v) __builtin_amdgcn_exp2f(v)
  #define GAPB(MF, X, B) do { MF; X[B] = EX(X[B]); X[B + 1] = EX(X[B + 1]); X[B + 2] = EX(X[B + 2]); X[B + 3] = EX(X[B + 3]); PIN(X); SBAR(); } while (0)
  #define VRD(i) do { vlo[i] = vtr(vp_ + (((i) >> 2) * 4096 + ((i) & 3) * 1024)); vhi[i] = vtr(vp_ + (((i) >> 2) * 4096 + ((i) & 3) * 1024 + 512)); } while (0)
  #define KRD(G, j) do { if (G) { kload2(kf, kp0 + sl_next, j); SBAR(); } } while (0)
  #define STEP(C0, C1, P0, P1, t, GK, GV, GL) do { SBAR(); \
    const lds_cptr vp_ = vp0 + sl_prev; \
    VRD(0); SBAR(); float sacc = (P0[0] + P0[1]); \
    GAPA(C0 = __builtin_amdgcn_mfma_f32_32x32x16_bf16(kf[0], qr[0], negm, 0, 0, 0), P0[2], P0[3], P0[4], P0[5],     pw0[0] = PKW(P0, 0), pw0[1] = PKW(P0, 2), pw0); \
    VRD(4); SBAR(); GAPA(C1 = __builtin_amdgcn_mfma_f32_32x32x16_bf16(kf[1], qr[0], negm, 0, 0, 0), P0[6], P0[7], P0[8], P0[9],     pw0[2] = PKW(P0, 4), pw0[3] = PKW(P0, 6), pw0); \
    VRD(1); SBAR(); GAPA(C0 = __builtin_amdgcn_mfma_f32_32x32x16_bf16(kf[2], qr[1], C0, 0, 0, 0),   P0[10], P0[11], P0[12], P0[13], pw1[0] = PKW(P0, 8), pw1[1] = PKW(P0, 10), pw1); \
    VRD(5); SBAR(); GAPA(C1 = __builtin_amdgcn_mfma_f32_32x32x16_bf16(kf[3], qr[1], C1, 0, 0, 0),   P0[14], P0[15], P1[0], P1[1],   pw1[2] = PKW(P0, 12), pw1[3] = PKW(P0, 14), pw1); \
    VRD(2); SBAR(); GAPA(C0 = __builtin_amdgcn_mfma_f32_32x32x16_bf16(kf[4], qr[2], C0, 0, 0, 0),   P1[2], P1[3], P1[4], P1[5],     pw2[0] = PKW(P1, 0), pw2[1] = PKW(P1, 2), pw2); \
    VRD(6); SBAR(); GAPA(C1 = __builtin_amdgcn_mfma_f32_32x32x16_bf16(kf[5], qr[2], C1, 0, 0, 0),   P1[6], P1[7], P1[8], P1[9],     pw2[2] = PKW(P1, 4), pw2[3] = PKW(P1, 6), pw2); \
    VRD(3); SBAR(); GAPA(C0 = __builtin_amdgcn_mfma_f32_32x32x16_bf16(kf[6], qr[3], C0, 0, 0, 0),   P1[10], P1[11], P1[12], P1[13], pw3[0] = PKW(P1, 8), pw3[1] = PKW(P1, 10), pw3); \
    VRD(7); SBAR(); GAPA(C1 = __builtin_amdgcn_mfma_f32_32x32x16_bf16(kf[7], qr[3], C1, 0, 0, 0),   P1[14], P1[15], 0.f, 0.f,       pw3[2] = PKW(P1, 12), pw3[3] = PKW(P1, 14), pw3); \
    l_reg += sacc; \
    if (GK) { DMA_K((t) + 3, sl_cur); } if (GV) { DMA_V((t) + 1, sl_next); } \
    kbias(C0, C1, csl, (t), hi); \
    CMASK(C0, C1, t); \
    { float a = MX3(C0[0], C0[1], C1[0]), b = MX3(C0[2], C0[3], C1[1]); a = MX3(a, C1[2], C1[3]); \
      _Pragma("unroll") for (int r = 4; r < 16; r += 4) { a = MX3(a, C0[r], C0[r + 1]); b = MX3(b, C0[r + 2], C0[r + 3]); a = MX3(a, C1[r], C1[r + 1]); b = MX3(b, C1[r + 2], C1[r + 3]); } \
      float rm = __builtin_fmaxf(a, b); { auto rr = __builtin_amdgcn_permlane32_swap(__float_as_uint(rm), __float_as_uint(rm), false, false); rm = __builtin_fmaxf(__uint_as_float(rr[0]), __uint_as_float(rr[1])); } \
      resc = false; \
      if (__builtin_expect(__any(rm > (float)THRL), 0)) { const float dl = __builtin_fmaxf(rm, 0.f); mhat += dl; \
        _Pragma("unroll") for (int r = 0; r < 16; ++r) { C0[r] -= dl; C1[r] -= dl; } \
        _Pragma("unroll") for (int r = 0; r < 16; ++r) negm[r] = cq - mhat; asm volatile("" : "+v"(negm)); \
        const float f = __builtin_amdgcn_exp2f(-dl); l_reg *= f; if (hi == 0) wsf[r32] = f; resc = true; } } \
    SBAR(); \
    GAPB(o[0] = __builtin_amdgcn_mfma_f32_32x32x16_bf16(PAF(0), VFR(0), o[0], 0, 0, 0), C0, 0); \
    GAPB(o[1] = __builtin_amdgcn_mfma_f32_32x32x16_bf16(PAF(0), VFR(4), o[1], 0, 0, 0), C0, 4); \
    KRD(GL, 0); GAPB(o[0] = __builtin_amdgcn_mfma_f32_32x32x16_bf16(PAF(1), VFR(1), o[0], 0, 0, 0), C0, 8); \
    KRD(GL, 1); GAPB(o[1] = __builtin_amdgcn_mfma_f32_32x32x16_bf16(PAF(1), VFR(5), o[1], 0, 0, 0), C0, 12); \
    KRD(GL, 2); GAPB(o[0] = __builtin_amdgcn_mfma_f32_32x32x16_bf16(PAF(2), VFR(2), o[0], 0, 0, 0), C1, 0); \
    KRD(GL, 3); GAPB(o[1] = __builtin_amdgcn_mfma_f32_32x32x16_bf16(PAF(2), VFR(6), o[1], 0, 0, 0), C1, 4); \
    GAPB(o[0] = __builtin_amdgcn_mfma_f32_32x32x16_bf16(PAF(3), VFR(3), o[0], 0, 0, 0), C1, 8); \
    GAPB(o[1] = __builtin_amdgcn_mfma_f32_32x32x16_bf16(PAF(3), VFR(7), o[1], 0, 0, 0), C1, 12); \
    } while (0)
  int t = 1;
  #undef CMASK
  #define CMASK(P0, P1, t) do {} while (0)
  for (; t + 5 < NT; t += 2) {
    STEP(pB0, pB1, pA0, pA1, t, true, true, true);     WAIT_BAR(2); RESC(); ROT();
    STEP(pA0, pA1, pB0, pB1, t + 1, true, true, true); WAIT_BAR(2); RESC(); ROT();
  }
  #undef CMASK
  #define CMASK(P0, P1, t) do { int jb_ = (t) - (NT - 4); if (jb_ >= 0) cmask(P0, P1, jb_, qrel, hi); } while (0)
  #define ENDW(tt) do { if ((tt) + 3 < NT) { WAIT_BAR(2); } else if ((tt) + 2 < NT) { WAIT_BAR(1); } else { WAIT_BAR(0); } } while (0)
  for (; t + 1 < NT; t += 2) {
    STEP(pB0, pB1, pA0, pA1, t, (t + 3 < NT), (t + 1 < NT), (t + 1 < NT));       ENDW(t);     RESC(); ROT();
    STEP(pA0, pA1, pB0, pB1, t + 1, (t + 4 < NT), (t + 2 < NT), (t + 2 < NT));   ENDW(t + 1); RESC(); ROT();
  }
  { float sacc = pA0[0] + pA0[1]; _Pragma("unroll") for (int r = 2; r < 16; ++r) sacc += pA0[r]; _Pragma("unroll") for (int r = 0; r < 16; ++r) sacc += pA1[r]; l_reg += sacc;
    pw0 = (v4u){PKW(pA0, 0), PKW(pA0, 2), PKW(pA0, 4), PKW(pA0, 6)}; pw1 = (v4u){PKW(pA0, 8), PKW(pA0, 10), PKW(pA0, 12), PKW(pA0, 14)}; pw2 = (v4u){PKW(pA1, 0), PKW(pA1, 2), PKW(pA1, 4), PKW(pA1, 6)}; pw3 = (v4u){PKW(pA1, 8), PKW(pA1, 10), PKW(pA1, 12), PKW(pA1, 14)};
    SBAR(); pv(o, vb0 + sl_prev, PAF(0), PAF(1), PAF(2), PAF(3)); }
  #undef PKW
  #undef PAF
  #undef VFR
  #undef PIN
  #undef MX3
  #undef GAPA
  #undef GAPB
  #undef EX
  #undef VRD
  #undef KRD
  #undef STEP
  #undef ENDW
  { auto rr = __builtin_amdgcn_permlane32_swap(__float_as_uint(l_reg), __float_as_uint(l_reg), false, false); l_reg = __uint_as_float(rr[0]) + __uint_as_float(rr[1]); }
  if (hi == 0) wsf[32 + r32] = l_reg; asm volatile("s_waitcnt lgkmcnt(0)" ::: "memory");
  float rli[16];
  #pragma unroll
  for (int r = 0; r < 16; ++r) rli[r] = __builtin_amdgcn_rcpf(wsf[32 + crow(r, hi)]);
  bf16h* Ow = O + (rowbaseQ + q0 + wid * QBLK) * DMA_ + h * D;
  { bf16h* stg = (bf16h*)(shm + LDS_OST) + wid * 2048;
    #pragma unroll
    for (int r = 0; r < 16; ++r) { const int orow = crow(r, hi);
      #pragma unroll
      for (int d0 = 0; d0 < 2; ++d0) stg[orow * 64 + d0 * 32 + r32] = __float2bfloat16(o[d0][r] * rli[r]); }
    asm volatile("s_waitcnt lgkmcnt(0)" ::: "memory");
    #pragma unroll
    for (int i = 0; i < 4; ++i) { const int row = i * 8 + (lane >> 3), ch = lane & 7; const v4u v = *(const v4u*)(stg + row * 64 + ch * 8); *(v4u*)(Ow + (long)row * DMA_ + ch * 8) = v; } }
  asm volatile("s_waitcnt lgkmcnt(0)\n\ts_barrier" ::: "memory");
  #undef DMA_K
  #undef DMA_V
  #undef CMASK
  #undef START
  #undef RESC
  #undef ROT
}
#undef SBAR
#undef WAIT_BAR
}

#define XB_TMO      128
#define XB_XCNT(j)  (256  + 64 * (j))
#define XB_XSUB(j)  (1280 + 64 * (j))
#define XB_XGEN(j)  (2304 + 64 * (j))
#define XB_TOP      3328
#define XB_TOPGEN   3392
#define XCD_BAR_WORDS 3456
#define XB_SPIN_CAP (1u << 18)
__device__ __forceinline__ unsigned xb_ld(unsigned* p)              { return __hip_atomic_load(p, __ATOMIC_RELAXED, __HIP_MEMORY_SCOPE_AGENT); }
__device__ __forceinline__ unsigned xb_add(unsigned* p, unsigned v) { return __hip_atomic_fetch_add(p, v, __ATOMIC_RELAXED, __HIP_MEMORY_SCOPE_AGENT); }
__device__ __forceinline__ unsigned xb_xcc_id() { return (unsigned)__builtin_amdgcn_s_getreg((3 << 11) | 20) & 0xFu; }
#define XB_SPIN(cond, bar) do { unsigned _sp = 0; while (cond) { __builtin_amdgcn_s_sleep(1); \
    if ((++_sp & 255u) == 0u) { if (xb_ld(&(bar)[XB_TMO])) break; if (_sp > XB_SPIN_CAP) { atomicAdd(&(bar)[XB_TMO], 1u); break; } } } } while (0)
struct XcdBarrier { unsigned* bar; unsigned x; volatile LAS unsigned* st; };
__device__ __forceinline__ XcdBarrier xcd_barrier_post(unsigned* bar, volatile LAS unsigned* st) {
    XcdBarrier b; b.bar = bar; b.x = xb_xcc_id(); b.st = st;
    if (threadIdx.x == 0) (void)xb_add(&bar[XB_XCNT(b.x)], 1u);
    return b;
}
__device__ __forceinline__ void xcd_barrier_complete(unsigned* bar, unsigned x, unsigned& nloc, unsigned& nx) {
    const unsigned G = gridDim.x * gridDim.y * gridDim.z;
    unsigned sum, cnt, mine, sp = 0u;
    for (;;) {
        sum = 0u; cnt = 0u; mine = 0u;
#pragma unroll
        for (unsigned j = 0; j < 16; ++j) { const unsigned c = xb_ld(&bar[XB_XCNT(j)]); sum += c; cnt += (c > 0u) ? 1u : 0u; mine = (j == x) ? c : mine; }
        if (sum == G) break;
        __builtin_amdgcn_s_sleep(1);
        if ((++sp & 255u) == 0u) { if (xb_ld(&bar[XB_TMO])) break; if (sp > XB_SPIN_CAP) { atomicAdd(&bar[XB_TMO], 1u); break; } }
    }
    nloc = mine > 0u ? mine : 1u; nx = cnt > 0u ? cnt : 1u;
}
__device__ __forceinline__ void xcd_barrier(const XcdBarrier& b) {
    asm volatile("s_waitcnt vmcnt(0)" ::: "memory");
    __syncthreads();
    if (threadIdx.x == 0) {
        unsigned* bar = b.bar;
        __builtin_amdgcn_s_waitcnt(0);
        unsigned nloc = b.st[0], nx = b.st[1];
        if (nloc == 0u) { xcd_barrier_complete(bar, b.x, nloc, nx); b.st[0] = nloc; b.st[1] = nx; }
        const unsigned old = xb_add(&bar[XB_XSUB(b.x)], 1u);
        const unsigned gen = old / nloc;
        if (old + 1u == (gen + 1u) * nloc) {
            __builtin_amdgcn_fence(__ATOMIC_RELEASE, "agent");
            asm volatile("s_waitcnt vmcnt(0)" ::: "memory");
            const unsigned og = xb_add(&bar[XB_TOP], 1u);
            const unsigned tg = og / nx;
            if (og + 1u == (tg + 1u) * nx) xb_add(&bar[XB_TOPGEN], 1u);
            else XB_SPIN(xb_ld(&bar[XB_TOPGEN]) == tg, bar);
            __builtin_amdgcn_fence(__ATOMIC_ACQUIRE, "agent");
            xb_add(&bar[XB_XGEN(b.x)], 1u);
            asm volatile("s_waitcnt vmcnt(0)" ::: "memory");
        } else {
            XB_SPIN(xb_ld(&bar[XB_XGEN(b.x)]) == gen, bar);
            __builtin_amdgcn_fence(__ATOMIC_ACQUIRE, "agent");
            asm volatile("s_waitcnt vmcnt(0)" ::: "memory");
        }
    }
    __syncthreads();
}

constexpr int RING_OFF = 0, RING_BYTES = 131072;
constexpr int MISC_OFF = RING_BYTES;
constexpr int TAB_OFF = MISC_OFF + 512;
constexpr int LDS_BYTES = RING_BYTES + 4096;
constexpr int NWAVES = 8;

struct Frame {
    LAS unsigned char* lds;
    volatile LAS unsigned* MISC;
    gu32* ctl;
    int tid, lane, wave, vcu, G, gw, NGW;
    unsigned char* ws;
    const float* const* in;
};
#define WSP(T, off) ((T*)(F.ws + (off)))
#define OPAQUE_IDS() int tid_ = F.tid; asm volatile("" : "+v"(tid_)); const int lane_ = tid_ & 63; const int wave_ = __builtin_amdgcn_readfirstlane(tid_ >> 6); (void)lane_; (void)wave_

__device__ __forceinline__ f32x4 mm16(const bf16* X, size_t ldx, const bf16* Y, size_t ldy, int K, f32x4 acc, int lane) {
    const int r = lane & 15, kg = lane >> 4;
    const GAS bf16* xp = (const GAS bf16*)X + (size_t)r * ldx + kg * 8; const GAS bf16* yp = (const GAS bf16*)Y + (size_t)r * ldy + kg * 8;
#pragma unroll 1
    for (int k = 0; k < K; k += 256) {
        bf16x8 xa[8], ya[8];
#pragma unroll
        for (int s = 0; s < 8; ++s) { xa[s] = *(const GAS bf16x8*)(xp + k + 32 * s); ya[s] = *(const GAS bf16x8*)(yp + k + 32 * s); }
#pragma unroll
        for (int s = 0; s < 8; ++s) acc = __builtin_amdgcn_mfma_f32_16x16x32_bf16(xa[s], ya[s], acc, 0, 0, 0);
    }
    return acc;
}

__device__ __forceinline__ f32x4 mm16_f8(const unsigned char* X, size_t ldx, const unsigned char* Y, size_t ldy, int K, f32x4 acc, int lane) {
    const int r = lane & 15, kg = lane >> 4;
    const GAS unsigned char* xp = (const GAS unsigned char*)X + (size_t)r * ldx + kg * 32; const GAS unsigned char* yp = (const GAS unsigned char*)Y + (size_t)r * ldy + kg * 32;
#pragma unroll 1
    for (int k = 0; k < K; k += 512) {
        pg8::v8i_t xa[4], ya[4];
#pragma unroll
        for (int s = 0; s < 4; ++s) { xa[s] = *(const GAS pg8::v8i_t*)(xp + k + 128 * s); ya[s] = *(const GAS pg8::v8i_t*)(yp + k + 128 * s); }
#pragma unroll
        for (int s = 0; s < 4; ++s) acc = __builtin_amdgcn_mfma_scale_f32_16x16x128_f8f6f4(xa[s], ya[s], acc, 0, 0, 0, 0x7f7f7f7f, 0, 0x7f7f7f7f);
    }
    return acc;
}

__device__ __forceinline__ void transpose_item(const float* W, size_t ldw, int K, bf16* WT, int csrc, int drow, int k0, LAS float* scr, int lane) {
    const GAS float* Wg = (const GAS float*)W;
#pragma unroll 8
    for (int i = 0; i < 32; ++i) { const int kk = 2 * i + (lane >> 5); scr[kk * 33 + (lane & 31)] = Wg[(size_t)(k0 + kk) * ldw + csrc + (lane & 31)]; }
    LDS_WAIT(); asm volatile("" ::: "memory");
    const int c = lane & 7;
#pragma unroll
    for (int j = 0; j < 4; ++j) { const int n = (lane >> 3) + 8 * j; const LAS float* s = scr + (8 * c) * 33 + n;
        v4u o; o.x = cvt_pk_bf16(s[0 * 33], s[1 * 33]); o.y = cvt_pk_bf16(s[2 * 33], s[3 * 33]); o.z = cvt_pk_bf16(s[4 * 33], s[5 * 33]); o.w = cvt_pk_bf16(s[6 * 33], s[7 * 33]);
        *(GAS v4u*)(WT + (size_t)(drow + n) * K + k0 + 8 * c) = o; }
    LDS_WAIT(); asm volatile("" ::: "memory");
}
__device__ __forceinline__ unsigned pk4_fp8(float a, float b, float c, float d) { int p = __builtin_amdgcn_cvt_pk_fp8_f32(a, b, 0, false); p = __builtin_amdgcn_cvt_pk_fp8_f32(c, d, p, true); return (unsigned)p; }
__device__ __forceinline__ void transpose_item_f8(const float* W, size_t ldw, int K, unsigned char* WT8, int csrc, int drow, int k0, LAS float* scr, int lane, float scale) {
    const GAS float* Wg = (const GAS float*)W;
#pragma unroll 8
    for (int i = 0; i < 32; ++i) { const int kk = 2 * i + (lane >> 5); scr[kk * 33 + (lane & 31)] = Wg[(size_t)(k0 + kk) * ldw + csrc + (lane & 31)] * scale; }
    LDS_WAIT(); asm volatile("" ::: "memory");
    const int c = lane & 3;
#pragma unroll
    for (int j = 0; j < 2; ++j) { const int n = (lane >> 2) + 16 * j; const LAS float* s = scr + (16 * c) * 33 + n;
        v4u o; o.x = pk4_fp8(s[0 * 33], s[1 * 33], s[2 * 33], s[3 * 33]); o.y = pk4_fp8(s[4 * 33], s[5 * 33], s[6 * 33], s[7 * 33]);
        o.z = pk4_fp8(s[8 * 33], s[9 * 33], s[10 * 33], s[11 * 33]); o.w = pk4_fp8(s[12 * 33], s[13 * 33], s[14 * 33], s[15 * 33]);
        *(GAS v4u*)(WT8 + (size_t)(drow + n) * K + k0 + 16 * c) = o; }
    LDS_WAIT(); asm volatile("" ::: "memory");
}
constexpr int IT_INA = 32 * 96, IT_INB = 32 * 192, IT_AO = 16 * 64, IT_CO = 16 * 64, IT_O = 32 * 64, IT_GU1 = 32 * 48, IT_GU = NE * IT_GU1, IT_DN1 = 12 * 64, IT_DN = NE * IT_DN1;
constexpr int IT_LAYER = IT_INA + IT_INB + IT_AO + IT_CO + IT_O + IT_GU + IT_DN;
__device__ __forceinline__ void p0_convert(Frame& F) {
    OPAQUE_IDS();
    LAS float* scr = (LAS float*)(F.lds + RING_OFF + wave_ * 16384);
    for (int it = F.gw; it < DEPTH * IT_LAYER; it += F.NGW) {
        const int l = it / IT_LAYER; int r = it % IT_LAYER;
        unsigned char* wl = F.ws + WS_W + (size_t)l * W_LSTRIDE;
        if (r < IT_INA) { const int kb = r / 96, nb = r % 96; transpose_item_f8(F.in[3] + (size_t)l * DM * INCOLS, INCOLS, DM, wl + WO_IN, 32 * nb, 32 * nb, 64 * kb, scr, lane_, W8S); continue; } r -= IT_INA;
        if (r < IT_INB) { const int kb = r / 192, nb = r % 192, c = 32 * nb; int drow;
            if (c < 2048) drow = 3072 + ((c & 1023) >> 7) * 256 + (c >> 10) * 128 + (c & 127); else drow = 5120 + (c - 2048);
            transpose_item_f8(F.in[3] + (size_t)l * DM * INCOLS, INCOLS, DM, wl + WO_IN, 3088 + c, drow, 64 * kb, scr, lane_, W8S); continue; } r -= IT_INB;
        if (r < IT_AO) { const int kb = r / 64, nb = r % 64; transpose_item(F.in[5] + (size_t)l * ATTW * DM, DM, ATTW, (bf16*)(wl + WO_AO), 32 * nb, 32 * nb, 64 * kb, scr, lane_); continue; } r -= IT_AO;
        if (r < IT_CO) { const int kb = r / 64, nb = r % 64; transpose_item(F.in[10] + (size_t)l * CONVC * DM, DM, CONVC, (bf16*)(wl + WO_CO), 32 * nb, 32 * nb, 64 * kb, scr, lane_); continue; } r -= IT_CO;
        if (r < IT_O) { const int kb = r / 64, nb = r % 64; transpose_item(F.in[11] + (size_t)l * DM * DM, DM, DM, (bf16*)(wl + WO_O), 32 * nb, 32 * nb, 64 * kb, scr, lane_); continue; } r -= IT_O;
        if (r < IT_GU) { const int e = r / IT_GU1, q = r % IT_GU1, kb = q / 48, nb = q % 48, c = 32 * nb; int drow;
            if (c < DE) drow = (c >> 7) * 256 + (c & 127); else drow = ((c - DE) >> 7) * 256 + 128 + ((c - DE) & 127);
            transpose_item(F.in[17] + ((size_t)l * NE + e) * DM * (2 * DE), 2 * DE, DM, (bf16*)(wl + WO_GU) + (size_t)e * (2 * DE) * DM, c, drow, 64 * kb, scr, lane_); continue; } r -= IT_GU;
        { const int e = r / IT_DN1, q = r % IT_DN1, kb = q / 64, nb = q % 64;
            transpose_item(F.in[18] + ((size_t)l * NE + e) * DE * DM, DM, DE, (bf16*)(wl + WO_DN) + (size_t)e * DM * DE, 32 * nb, 32 * nb, 64 * kb, scr, lane_); }
    }
    const int gt = F.vcu * 512 + tid_, NGT = F.G * 512;
    bf16* WfT = WSP(bf16, WS_WF); bf16* WrT = WSP(bf16, WS_WR);
    for (int i = gt; i < DEPTH * 16 * DM; i += NGT) { const int l = i / (16 * DM), h = (i / DM) % 16, k = i % DM;
        WfT[i] = (bf16)(cvt_pk_bf16(F.in[3][((size_t)l * DM + k) * INCOLS + 3072 + h], 0.f) & 0xffffu); }
    for (int i = gt; i < DEPTH * 48 * DM; i += NGT) { const int l = i / (48 * DM), c = (i / DM) % 48, k = i % DM; float v = 0.f;
        if (c < NGRP) v = F.in[13][((size_t)l * DM + k) * NGRP + c]; else if (c < NGRP + NE) v = F.in[15][((size_t)l * DM + k) * NE + (c - NGRP)];
        WrT[i] = (bf16)(cvt_pk_bf16(v, 0.f) & 0xffffu); }
    { v4u* kb = WSP(v4u, WS_KB); v4u* vb = WSP(v4u, WS_VB);
        for (int i = gt; i < NB * 6144; i += NGT) { const int b = i / 6144, q = i % 6144; const size_t o = (size_t)b * KSEQ * 128 + q; kb[o] = (v4u){0u, 0u, 0u, 0u}; vb[o] = (v4u){0u, 0u, 0u, 0u}; } }
}

template <int MODE> __device__ __forceinline__ void norm_phase(Frame& F, const float* gain, bf16* dst, float* outf) {
    OPAQUE_IDS();
    float* RES = WSP(float, WS_RES); const bf16* Y0 = WSP(bf16, WS_Y0); const bf16* Y1 = WSP(bf16, WS_Y1);
    f32x4 g[8];
#pragma unroll
    for (int j = 0; j < 8; ++j) g[j] = ((const GAS f32x4*)gain)[lane_ + 64 * j];
    const int mend = (MODE == 3) ? MR : MT;
    for (int m = F.gw; m < mend; m += F.NGW) {
        const float* src = (MODE == 0) ? (m < MR ? F.in[0] + (size_t)m * DM : F.in[1] + (size_t)(m - MR) * DM) : RES + (size_t)m * DM;
        const GAS f32x4* sp = (const GAS f32x4*)src + lane_;
        f32x4 v[8]; float ss = 0.f;
#pragma unroll
        for (int j = 0; j < 8; ++j) v[j] = sp[64 * j];
        if (MODE == 1 || MODE == 3) {
            const GAS v2u* y0 = (const GAS v2u*)(Y0 + (size_t)m * DM) + lane_; const GAS v2u* y1 = (const GAS v2u*)(Y1 + (size_t)m * DM) + lane_;
#pragma unroll
            for (int j = 0; j < 8; ++j) { const v2u a = y0[64 * j], b = y1[64 * j];
                v[j].x += bf_lo(a.x) + bf_lo(b.x); v[j].y += bf_hi(a.x) + bf_hi(b.x); v[j].z += bf_lo(a.y) + bf_lo(b.y); v[j].w += bf_hi(a.y) + bf_hi(b.y); }
        }
#pragma unroll
        for (int j = 0; j < 8; ++j) ss += (v[j].x * v[j].x + v[j].y * v[j].y) + (v[j].z * v[j].z + v[j].w * v[j].w);
        const float rstd = 1.0f / sqrtf(wave_sum(ss) * (1.0f / DM) + RMS_EPS);
        if (MODE == 1) { GAS f32x4* rp = (GAS f32x4*)(RES + (size_t)m * DM) + lane_;
#pragma unroll
            for (int j = 0; j < 8; ++j) rp[64 * j] = v[j]; }
        if (MODE == 3) { GAS f32x4* op = (GAS f32x4*)(outf + (size_t)m * DM) + lane_;
#pragma unroll
            for (int j = 0; j < 8; ++j) op[64 * j] = v[j] * rstd * g[j];
        } else { GAS v2u* op = (GAS v2u*)(dst + (size_t)m * DM) + lane_;
#pragma unroll
            for (int j = 0; j < 8; ++j) { const f32x4 o = v[j] * rstd * g[j]; v2u w; w.x = cvt_pk_bf16(o.x, o.y); w.y = cvt_pk_bf16(o.z, o.w); op[64 * j] = w; }
            if (MODE == 0 || MODE == 1) { GAS unsigned* o8 = (GAS unsigned*)(F.ws + WS_XN8 + (size_t)m * DM) + lane_;
#pragma unroll
                for (int j = 0; j < 8; ++j) { const f32x4 o = v[j] * rstd * g[j]; o8[64 * j] = pk4_fp8(o.x, o.y, o.z, o.w); } } }
    }
}

__device__ __forceinline__ void pb_side(Frame& F, int l) {
    OPAQUE_IDS();
    const bf16* XN = WSP(bf16, WS_XN); const unsigned char* WinT = F.ws + WS_W + (size_t)l * W_LSTRIDE + WO_IN;
    const int g4 = (lane_ >> 4) * 4, y_ = lane_ & 15;
    if (F.gw < MT / 16) {
        const int rb = F.gw;
        const f32x4 a = mm16(WSP(bf16, WS_WF) + (size_t)l * 16 * DM, DM, XN + (size_t)rb * 16 * DM, DM, DM, (f32x4){0.f, 0.f, 0.f, 0.f}, lane_);
        float* LOGF = WSP(float, WS_LOGF); int y = y_; asm volatile("" : "+v"(y));
#pragma unroll 1
        for (int r = 0; r < 4; ++r) { const int h = g4 + r; const float x = a[r] + F.in[4][l * NH + h];
            const float lf = (fminf(x, 0.f) - log1pf(expf(-fabsf(x)))) * LOG2E;
            if (rb < MR / 16) { const int m = rb * 16 + y, b = m >> 11, t = m & 2047; LOGF[(size_t)(b * NH + h) * KSEQ + 64 + t] = lf; }
            else { float* lp = LOGF + (size_t)h * KSEQ + 48 + y;
_Pragma("unroll 1")
                for (int bb = 0; bb < NB; ++bb) { *lp = lf; lp += (size_t)NH * KSEQ; } } }
    }
    const int j = F.NGW - 1 - F.gw;
    if (j < 576) {
        const int tile = j >> 4, sub = j & 15;
        const unsigned char* Ym = F.ws + WS_XN8 + (size_t)MR * DM;
        if (tile >= 12 && tile < 20) {
            if (sub < 8) {
                const f32x4 a = mm16_f8(WinT + (size_t)(tile * 256 + sub * 16) * DM, DM, Ym, DM, DM, (f32x4){0.f, 0.f, 0.f, 0.f}, lane_) * W8I;
                const f32x4 bq = mm16_f8(WinT + (size_t)(tile * 256 + 128 + sub * 16) * DM, DM, Ym, DM, DM, (f32x4){0.f, 0.f, 0.f, 0.f}, lane_) * W8I;
                int y = y_; asm volatile("" : "+v"(y));
                v2u w; w.x = cvt_pk_bf16(a[0] * sigmoidf_fast(bq[0]), a[1] * sigmoidf_fast(bq[1])); w.y = cvt_pk_bf16(a[2] * sigmoidf_fast(bq[2]), a[3] * sigmoidf_fast(bq[3]));
                bf16* ZG = WSP(bf16, WS_ZG);
                bf16* zp = ZG + (size_t)y * CONVC + (tile - 12) * 128 + sub * 16 + g4;
_Pragma("unroll 1")
                for (int bb = 0; bb < NB; ++bb) { *(v2u*)zp = w; zp += (size_t)ZSEQ * CONVC; }
            }
        } else {
            f32x4 a = mm16_f8(WinT + (size_t)(tile * 256 + sub * 16) * DM, DM, Ym, DM, DM, (f32x4){0.f, 0.f, 0.f, 0.f}, lane_) * W8I;
            const int n = sub * 16 + g4;
            int y = y_; asm volatile("" : "+v"(y));
            if (tile < 4) { a = a * C2; v2u w; w.x = cvt_pk_bf16(a[0], a[1]); w.y = cvt_pk_bf16(a[2], a[3]); *(v2u*)(WSP(bf16, WS_QO) + (size_t)(MR + y) * ATTW + tile * 256 + n) = w; }
            else if (tile < 12) { v2u w; w.x = cvt_pk_bf16(a[0], a[1]); w.y = cvt_pk_bf16(a[2], a[3]); bf16* KV = (tile < 8) ? WSP(bf16, WS_KB) : WSP(bf16, WS_VB);
                bf16* kp = KV + (size_t)(48 + y) * ATTW + (tile & 3) * 256 + n;
_Pragma("unroll 1")
                for (int bb = 0; bb < NB; ++bb) { *(v2u*)kp = w; kp += (size_t)KSEQ * ATTW; } }
            else { v2u w; w.x = cvt_pk_bf16(sigmoidf_fast(a[0]), sigmoidf_fast(a[1])); w.y = cvt_pk_bf16(sigmoidf_fast(a[2]), sigmoidf_fast(a[3]));
                bf16* SG = (tile < 28) ? WSP(bf16, WS_SGA) : WSP(bf16, WS_SGC); *(v2u*)(SG + (size_t)(MR + y) * DM + ((tile - 20) & 7) * 256 + n) = w; }
        }
    }
}

struct GridSched {
    pg8::GridOrder go; const char* A; const char* B; size_t tstep;
    __device__ __forceinline__ bool next(int i, pg8::Unit& u) const { u.aux = 0; return go.tile(i, u.pm, u.pn); }
    __device__ __forceinline__ const char* opA(const pg8::Unit& u) const { return A + (size_t)u.pm * tstep; }
    __device__ __forceinline__ const char* opB(const pg8::Unit& u) const { return B + (size_t)u.pn * tstep; }
};
struct DualSched {
    pg8::GridOrder go; const char *A0, *B0, *A1, *B1; size_t tstep;
    __device__ __forceinline__ bool next(int i, pg8::Unit& u) const { u.aux = i & 1; return go.tile(i >> 1, u.pm, u.pn); }
    __device__ __forceinline__ const char* opA(const pg8::Unit& u) const { return (u.aux ? A1 : A0) + (size_t)u.pm * tstep; }
    __device__ __forceinline__ const char* opB(const pg8::Unit& u) const { return (u.aux ? B1 : B0) + (size_t)u.pn * tstep; }
};
struct MoeSched {
    const LAS int* tb; int npn, G, c; const char* A; const char* W; size_t a_tstep, w_estride, w_tstep;
    __device__ __forceinline__ bool next(int i, pg8::Unit& u) const {
        const int L = i * G + c, T = L / npn; if (T >= tb[32]) return false;
        int e = 0;
#pragma unroll 1
        for (int q = 1; q < 32; ++q) e += (tb[q] <= T) ? 1 : 0;
        u.pm = T; u.pn = L - T * npn; u.aux = e; return true; }
    __device__ __forceinline__ const char* opA(const pg8::Unit& u) const { return A + (size_t)u.pm * a_tstep; }
    __device__ __forceinline__ const char* opB(const pg8::Unit& u) const { return W + (size_t)u.aux * w_estride + (size_t)u.pn * w_tstep; }
};
typedef f32x4 Acc[2][2][4][2];
__device__ __forceinline__ v4u pack8(const f32x4 a, const f32x4 b) { v4u w; w.x = cvt_pk_bf16(a[0], a[1]); w.y = cvt_pk_bf16(a[2], a[3]); w.z = cvt_pk_bf16(b[0], b[1]); w.w = cvt_pk_bf16(b[2], b[3]); return w; }
__device__ __forceinline__ f32x4 sig4(const f32x4 a) { return (f32x4){sigmoidf_fast(a[0]), sigmoidf_fast(a[1]), sigmoidf_fast(a[2]), sigmoidf_fast(a[3])}; }
struct EpiIn {
    static constexpr bool PERM = true;
    bf16 *Q, *KB, *VB, *ZG, *SGA, *SGC;
    __device__ __forceinline__ bool keep(const pg8::Unit&) const { return false; }
    __device__ __forceinline__ void operator()(Acc& acc, const pg8::Unit& u, int wr, int wc, int fr, int fq) const {
        const int pn = u.pn, m0 = u.pm * 256, b = m0 >> 11, rl = wr * 64 + fr, cw = wc * 32 + 8 * fq;
        if (pn < 12) {
            const int which = pn >> 2; bf16* base; size_t row0; float sc = W8I;
            if (which == 0) { base = Q; row0 = (size_t)m0; sc = C2 * W8I; } else { base = (which == 1) ? KB : VB; row0 = (size_t)m0 + 64 * (b + 1); }
            base += (pn & 3) * 256 + cw;
#pragma unroll
            for (int ai = 0; ai < 2; ++ai)
#pragma unroll
                for (int m = 0; m < 4; ++m) { bf16* rowp = base + (row0 + rl + ai * 128 + m * 16) * ATTW;
#pragma unroll
                    for (int bj = 0; bj < 2; ++bj) *(GAS v4u*)(rowp + bj * 128) = pack8(acc[ai][bj][m][0] * sc, acc[ai][bj][m][1] * sc); }
        } else if (pn < 20) {
            bf16* base = ZG + (pn - 12) * 128 + cw; const size_t row0 = (size_t)m0 + 16 * (b + 1);
#pragma unroll
            for (int ai = 0; ai < 2; ++ai)
#pragma unroll
                for (int m = 0; m < 4; ++m) { bf16* rowp = base + (row0 + rl + ai * 128 + m * 16) * CONVC;
                    *(GAS v4u*)rowp = pack8(acc[ai][0][m][0] * W8I * sig4(acc[ai][1][m][0] * W8I), acc[ai][0][m][1] * W8I * sig4(acc[ai][1][m][1] * W8I)); }
        } else {
            bf16* base = ((pn < 28) ? SGA : SGC) + ((pn - 20) & 7) * 256 + cw;
#pragma unroll
            for (int ai = 0; ai < 2; ++ai)
#pragma unroll
                for (int m = 0; m < 4; ++m) { bf16* rowp = base + (size_t)(m0 + rl + ai * 128 + m * 16) * DM;
#pragma unroll
                    for (int bj = 0; bj < 2; ++bj) *(GAS v4u*)(rowp + bj * 128) = pack8(sig4(acc[ai][bj][m][0] * W8I), sig4(acc[ai][bj][m][1] * W8I)); }
        }
    }
};
struct EpiDual {
    static constexpr bool PERM = true;
    const bf16 *SGA, *SGC; bf16* MG;
    __device__ __forceinline__ bool keep(const pg8::Unit& u) const { return u.aux == 0; }
    __device__ __forceinline__ void operator()(Acc& acc, const pg8::Unit& u, int wr, int wc, int fr, int fq) const {
        const size_t off0 = (size_t)(u.pm * 256 + wr * 64 + fr) * DM + u.pn * 256 + wc * 32 + 8 * fq;
#pragma unroll
        for (int ai = 0; ai < 2; ++ai)
#pragma unroll
            for (int m = 0; m < 4; ++m)
#pragma unroll
                for (int bj = 0; bj < 2; ++bj) { const size_t off = off0 + (size_t)(ai * 128 + m * 16) * DM + bj * 128;
                    const v4u c = *(const GAS v4u*)(SGC + off);
                    const f32x4 c0 = {bf_lo(c.x), bf_hi(c.x), bf_lo(c.y), bf_hi(c.y)}, c1 = {bf_lo(c.z), bf_hi(c.z), bf_lo(c.w), bf_hi(c.w)};
                    if (u.aux == 0) { const v4u a = *(const GAS v4u*)(SGA + off);
                        const f32x4 a0 = {bf_lo(a.x), bf_hi(a.x), bf_lo(a.y), bf_hi(a.y)}, a1 = {bf_lo(a.z), bf_hi(a.z), bf_lo(a.w), bf_hi(a.w)};
#pragma unroll
                        for (int q = 0; q < 4; ++q) { acc[ai][bj][m][0][q] *= a0[q] * __builtin_amdgcn_rcpf(c0[q]); acc[ai][bj][m][1][q] *= a1[q] * __builtin_amdgcn_rcpf(c1[q]); }
                    } else *(GAS v4u*)(MG + off) = pack8(acc[ai][bj][m][0] * c0, acc[ai][bj][m][1] * c1);
                }
    }
};
struct EpiRes {
    static constexpr bool PERM = false;
    const float* base; float* out;
    __device__ __forceinline__ bool keep(const pg8::Unit&) const { return false; }
    __device__ __forceinline__ void operator()(Acc& acc, const pg8::Unit& u, int wr, int wc, int fr, int fq) const {
        const size_t off0 = (size_t)(u.pm * 256 + wr * 64 + fr) * DM + u.pn * 256 + wc * 32 + 4 * fq;
#pragma unroll
        for (int ai = 0; ai < 2; ++ai)
#pragma unroll
            for (int m = 0; m < 4; ++m)
#pragma unroll
                for (int bj = 0; bj < 2; ++bj)
#pragma unroll
                    for (int n = 0; n < 2; ++n) { const size_t off = off0 + (size_t)(ai * 128 + m * 16) * DM + bj * 128 + n * 16;
                        *(GAS f32x4*)(out + off) = *(const GAS f32x4*)(base + off) + acc[ai][bj][m][n]; }
    }
};
struct EpiGlu {
    static constexpr bool PERM = true;
    bf16* H;
    __device__ __forceinline__ bool keep(const pg8::Unit&) const { return false; }
    __device__ __forceinline__ void operator()(Acc& acc, const pg8::Unit& u, int wr, int wc, int fr, int fq) const {
        bf16* base = H + (size_t)(u.pm * 256 + wr * 64 + fr) * DE + u.pn * 128 + wc * 32 + 8 * fq;
#pragma unroll
        for (int ai = 0; ai < 2; ++ai)
#pragma unroll
            for (int m = 0; m < 4; ++m) { const f32x4 g0 = acc[ai][0][m][0], g1 = acc[ai][0][m][1];
                *(GAS v4u*)(base + (size_t)(ai * 128 + m * 16) * DE) = pack8(g0 * sig4(g0) * acc[ai][1][m][0], g1 * sig4(g1) * acc[ai][1][m][1]); }
    }
};
struct EpiDown {
    static constexpr bool PERM = true;
    const LAS int* tb; const LAS int* cn; const int* perm; const float* wts; bf16 *Y0, *Y1;
    __device__ __forceinline__ bool keep(const pg8::Unit&) const { return false; }
    __device__ __forceinline__ void operator()(Acc& acc, const pg8::Unit& u, int wr, int wc, int fr, int fq) const {
        const int e = u.aux, r0 = (u.pm - tb[e]) * 256 + wr * 64 + fr, cnt = cn[e], col = u.pn * 256 + wc * 32 + 8 * fq;
#pragma unroll
        for (int ai = 0; ai < 2; ++ai)
#pragma unroll
            for (int m = 0; m < 4; ++m) { const int r = r0 + ai * 128 + m * 16;
                if (r < cnt) { const int id = perm[(size_t)e * PCAP + r]; const float w = wts[id]; bf16* rowp = ((id & 1) ? Y1 : Y0) + (size_t)(id >> 1) * DM + col;
#pragma unroll
                    for (int bj = 0; bj < 2; ++bj) *(GAS v4u*)(rowp + bj * 128) = pack8(acc[ai][bj][m][0] * w, acc[ai][bj][m][1] * w); } }
    }
};

__device__ __forceinline__ void cum_table(Frame& F, int bh) {
    int tid_ = F.tid; asm volatile("" : "+v"(tid_)); const int lane = tid_ & 63, wave = __builtin_amdgcn_readfirstlane(tid_ >> 6);
    LAS float* cs = (LAS float*)(F.lds + RING_OFF + attn_body::LDS_CS); LAS float* tot = (LAS float*)(F.lds + RING_OFF + attn_body::LDS_TOT);
    const GAS float* lf = (const GAS float*)WSP(float, WS_LOGF) + (size_t)bh * KSEQ;
    constexpr int NCH = KSEQ / 64;
    for (int c = wave; c < NCH; c += NWAVES) { const int row = 64 * c + lane; float v = (row >= 48) ? lf[row] : 0.f;
#pragma unroll
        for (int o = 1; o < 64; o <<= 1) { const float t = shfl_idx(v, lane - o); if (lane >= o) v += t; }
        cs[row] = v; if (lane == 63) tot[c] = v; }
    LDS_WAIT(); __syncthreads();
    float tv = (lane < NCH) ? tot[lane] : 0.f, inc = tv;
#pragma unroll
    for (int o = 1; o < 64; o <<= 1) { const float t = shfl_idx(inc, lane - o); if (lane >= o) inc += t; }
    const float exc = inc - tv;
    for (int c = wave; c < NCH; c += NWAVES) { const int row = 64 * c + lane; const float off = __int_as_float(__builtin_amdgcn_readlane(__float_as_int(exc), c));
        cs[row] = (row >= 48) ? cs[row] + off : INFINITY; }
    LDS_WAIT(); __syncthreads();
}
__device__ __forceinline__ void meta_attn_head(Frame& F, int h) {
    OPAQUE_IDS();
    const bf16* Qm = WSP(bf16, WS_QO) + (size_t)MR * ATTW + h * HD; const bf16* Km = WSP(bf16, WS_KB) + (size_t)48 * ATTW + h * HD; const bf16* Vm = WSP(bf16, WS_VB) + (size_t)48 * ATTW + h * HD;
    const float* lf = WSP(float, WS_LOGF) + (size_t)h * KSEQ + 48;
    const int i = lane_ & 15, qd = (lane_ >> 4) * 16;
    float q[16];
#pragma unroll
    for (int d = 0; d < 16; ++d) q[d] = bf_lo((unsigned)Qm[(size_t)i * ATTW + qd + d]);
    float cum[16]; { float c = 0.f;
#pragma unroll
        for (int j = 0; j < 16; ++j) { c += lf[j]; cum[j] = c; } }
    float ci = 0.f;
#pragma unroll
    for (int j = 0; j < 16; ++j) ci = (j == i) ? cum[j] : ci;
    float s[16], mx = -INFINITY;
#pragma unroll
    for (int j = 0; j < 16; ++j) { float p = 0.f;
#pragma unroll
        for (int d = 0; d < 16; ++d) p += q[d] * bf_lo((unsigned)Km[(size_t)j * ATTW + qd + d]);
        p += swz_xor<16>(p); p = xor32_sum(p);
        s[j] = (j <= i) ? p + ci - cum[j] : -INFINITY; mx = fmaxf(mx, s[j]); }
    float den = 0.f, o[16];
#pragma unroll
    for (int d = 0; d < 16; ++d) o[d] = 0.f;
#pragma unroll
    for (int j = 0; j < 16; ++j) { const float p = __builtin_amdgcn_exp2f(s[j] - mx); den += p;
#pragma unroll
        for (int d = 0; d < 16; ++d) o[d] += p * bf_lo((unsigned)Vm[(size_t)j * ATTW + qd + d]); }
    const float inv = 1.0f / den;
    bf16* Om = WSP(bf16, WS_QO) + (size_t)(MR + i) * ATTW + h * HD + qd;
#pragma unroll
    for (int d = 0; d < 16; d += 2) *(unsigned*)(Om + d) = cvt_pk_bf16(o[d] * inv, o[d + 1] * inv);
}
__device__ __forceinline__ void conv_item(Frame& F, int l, int b, int p0, int out_row0) {
    int tid_ = F.tid; asm volatile("" : "+v"(tid_));
    const int c2 = tid_ * 2;
    const float* cw = F.in[6] + (size_t)l * CONVK * CONVC; const float cb0 = F.in[7][l * CONVC + c2], cb1 = F.in[7][l * CONVC + c2 + 1];
    LAS float* zb = (LAS float*)(F.lds + RING_OFF);
    f32x2 w[CONVK];
#pragma unroll
    for (int j = 0; j < CONVK; ++j) w[j] = *(const GAS f32x2*)(cw + (size_t)j * CONVC + c2);
    LAS unsigned char* win = F.lds + RING_OFF;
    { const GAS char* zsrc = (const GAS char*)WSP(bf16, WS_ZG) + ((size_t)b * ZSEQ + p0 - 30) * (CONVC * 2);
#pragma unroll
      for (int k = 0; k < 12; ++k) { const int q = tid_ + 512 * k; if (q < 46 * 128) { v4u v = {0u, 0u, 0u, 0u}; if (p0 - 30 + (q >> 7) >= 0) v = *(const GAS v4u*)(zsrc + (size_t)q * 16); *(LAS v4u*)(win + q * 16) = v; } } }
    LDS_WAIT(); __syncthreads();
    f32x2 a[16];
#pragma unroll
    for (int o = 0; o < 16; ++o) a[o] = (f32x2){cb0, cb1};
#pragma unroll
    for (int i = 0; i < 46; ++i) { const unsigned u = *(const LAS unsigned*)(win + i * (CONVC * 2) + tid_ * 4);
        const f32x2 x = {bf_lo(u), bf_hi(u)};
#pragma unroll
        for (int o = 0; o < 16; ++o) if (i - o >= 0 && i - o < CONVK) a[o] += w[i - o] * x; }
    LDS_WAIT(); __syncthreads();
#pragma unroll
    for (int o = 0; o < 16; ++o) *(LAS f32x2*)(zb + o * CONVC + c2) = a[o];
    LDS_WAIT(); __syncthreads();
    const int ln = tid_ & 63, wv_ = tid_ >> 6;
    const float* lg = F.in[8] + (size_t)l * CONVC; const float* lb = F.in[9] + (size_t)l * CONVC;
#pragma unroll
    for (int rr = 0; rr < 2; ++rr) { const int o = wv_ * 2 + rr;
        f32x4 v[4]; float s = 0.f;
#pragma unroll
        for (int j = 0; j < 4; ++j) { v[j] = *(const LAS f32x4*)(zb + o * CONVC + 4 * (ln + 64 * j)); s += (v[j].x + v[j].y) + (v[j].z + v[j].w); }
        const float mu = wave_sum(s) * (1.0f / CONVC); float q = 0.f;
#pragma unroll
        for (int j = 0; j < 4; ++j) { v[j] = v[j] - mu; q += (v[j].x * v[j].x + v[j].y * v[j].y) + (v[j].z * v[j].z + v[j].w * v[j].w); }
        const float rstd = 1.0f / sqrtf(wave_sum(q) * (1.0f / CONVC) + LN_EPS);
        bf16* op = WSP(bf16, WS_CV) + (size_t)(out_row0 + o) * CONVC;
#pragma unroll
        for (int j = 0; j < 4; ++j) { const int c = 4 * (ln + 64 * j); const f32x4 gg = *(const GAS f32x4*)(lg + c), bb = *(const GAS f32x4*)(lb + c);
            f32x4 z = v[j] * rstd * gg + bb; z = z * sig4(z); v2u wv; wv.x = cvt_pk_bf16(z.x, z.y); wv.y = cvt_pk_bf16(z.z, z.w); *(GAS v2u*)(op + c) = wv; } }
    __syncthreads();
}
__device__ __forceinline__ void pc_phase(Frame& F, int l, char* ldsg) {
    for (int v = F.vcu; v < 2 * NB * NH; v += F.G) {
        const int bh = v >> 1, s0 = 2 * (v & 1);
        cum_table(F, bh);
        const __hip_bfloat16* Q = (const __hip_bfloat16*)WSP(bf16, WS_QO); const __hip_bfloat16* K = (const __hip_bfloat16*)WSP(bf16, WS_KB); const __hip_bfloat16* V = (const __hip_bfloat16*)WSP(bf16, WS_VB);
#pragma unroll 1
        for (int i = 0; i < 4; ++i) { const int qb = (i == 0) ? s0 : (i == 1) ? 7 - s0 : (i == 2) ? s0 + 1 : 6 - s0;
#ifndef NO_ATTN
            attn_body::attn_unit<8>(bh / NH, bh % NH, qb, Q, K, V, (__hip_bfloat16*)WSP(bf16, WS_QO), ldsg + RING_OFF);
#endif
        }
        __syncthreads();
    }
#ifndef NO_MATTN
    if (F.vcu >= F.G - 2) meta_attn_head(F, (F.vcu - (F.G - 2)) * 8 + F.wave);
#endif
    __syncthreads();
#ifndef NO_CONV
    for (int it = F.vcu; it < MR / 16 + 1; it += F.G) {
        const bool real = it < MR / 16; const int b = real ? it >> 7 : 0, t0 = (it & 127) * 16;
        conv_item(F, l, b, real ? NMETA + t0 : 0, real ? b * SEQ + t0 : MR);
    }
#endif
}
__device__ __forceinline__ void pd_side(Frame& F, int l) {
    OPAQUE_IDS();
    const int j = F.NGW - 1 - F.gw; if (j >= DM / 16) return;
    const unsigned char* wl = F.ws + WS_W + (size_t)l * W_LSTRIDE; const int g4 = (lane_ >> 4) * 4, y = lane_ & 15;
    const f32x4 a1 = mm16((const bf16*)(wl + WO_AO) + (size_t)j * 16 * ATTW, ATTW, WSP(bf16, WS_QO) + (size_t)MR * ATTW, ATTW, ATTW, (f32x4){0.f, 0.f, 0.f, 0.f}, lane_);
    const f32x4 a2 = mm16((const bf16*)(wl + WO_CO) + (size_t)j * 16 * CONVC, CONVC, WSP(bf16, WS_CV) + (size_t)MR * CONVC, CONVC, CONVC, (f32x4){0.f, 0.f, 0.f, 0.f}, lane_);
    const size_t off = (size_t)(MR + y) * DM + j * 16 + g4;
    const v2u ga = *(const GAS v2u*)(WSP(bf16, WS_SGA) + off), gc = *(const GAS v2u*)(WSP(bf16, WS_SGC) + off);
    v2u w; w.x = cvt_pk_bf16(bf_lo(ga.x) * a1[0] + bf_lo(gc.x) * a2[0], bf_hi(ga.x) * a1[1] + bf_hi(gc.x) * a2[1]);
    w.y = cvt_pk_bf16(bf_lo(ga.y) * a1[2] + bf_lo(gc.y) * a2[2], bf_hi(ga.y) * a1[3] + bf_hi(gc.y) * a2[3]);
    *(GAS v2u*)(WSP(bf16, WS_MG) + off) = w;
}
__device__ __forceinline__ void pe_side(Frame& F, int l) {
    OPAQUE_IDS();
    const int j = F.NGW - 1 - F.gw; if (j >= DM / 16) return;
    const unsigned char* wl = F.ws + WS_W + (size_t)l * W_LSTRIDE; const int g4 = (lane_ >> 4) * 4, y = lane_ & 15;
    const f32x4 a = mm16((const bf16*)(wl + WO_O) + (size_t)j * 16 * DM, DM, WSP(bf16, WS_MG) + (size_t)MR * DM, DM, DM, (f32x4){0.f, 0.f, 0.f, 0.f}, lane_);
    const float* base = (l == 0) ? F.in[1] + (size_t)y * DM + j * 16 + g4 : WSP(float, WS_RES) + (size_t)(MR + y) * DM + j * 16 + g4;
    const f32x4 bv = *(const GAS f32x4*)base;
    *(GAS f32x4*)(WSP(float, WS_RES) + (size_t)(MR + y) * DM + j * 16 + g4) = bv + a;
}
__device__ __forceinline__ void pg_router(Frame& F, int l) {
    OPAQUE_IDS();
    if (F.gw >= MT / 16) return;
    const int rb = F.gw, g4 = (lane_ >> 4) * 4, y = lane_ & 15;
    LAS float* scr = (LAS float*)(F.lds + RING_OFF) + wave_ * (16 * 49);
    const bf16* Yp = WSP(bf16, WS_N2) + (size_t)rb * 16 * DM; const bf16* WrT = WSP(bf16, WS_WR) + (size_t)l * 48 * DM;
#pragma unroll
    for (int blk = 0; blk < 3; ++blk) { const f32x4 a = mm16(WrT + (size_t)blk * 16 * DM, DM, Yp, DM, DM, (f32x4){0.f, 0.f, 0.f, 0.f}, lane_);
#pragma unroll
        for (int r = 0; r < 4; ++r) scr[y * 49 + blk * 16 + g4 + r] = a[r]; }
    LDS_WAIT(); asm volatile("" ::: "memory");
    if (lane_ < 16) {
        const LAS float* lg = scr + lane_ * 49; const int m = rb * 16 + lane_;
        float gl[NGRP]; int gi = 0;
#pragma unroll
        for (int g = 0; g < NGRP; ++g) gl[g] = lg[g] + F.in[14][l * NGRP + g];
#pragma unroll
        for (int g = 1; g < NGRP; ++g) if (gl[g] > gl[gi]) gi = g;
        float gmax = gl[0];
#pragma unroll
        for (int g = 1; g < NGRP; ++g) gmax = fmaxf(gmax, gl[g]);
        float den = 0.f;
#pragma unroll
        for (int g = 0; g < NGRP; ++g) den += expf(gl[g] - gmax);
        const float gw = 1.0f / den;
        float ev[EPG];
#pragma unroll
        for (int i = 0; i < EPG; ++i) ev[i] = lg[NGRP + gi * EPG + i] + F.in[16][l * NE + gi * EPG + i];
        int i0 = 0;
#pragma unroll
        for (int i = 1; i < EPG; ++i) if (ev[i] > ev[i0]) i0 = i;
        float v0 = ev[0];
#pragma unroll
        for (int i = 1; i < EPG; ++i) v0 = fmaxf(v0, ev[i]);
        int i1 = (i0 == 0) ? 1 : 0; float v1 = -INFINITY;
#pragma unroll
        for (int i = 0; i < EPG; ++i) if (i != i0 && ev[i] > v1) { v1 = ev[i]; i1 = i; }
        const float w0 = gw / (1.0f + expf(v1 - v0)), w1 = gw - w0;
        unsigned* cnt = (unsigned*)(F.ctl + CW_CNT + l * 64); int* perm = WSP(int, WS_PERM); float* wts = WSP(float, WS_WTS);
        const int e0 = gi * EPG + i0, e1 = gi * EPG + i1;
        const unsigned q0 = __hip_atomic_fetch_add(cnt + e0, 1u, RLX_AGENT), q1 = __hip_atomic_fetch_add(cnt + e1, 1u, RLX_AGENT);
        perm[(size_t)e0 * PCAP + q0] = 2 * m; perm[(size_t)e1 * PCAP + q1] = 2 * m + 1; wts[2 * m] = w0; wts[2 * m + 1] = w1;
    }
}
__device__ __forceinline__ void moe_tables(Frame& F, int l) {
    OPAQUE_IDS();
    LAS int* tb = (LAS int*)(F.lds + TAB_OFF); LAS int* cn = tb + 40;
    if (wave_ == 0) { const int c = (lane_ < NE) ? (int)__hip_atomic_load((unsigned*)(F.ctl + CW_CNT + l * 64 + lane_), RLX_AGENT) : 0; int nt = (c + 255) >> 8, inc = nt;
#pragma unroll
        for (int o = 1; o < 64; o <<= 1) { const int t = shfl_idx_i(inc, lane_ - o); if (lane_ >= o) inc += t; }
        if (lane_ < NE) { tb[lane_] = inc - nt; cn[lane_] = c; } if (lane_ == NE) tb[NE] = inc; }
    LDS_WAIT(); __syncthreads();
}
__device__ __forceinline__ void ph0_gather(Frame& F) {
    OPAQUE_IDS();
    const LAS int* tb = (const LAS int*)(F.lds + TAB_OFF); const LAS int* cn = tb + 40;
    const int nrows = tb[NE] * 256; const int* perm = WSP(int, WS_PERM);
    for (int row = F.gw; row < nrows; row += F.NGW) {
        const int T = row >> 8; int e = 0;
#pragma unroll 1
        for (int q = 1; q < NE; ++q) e += (tb[q] <= T) ? 1 : 0;
        const int r = row - tb[e] * 256;
        GAS v4u* dp = (GAS v4u*)(WSP(bf16, WS_XS) + (size_t)row * DM) + lane_;
        if (r < cn[e]) { const int tok = perm[(size_t)e * PCAP + r] >> 1; const GAS v4u* sp = (const GAS v4u*)(WSP(bf16, WS_N2) + (size_t)tok * DM) + lane_;
#pragma unroll
            for (int j = 0; j < 4; ++j) dp[64 * j] = sp[64 * j];
        } else {
#pragma unroll
            for (int j = 0; j < 4; ++j) dp[64 * j] = (v4u){0u, 0u, 0u, 0u}; }
    }
}

struct Args { const float* in[20]; float* out; unsigned char* ws; int ph_lo, ph_hi; };
constexpr int N_PHASES = 22;
__global__ void __launch_bounds__(NWAVES * 64, 2) fox_fwd(Args args) {
    extern __shared__ __attribute__((aligned(16))) unsigned char lds[];
#ifdef USE_AGPR_HINT
    { float dummy_ = 0.f; asm volatile("" :: "a"(dummy_)); }
#endif
    Frame F;
    F.lds = (LAS unsigned char*)lds; F.MISC = (volatile LAS unsigned*)(F.lds + MISC_OFF);
    F.tid = threadIdx.x; F.lane = F.tid & 63; F.wave = __builtin_amdgcn_readfirstlane(F.tid >> 6);
    F.G = gridDim.x; { const int bx = blockIdx.x; F.vcu = (F.G % 8 == 0) ? (bx % 8) * (F.G / 8) + bx / 8 : bx; }
    F.gw = F.vcu * NWAVES + F.wave; F.NGW = F.G * NWAVES;
    F.ws = args.ws; F.in = args.in; F.ctl = (gu32*)(args.ws + WS_CTL);
    for (int u = F.tid; u < (LDS_BYTES - MISC_OFF) / 4; u += NWAVES * 64) ((LAS unsigned*)(F.lds + MISC_OFF))[u] = 0u;
    __syncthreads();
    const int lo = args.ph_lo, hi = args.ph_hi;
    const bool one_launch = (hi - lo) > 1;
    XcdBarrier bar; bar.bar = (unsigned*)(F.ctl + CW_BAR); bar.x = 0; bar.st = nullptr;
    if (one_launch) bar = xcd_barrier_post((unsigned*)(F.ctl + CW_BAR), F.MISC + 8);
#ifndef PH_MASK
#define PH_MASK 0xffffffffu
#endif
#define IN(k) (((PH_MASK >> ((k) > 10 ? (k) - 10 : (k))) & 1u) && lo <= (k) && (k) < hi)
#define SEAM(k) do { if (IN(k) && IN((k) + 1)) xcd_barrier(bar); } while (0)
    LAS unsigned char* ring = F.lds + RING_OFF;
    const int bx = (int)blockIdx.x;

    if (IN(0)) { p0_convert(F); norm_phase<0>(F, F.in[2], WSP(bf16, WS_XN), nullptr); }
    SEAM(0);
#pragma unroll 1
    for (int l = 0; l < DEPTH; ++l) {
        const int P = 1 + 10 * l;
        const unsigned char* wl = F.ws + WS_W + (size_t)l * W_LSTRIDE;
        if (l > 0) { if (IN(P)) norm_phase<1>(F, F.in[2] + (size_t)l * DM, WSP(bf16, WS_XN), nullptr); SEAM(P); }
        if (IN(P + 1)) {
#ifndef NO_PBSIDE
            pb_side(F, l); VM_WAIT(); __syncthreads();
#endif
            GridSched S; S.go.init(MR / 256, 36, F.G, bx); S.A = (const char*)(F.ws + WS_XN8); S.B = (const char*)(wl + WO_IN); S.tstep = (size_t)256 * DM;
            EpiIn E{WSP(bf16, WS_QO), WSP(bf16, WS_KB), WSP(bf16, WS_VB), WSP(bf16, WS_ZG), WSP(bf16, WS_SGA), WSP(bf16, WS_SGC)};
#ifndef NO_PBGEMM
            pg8::gemm_phase<EpiIn, GridSched, true, true>(ring, DM, S, E);
#endif
        }
        SEAM(P + 1);
        if (IN(P + 2)) pc_phase(F, l, (char*)lds);
        SEAM(P + 2);
        if (IN(P + 3)) {
            pd_side(F, l); VM_WAIT(); __syncthreads();
            DualSched S; S.go.init(MR / 256, DM / 256, F.G, bx); S.A0 = (const char*)WSP(bf16, WS_QO); S.B0 = (const char*)(wl + WO_AO); S.A1 = (const char*)WSP(bf16, WS_CV); S.B1 = (const char*)(wl + WO_CO); S.tstep = (size_t)256 * ATTW * 2;
            EpiDual E{WSP(bf16, WS_SGA), WSP(bf16, WS_SGC), WSP(bf16, WS_MG)};
            pg8::gemm_phase<EpiDual, DualSched, true>(ring, ATTW * 2, S, E);
        }
        SEAM(P + 3);
        if (IN(P + 4)) {
            pe_side(F, l); VM_WAIT(); __syncthreads();
            GridSched S; S.go.init(MR / 256, DM / 256, F.G, bx); S.A = (const char*)WSP(bf16, WS_MG); S.B = (const char*)(wl + WO_O); S.tstep = (size_t)256 * DM * 2;
            EpiRes E{(l == 0) ? F.in[0] : WSP(float, WS_RES), WSP(float, WS_RES)};
            pg8::gemm_phase<EpiRes, GridSched, true>(ring, DM * 2, S, E);
        }
        SEAM(P + 4);
        if (IN(P + 5)) norm_phase<2>(F, F.in[12] + (size_t)l * DM, WSP(bf16, WS_N2), nullptr);
        SEAM(P + 5);
        if (IN(P + 6)) pg_router(F, l);
        SEAM(P + 6);
        if (IN(P + 7)) { moe_tables(F, l); ph0_gather(F); }
        SEAM(P + 7);
        if (IN(P + 8)) {
            moe_tables(F, l);
            MoeSched S; S.tb = (const LAS int*)(F.lds + TAB_OFF); S.npn = DE / 128; S.G = F.G; S.c = bx; S.A = (const char*)WSP(bf16, WS_XS); S.W = (const char*)(wl + WO_GU);
            S.a_tstep = (size_t)256 * DM * 2; S.w_estride = (size_t)(2 * DE) * DM * 2; S.w_tstep = (size_t)256 * DM * 2;
            EpiGlu E{WSP(bf16, WS_H)};
            pg8::gemm_phase<EpiGlu, MoeSched, true>(ring, DM * 2, S, E);
        }
        SEAM(P + 8);
        if (IN(P + 9)) {
            moe_tables(F, l);
            MoeSched S; S.tb = (const LAS int*)(F.lds + TAB_OFF); S.npn = DM / 256; S.G = F.G; S.c = bx; S.A = (const char*)WSP(bf16, WS_H); S.W = (const char*)(wl + WO_DN);
            S.a_tstep = (size_t)256 * DE * 2; S.w_estride = (size_t)DM * DE * 2; S.w_tstep = (size_t)256 * DE * 2;
            EpiDown E{(const LAS int*)(F.lds + TAB_OFF), (const LAS int*)(F.lds + TAB_OFF) + 40, WSP(int, WS_PERM), WSP(float, WS_WTS), WSP(bf16, WS_Y0), WSP(bf16, WS_Y1)};
            pg8::gemm_phase<EpiDown, MoeSched, true>(ring, DE * 2, S, E);
        }
        SEAM(P + 9);
    }
#if DBG_DUMP == 0
    if (IN(21)) norm_phase<3>(F, F.in[19], nullptr, args.out);
#else
    if (IN(21)) {
        for (size_t i = (size_t)blockIdx.x * 512 + threadIdx.x; i < (size_t)MR * DM; i += (size_t)gridDim.x * 512) { const size_t m = i / DM, c = i % DM; float v = 0.f;
            if (DBG_DUMP == 1) v = WSP(float, WS_RES)[i];
            else if (DBG_DUMP == 2) v = bf_lo(WSP(bf16, WS_Y0)[i]) + bf_lo(WSP(bf16, WS_Y1)[i]);
            else if (DBG_DUMP == 3) v = bf_lo(WSP(bf16, WS_MG)[i]);
            else if (DBG_DUMP == 4) v = (c < 1024) ? bf_lo(WSP(bf16, WS_QO)[m * 1024 + c]) : bf_lo(WSP(bf16, WS_CV)[m * 1024 + c - 1024]);
            else if (DBG_DUMP == 5) v = bf_lo(WSP(bf16, WS_XN)[i]);
            else if (DBG_DUMP == 6) v = bf_lo(WSP(bf16, WS_SGA)[i]) + bf_lo(WSP(bf16, WS_SGC)[i]);
            else if (DBG_DUMP == 7) v = bf_lo(WSP(bf16, WS_N2)[i]);
            else if (DBG_DUMP == 8) { const size_t b = m >> 11, t = m & 2047; v = (c < 1024) ? bf_lo(WSP(bf16, WS_KB)[(b * KSEQ + 64 + t) * 1024 + c]) : bf_lo(WSP(bf16, WS_ZG)[(b * ZSEQ + 16 + t) * 1024 + c - 1024]); }
            args.out[i] = v; }
    }
#endif
#undef IN
#undef SEAM
}

extern "C" void kernel_launch(void* const* d_in, const int* in_sizes, int n_in, void* d_out, int out_size, void* d_ws, size_t ws_size, hipStream_t stream) {
    static int grid = 0;
    if (grid == 0) {
        if (n_in != 20 || out_size != MR * DM || ws_size < WS_END) { fprintf(stderr, "kernel_launch: unexpected problem (n_in %d, out %d, ws %zu); nothing launched\n", n_in, out_size, ws_size); grid = -1; return; }
        int dev = 0, cus = 0, per_cu = 0;
        if (hipGetDevice(&dev) != hipSuccess || hipDeviceGetAttribute(&cus, hipDeviceAttributeMultiprocessorCount, dev) != hipSuccess) { grid = -1; return; }
        if (hipFuncSetAttribute((const void*)fox_fwd, hipFuncAttributeMaxDynamicSharedMemorySize, LDS_BYTES) != hipSuccess) { fprintf(stderr, "kernel_launch: hipFuncSetAttribute failed\n"); grid = -1; return; }
        if (hipOccupancyMaxActiveBlocksPerMultiprocessor(&per_cu, (const void*)fox_fwd, NWAVES * 64, LDS_BYTES) != hipSuccess || per_cu < 1) { fprintf(stderr, "kernel_launch: occupancy query says %d\n", per_cu); }
        (void)hipGetLastError();
        grid = cus;
    }
    if (grid < 0) return;
    if (hipMemsetAsync((char*)d_ws + WS_CTL, 0, CTL_ZERO_BYTES, stream) != hipSuccess) return;
    Args a{};
    for (int i = 0; i < 20; ++i) a.in[i] = (const float*)d_in[i];
    a.out = (float*)d_out; a.ws = (unsigned char*)d_ws;
#if MK_N_LAUNCHES == 1
    a.ph_lo = 0; a.ph_hi = N_PHASES;
    hipLaunchKernelGGL(fox_fwd, dim3(grid), dim3(NWAVES * 64), LDS_BYTES, stream, a);
#else
    for (int p = 0; p < N_PHASES; ++p) { if (p == 1 || (p > DBG_STOP && p != N_PHASES - 1)) continue; a.ph_lo = p; a.ph_hi = p + 1; hipLaunchKernelGGL(fox_fwd, dim3(grid), dim3(NWAVES * 64), LDS_BYTES, stream, a); }
#endif
}
```

```cpp
#include <hip/hip_runtime.h>
#include <hip/hip_bf16.h>
#include <cstdio>
#include <cstdint>
#include <cmath>

#ifndef MK_N_LAUNCHES
#define MK_N_LAUNCHES 1
#endif

#ifndef DBG_DUMP
#define DBG_DUMP 0
#endif
#ifndef DBG_STOP
#define DBG_STOP 100
#endif
#ifndef REP_PHASE
#define REP_PHASE -1
#endif
#define LAS __attribute__((address_space(3)))
#define GAS __attribute__((address_space(1)))
typedef unsigned short bf16;
typedef unsigned v4u __attribute__((ext_vector_type(4)));
typedef unsigned v2u __attribute__((ext_vector_type(2)));
typedef float f32x4 __attribute__((ext_vector_type(4)));
typedef float f32x2 __attribute__((ext_vector_type(2)));
typedef short bf16x8 __attribute__((ext_vector_type(8)));
typedef float f32x16 __attribute__((ext_vector_type(16)));
typedef short s16x4 __attribute__((ext_vector_type(4)));
typedef GAS unsigned gu32;

constexpr int NB = 8, SEQ = 2048, DM = 2048, NMETA = 16, NH = 16, HD = 64, ATTW = 1024, CONVC = 1024, CONVK = 31;
constexpr int NGRP = 4, EPG = 8, NE = 32, DE = 768, INCOLS = 9232, DEPTH = 2;
constexpr int MR = NB * SEQ;
constexpr int MT = MR + NMETA;
constexpr int MALLOC = 16640;
constexpr int KSEQ = 64 + SEQ;
constexpr int ZSEQ = NMETA + SEQ;
constexpr int PCAP = MT;
constexpr int MAXT = 162;
constexpr float RMS_EPS = 1e-6f, LN_EPS = 1e-5f;
constexpr float LOG2E = 1.4426950408889634f;
constexpr float C2 = 0.125f * 1.4426950408889634f;
constexpr float W8S = 32.0f, W8I = 1.0f / 32.0f;

constexpr size_t MiB = 1u << 20;
constexpr size_t WS_CTL = 0, CTL_ZERO_BYTES = 64 * 1024;
constexpr size_t WS_WF = 1 * MiB, WS_WR = 2 * MiB, WS_LOGF = 3 * MiB, WS_PERM = 6 * MiB, WS_WTS = 9 * MiB;
constexpr size_t WS_W = 16 * MiB, W_LSTRIDE = 340 * MiB;
constexpr size_t WO_IN = 0, WO_AO = 36 * MiB, WO_CO = 40 * MiB, WO_O = 44 * MiB, WO_GU = 52 * MiB, WO_DN = 244 * MiB;
constexpr size_t WS_XN = 696 * MiB, WS_QO = 761 * MiB, WS_KB = 794 * MiB, WS_VB = 827 * MiB, WS_ZG = 860 * MiB, WS_SGA = 893 * MiB, WS_SGC = 958 * MiB;
constexpr size_t WS_CV = 1023 * MiB, WS_MG = 1056 * MiB, WS_RES = 1121 * MiB, WS_N2 = 1251 * MiB, WS_XS = 1316 * MiB, WS_H = 1478 * MiB, WS_Y0 = 1539 * MiB, WS_Y1 = 1604 * MiB;
constexpr size_t WS_XN8 = 1669 * MiB;
constexpr size_t WS_O = 1702 * MiB;
constexpr size_t WS_END = 1735 * MiB;
constexpr int CW_TMO = 0, CW_BAR = 4096, CW_CNT = 8192;

#define RLX_AGENT __ATOMIC_RELAXED, __HIP_MEMORY_SCOPE_AGENT
#define LDS_WAIT() asm volatile("s_waitcnt lgkmcnt(0)" ::: "memory")
#define VM_WAIT() asm volatile("s_waitcnt vmcnt(0)" ::: "memory")
typedef __bf16 bf16x2_t __attribute__((ext_vector_type(2)));
__device__ __forceinline__ unsigned cvt_pk_bf16(float lo, float hi) { f32x2 v = {lo, hi}; bf16x2_t b = __builtin_convertvector(v, bf16x2_t); return __builtin_bit_cast(unsigned, b); }
__device__ __forceinline__ float bf_lo(unsigned u) { return __uint_as_float(u << 16); }
__device__ __forceinline__ float bf_hi(unsigned u) { return __uint_as_float(u & 0xffff0000u); }
__device__ __forceinline__ float sigmoidf_fast(float x) { return __builtin_amdgcn_rcpf(1.0f + __builtin_amdgcn_exp2f(-x * LOG2E)); }
template <int X> __device__ __forceinline__ float swz_xor(float v) { return __int_as_float(__builtin_amdgcn_ds_swizzle(__float_as_int(v), 0x1f | (X << 10))); }
__device__ __forceinline__ float xor32_sum(float v) { auto rr = __builtin_amdgcn_permlane32_swap(__float_as_uint(v), __float_as_uint(v), false, false); return __uint_as_float(rr[0]) + __uint_as_float(rr[1]); }
__device__ __forceinline__ float wave_sum(float v) {
    v += swz_xor<1>(v); v += swz_xor<2>(v); v += swz_xor<4>(v); v += swz_xor<8>(v); v += swz_xor<16>(v);
    return xor32_sum(v);
}
__device__ __forceinline__ float shfl_idx(float v, int src_lane) { return __int_as_float(__builtin_amdgcn_ds_bpermute(src_lane << 2, __float_as_int(v))); }
__device__ __forceinline__ int shfl_idx_i(int v, int src_lane) { return __builtin_amdgcn_ds_bpermute(src_lane << 2, v); }

namespace pg8 {
constexpr int BM = 256, BK = 64, HALF = 128, HTB = HALF * BK * 2, STAGE_BYTES = 8 * HTB, NXCD = 8, WGM = 8;
__host__ __device__ __forceinline__ int lds_byte(int r, int c) { const int st = (r >> 4) * 2 + (c >> 5), rr = r & 15, cc = c & 31, ob = rr * 64 + cc * 2; return st * 1024 + (ob ^ (((ob >> 9) & 1) << 5)); }
__host__ __device__ __forceinline__ void stage_rc(int b, int& R, int& C) { const int st = b / 1024, sb = b % 1024, swz = sb ^ (((sb >> 9) & 1) << 5); R = (st >> 1) * 16 + swz / 64; C = (st & 1) * 32 + (swz % 64) / 2; }
__host__ __device__ __forceinline__ int perm32(int rho) { const int n = rho >> 4, i = rho & 15; return 8 * (i >> 2) + 4 * n + (i & 3); }

struct Unit { int pm, pn, aux; };

struct GridOrder {
    int nM, nN, nwg, G, c;
    __device__ __forceinline__ void init(int nM_, int nN_, int G_, int c_) { nM = nM_; nN = nN_; nwg = nM * nN; G = G_; c = c_; }
    __device__ __forceinline__ bool tile(int i, int& pm, int& pn) const {
        const long L = (long)i * G + c; if (L >= nwg) return false;
        int wgid = (int)L; { const int q = nwg / NXCD, r = nwg % NXCD, xcd = wgid % NXCD, off = wgid / NXCD; wgid = (xcd < r ? xcd * (q + 1) : r * (q + 1) + (xcd - r) * q) + off; }
        const int nig = WGM * nN, gid = wgid / nig, fm = gid * WGM, gsz = (nM - fm) < WGM ? (nM - fm) : WGM;
        pm = fm + ((wgid % nig) % gsz); pn = (wgid % nig) / gsz; return true;
    }
};

typedef int v8i_t __attribute__((ext_vector_type(8)));
template <class Epi, class Sched, bool ALIGN_EPI, bool FP8 = false, bool GATHER = false>
__device__ __forceinline__ void gemm_phase(LAS unsigned char* lds, const int KB, const Sched& S, const Epi& E) {
    int tid = threadIdx.x; asm volatile("" : "+v"(tid));
    const int wid = __builtin_amdgcn_readfirstlane(tid >> 6), lane = tid & 63, wr = wid >> 2, wc = wid & 3, fr = lane & 15, fq = lane >> 4;
    const int nt = KB / (BK * 2);
    unsigned voffB[2], cvo[2][2], nvo[2][2]; int RA[2], CA[2];
    const size_t kstep = (size_t)(BK * 2);
    const size_t hstep = (size_t)HALF * KB;
#pragma unroll
    for (int i = 0; i < 2; ++i) { int R, C; stage_rc(tid * 16 + i * 8192, R, C); const int Rb = Epi::PERM ? ((R & ~31) + perm32(R & 31)) : R; RA[i] = R; CA[i] = C * 2;
        voffB[i] = (unsigned)(Rb * KB + C * 2);
#pragma unroll
        for (int h = 0; h < 2; ++h) { cvo[h][i] = GATHER ? 0u : (unsigned)(R * KB + C * 2) + (unsigned)(h * hstep); nvo[h][i] = cvo[h][i]; } }
    const unsigned ldsw = (unsigned)wid * 1024u;
    const int aoff = lds_byte(wr * 64 + fr, fq * 8), boff = lds_byte(wc * 32 + fr, fq * 8);
#define PG8_SA(b, h) (((b) * 2 + (h)) * HTB)
#define PG8_SB(b, h) ((4 + (b) * 2 + (h)) * HTB)
#define PG8_STAGE(bufoff, gbase, voff) do { _Pragma("unroll") for (int _i = 0; _i < 2; ++_i) \
        __builtin_amdgcn_global_load_lds((const unsigned*)((const char*)(gbase) + (voff)[_i]), (LAS unsigned*)(lds + (bufoff) + ldsw + _i * 8192), 16, 0, 0); } while (0)
#define PG8_LD32(off) __builtin_shufflevector(*(const LAS v4u*)(lds + (off)), *(const LAS v4u*)(lds + (off) + 1024), 0, 1, 2, 3, 4, 5, 6, 7)
#define PG8_LDA(dst, b, h) do { _Pragma("unroll") for (int m = 0; m < 4; ++m) { if constexpr (FP8) dst##8[m] = __builtin_bit_cast(v8i_t, PG8_LD32(PG8_SA(b, h) + aoff + m * 2048)); else { _Pragma("unroll") for (int k = 0; k < 2; ++k) dst[m][k] = *(const LAS bf16x8*)(lds + PG8_SA(b, h) + aoff + m * 2048 + k * 1024); } } } while (0)
#define PG8_LDB(dst, b, h) do { _Pragma("unroll") for (int n = 0; n < 2; ++n) { if constexpr (FP8) dst##8[n] = __builtin_bit_cast(v8i_t, PG8_LD32(PG8_SB(b, h) + boff + n * 2048)); else { _Pragma("unroll") for (int k = 0; k < 2; ++k) dst[n][k] = *(const LAS bf16x8*)(lds + PG8_SB(b, h) + boff + n * 2048 + k * 1024); } } } while (0)
#define PG8_CAT(x) __builtin_shufflevector(__builtin_bit_cast(v4u, (x)[0]), __builtin_bit_cast(v4u, (x)[1]), 0, 1, 2, 3, 4, 5, 6, 7)
#define PG8_MMA(ai, bj, At, Bt) do { __builtin_amdgcn_s_setprio(1); _Pragma("unroll") for (int m = 0; m < 4; ++m) _Pragma("unroll") for (int n = 0; n < 2; ++n) { \
        if constexpr (FP8) asm volatile("v_mfma_scale_f32_16x16x128_f8f6f4 %0, %1, %2, %0, %3, %3 op_sel_hi:[0,0,0]" : "+v"(acc[ai][bj][m][n]) : "v"(Bt##8[n]), "v"(At##8[m]), "v"(sc1_)); \
        else { _Pragma("unroll") for (int k = 0; k < 2; ++k) acc[ai][bj][m][n] = __builtin_amdgcn_mfma_f32_16x16x32_bf16(Bt[n][k], At[m][k], acc[ai][bj][m][n], 0, 0, 0); } } \
        __builtin_amdgcn_s_setprio(0); } while (0)
#define PG8_WAIT_V(n) asm volatile("s_waitcnt vmcnt(" #n ")" ::: "memory")
#define PG8_WAIT_L(n) asm volatile("s_waitcnt lgkmcnt(" #n ")" ::: "memory")
#define PG8_BAR __builtin_amdgcn_s_barrier()
#define PG8_SCHED __builtin_amdgcn_sched_barrier(0)
#define PG8_ZERO() do { float zf_; asm volatile("v_mov_b32 %0, 0" : "=v"(zf_)); const f32x4 z4_ = {zf_, zf_, zf_, zf_}; _Pragma("unroll") for (int a = 0; a < 2; ++a) _Pragma("unroll") for (int b = 0; b < 2; ++b) _Pragma("unroll") for (int m = 0; m < 4; ++m) _Pragma("unroll") for (int n = 0; n < 2; ++n) acc[a][b][m][n] = z4_; } while (0)
    Unit cur, nxt; int ui = 0;
    if (!S.next(0, cur)) return;
    f32x4 acc[2][2][4][2];
    PG8_ZERO();
    bf16x8 At[4][2], B0[2][2], B1[2][2]; v8i_t At8[4], B08[2], B18[2];
    int sc1_ = 0x7f7f7f7f; asm volatile("" : "+v"(sc1_));
    const char* cA = S.opA(cur); const char* cB = S.opB(cur);
    if constexpr (GATHER) {
#pragma unroll
        for (int h = 0; h < 2; ++h)
#pragma unroll
            for (int i = 0; i < 2; ++i) { cvo[h][i] = S.goff(0, h * HALF + RA[i]) + (unsigned)CA[i]; nvo[h][i] = cvo[h][i]; } }
    PG8_STAGE(PG8_SB(0, 0), cB, voffB); PG8_STAGE(PG8_SB(0, 1), cB + hstep, voffB); PG8_STAGE(PG8_SA(0, 0), cA, cvo[0]); PG8_STAGE(PG8_SA(0, 1), cA, cvo[1]);
    if (wr == 1) PG8_BAR;
    PG8_WAIT_V(2); PG8_BAR;
    PG8_STAGE(PG8_SB(1, 0), cB + kstep, voffB); PG8_STAGE(PG8_SA(1, 0), cA + kstep, cvo[0]); PG8_STAGE(PG8_SB(1, 1), cB + hstep + kstep, voffB);
    PG8_WAIT_V(6); PG8_BAR;
    for (;;) {
        const bool has_next = S.next(ui + 1, nxt);
        const char* nA = has_next ? S.opA(nxt) : cA; const char* nB = has_next ? S.opB(nxt) : cB;
        if constexpr (GATHER) { if (has_next) {
#pragma unroll
            for (int h = 0; h < 2; ++h)
#pragma unroll
                for (int i = 0; i < 2; ++i) nvo[h][i] = S.goff(ui + 1, h * HALF + RA[i]) + (unsigned)CA[i]; } }
        for (int t = 0; t < nt; t += 2) {
            const bool last = (t == nt - 2);
            const char* a1 = cA + (size_t)(t + 1) * kstep;
            const char* a2 = last ? nA : cA + (size_t)(t + 2) * kstep; const char* b2 = last ? nB : cB + (size_t)(t + 2) * kstep;
            const char* a3 = a2 + kstep; const char* b3 = b2 + kstep;
            unsigned o2[2][2];
#pragma unroll
            for (int h = 0; h < 2; ++h)
#pragma unroll
                for (int i = 0; i < 2; ++i) o2[h][i] = (GATHER && last) ? nvo[h][i] : cvo[h][i];
            PG8_LDB(B0, 0, 0); PG8_LDB(B1, 0, 1); PG8_SCHED; PG8_LDA(At, 0, 0); PG8_STAGE(PG8_SA(1, 1), a1, cvo[1]);
            PG8_WAIT_V(8); PG8_WAIT_L(0); PG8_BAR; PG8_MMA(0, 0, At, B0); PG8_MMA(0, 1, At, B1); PG8_BAR; PG8_SCHED;
            PG8_LDA(At, 0, 1); PG8_STAGE(PG8_SB(0, 0), b2, voffB); PG8_STAGE(PG8_SB(0, 1), b2 + hstep, voffB); PG8_STAGE(PG8_SA(0, 0), a2, o2[0]);
            PG8_WAIT_V(8); PG8_WAIT_L(0); PG8_BAR; PG8_MMA(1, 0, At, B0); PG8_MMA(1, 1, At, B1); PG8_BAR; PG8_SCHED;
            PG8_LDB(B0, 1, 0); PG8_LDB(B1, 1, 1); PG8_SCHED; PG8_LDA(At, 1, 0); PG8_STAGE(PG8_SA(0, 1), a2, o2[1]);
            PG8_WAIT_V(8); PG8_WAIT_L(0); PG8_BAR; PG8_MMA(0, 0, At, B0); PG8_MMA(0, 1, At, B1); PG8_BAR; PG8_SCHED;
            PG8_LDA(At, 1, 1); PG8_STAGE(PG8_SB(1, 0), b3, voffB); PG8_STAGE(PG8_SB(1, 1), b3 + hstep, voffB); PG8_STAGE(PG8_SA(1, 0), a3, o2[0]);
            PG8_WAIT_V(8); PG8_WAIT_L(0); PG8_BAR; PG8_MMA(1, 0, At, B0); PG8_MMA(1, 1, At, B1); PG8_BAR; PG8_SCHED;
        }
        if constexpr (ALIGN_EPI) { if (wr == 0) PG8_BAR; }
        if constexpr (FP8) asm volatile("s_nop 15\n\ts_nop 15" ::: "memory");
        E(acc, cur, wr, wc, fr, fq);
        if (!has_next) break;
        if (!E.keep(cur)) PG8_ZERO();
        cur = nxt; cA = nA; cB = nB; ++ui;
        if constexpr (GATHER) {
#pragma unroll
            for (int h = 0; h < 2; ++h)
#pragma unroll
                for (int i = 0; i < 2; ++i) cvo[h][i] = nvo[h][i]; }
        if constexpr (ALIGN_EPI) { if (wr == 1) PG8_BAR; }
    }
    PG8_WAIT_V(0);
    if constexpr (!ALIGN_EPI) { if (wr == 0) PG8_BAR; }
    PG8_BAR;
#undef PG8_SA
#undef PG8_SB
#undef PG8_STAGE
#undef PG8_LDA
#undef PG8_LD32
#undef PG8_LDB
#undef PG8_MMA
#undef PG8_CAT
#undef PG8_WAIT_V
#undef PG8_WAIT_L
#undef PG8_BAR
#undef PG8_SCHED
#undef PG8_ZERO
}
}

namespace attn_body {
constexpr int D = 64, DMA_ = NH * D;
constexpr int NW = 8, QBLK = 32, QB = QBLK * NW, KVBLK = 64;
__device__ __forceinline__ int crow(int r, int hi) { return (r & 3) + 8 * (r >> 2) + 4 * hi; }
#define SBAR() __builtin_amdgcn_sched_barrier(0)
__device__ __forceinline__ void cmask(f32x16& p0, f32x16& p1, int jb, int qrel, int hi) {
  const float NEG = -INFINITY; int kb = 64 * jb + 4 * hi;
  #pragma unroll
  for (int r = 0; r < 16; ++r) { int kv = kb + (r & 3) + 8 * (r >> 2); if (kv > qrel) p0[r] = NEG; if (kv + 32 > qrel) p1[r] = NEG; }
}
constexpr int NSLOT = 3, SLOTB = 8192;
constexpr int LDS_K = 0, LDS_V = NSLOT * SLOTB, LDS_WS = 2 * NSLOT * SLOTB, LDS_OST = LDS_WS + NW * 64 * 4, LDS_BYTES = LDS_OST + NW * 4096;
constexpr int LDS_CS = LDS_BYTES, LDS_TOT = LDS_CS + KSEQ * 4, LDS_ALL = LDS_TOT + 256;
__device__ __forceinline__ void glds16(const void* gsrc, unsigned lds_dst) { unsigned keep;
  asm volatile("s_mov_b32 %0, m0\n\ts_mov_b32 m0, %2\n\ts_nop 0\n\tglobal_load_lds_dwordx4 %1, off\n\ts_mov_b32 m0, %0" : "=&s"(keep) : "v"(gsrc), "s"(lds_dst) : "memory"); }
__device__ __forceinline__ float max3f(float a, float b, float c) { float r; asm("v_max3_f32 %0, %1, %2, %3" : "=v"(r) : "v"(a), "v"(b), "v"(c)); return r; }
__device__ __forceinline__ float max2f(float a, float b) { float r; asm("v_max_f32_e32 %0, %1, %2" : "=v"(r) : "v"(a), "v"(b)); return r; }
__device__ __forceinline__ float fadd_s(float a, float b) { float r; asm("v_add_f32_e32 %0, %1, %2" : "=v"(r) : "v"(a), "v"(b)); return r; }
__device__ __forceinline__ float fsub_s(float a, float b) { float r; asm("v_sub_f32_e32 %0, %1, %2" : "=v"(r) : "v"(a), "v"(b)); return r; }
__device__ __forceinline__ unsigned cvtpk_s(float lo, float hi) { f32x2 v = {lo, hi}; bf16x2_t b = __builtin_convertvector(v, bf16x2_t); return __builtin_bit_cast(unsigned, b); }
#define WAIT_BAR(N) asm volatile("s_waitcnt vmcnt(" #N ") lgkmcnt(0)\n\ts_barrier" ::: "memory")

__device__ __forceinline__ void qkt(f32x16& p0, f32x16& p1, const char* Kslot, const bf16x8* qr, const f32x16& negm, int r32, int hi) {
  const char* kb = Kslot + hi * 1024 + r32 * 16;
  #pragma unroll
  for (int d0 = 0; d0 < 4; ++d0) {
    const bf16x8 b0 = *reinterpret_cast<const bf16x8*>(kb + d0 * 2048);
    const bf16x8 b1 = *reinterpret_cast<const bf16x8*>(kb + d0 * 2048 + 512);
    if (d0 == 0) { p0 = __builtin_amdgcn_mfma_f32_32x32x16_bf16(b0, qr[0], negm, 0, 0, 0); p1 = __builtin_amdgcn_mfma_f32_32x32x16_bf16(b1, qr[0], negm, 0, 0, 0); }
    else { p0 = __builtin_amdgcn_mfma_f32_32x32x16_bf16(b0, qr[d0], p0, 0, 0, 0); p1 = __builtin_amdgcn_mfma_f32_32x32x16_bf16(b1, qr[d0], p1, 0, 0, 0); } }
}
typedef LAS const char* lds_cptr;
typedef short v4i16_t __attribute__((ext_vector_type(4)));
__device__ __forceinline__ void kload8(bf16x8* kf, lds_cptr kp) {
  kf[0] = *(const LAS bf16x8*)(kp);        kf[1] = *(const LAS bf16x8*)(kp + 512);
  kf[2] = *(const LAS bf16x8*)(kp + 2048); kf[3] = *(const LAS bf16x8*)(kp + 2560);
  kf[4] = *(const LAS bf16x8*)(kp + 4096); kf[5] = *(const LAS bf16x8*)(kp + 4608);
  kf[6] = *(const LAS bf16x8*)(kp + 6144); kf[7] = *(const LAS bf16x8*)(kp + 6656);
}
__device__ __forceinline__ void kload2(bf16x8* kf, lds_cptr kp, int j) { kf[2 * j] = *(const LAS bf16x8*)(kp + j * 2048); kf[2 * j + 1] = *(const LAS bf16x8*)(kp + j * 2048 + 512); }
__device__ __forceinline__ s16x4 vtr(lds_cptr p) { return __builtin_bit_cast(s16x4, __builtin_amdgcn_ds_read_tr16_b64_v4i16((LAS v4i16_t*)p)); }
__device__ __forceinline__ float rowmax(const f32x16& p0, const f32x16& p1) {
  float a = max3f(p0[0], p0[1], p1[0]), b = max3f(p0[2], p0[3], p1[1]); a = max3f(a, p1[2], p1[3]);
  #pragma unroll
  for (int r = 4; r < 16; r += 4) { a = max3f(a, p0[r], p0[r + 1]); b = max3f(b, p0[r + 2], p0[r + 3]); a = max3f(a, p1[r], p1[r + 1]); b = max3f(b, p1[r + 2], p1[r + 3]); }
  const float m = max2f(a, b);
  auto rr = __builtin_amdgcn_permlane32_swap(__float_as_uint(m), __float_as_uint(m), false, false);
  return max2f(__uint_as_float(rr[0]), __uint_as_float(rr[1]));
}
__device__ __forceinline__ void pv(f32x16* o, int vb, bf16x8 pa0, bf16x8 pa1, bf16x8 pa2, bf16x8 pa3) {
  #pragma unroll
  for (int d0 = 0; d0 < 2; ++d0) { s16x4 lo[4], hi[4];
    #pragma unroll
    for (int ks = 0; ks < 4; ++ks) {
      asm volatile("ds_read_b64_tr_b16 %0,%1 offset:%c2" : "=&v"(lo[ks]) : "v"(vb), "i"(d0 * 4096 + ks * 1024) : "memory");
      asm volatile("ds_read_b64_tr_b16 %0,%1 offset:%c2" : "=&v"(hi[ks]) : "v"(vb), "i"(d0 * 4096 + ks * 1024 + 512) : "memory"); }
    asm volatile("s_waitcnt lgkmcnt(0)" ::: "memory"); SBAR();
    #define PK(k) (bf16x8){lo[k][0], lo[k][1], lo[k][2], lo[k][3], hi[k][0], hi[k][1], hi[k][2], hi[k][3]}
    o[d0] = __builtin_amdgcn_mfma_f32_32x32x16_bf16(pa0, PK(0), o[d0], 0, 0, 0);
    o[d0] = __builtin_amdgcn_mfma_f32_32x32x16_bf16(pa1, PK(1), o[d0], 0, 0, 0);
    o[d0] = __builtin_amdgcn_mfma_f32_32x32x16_bf16(pa2, PK(2), o[d0], 0, 0, 0);
    o[d0] = __builtin_amdgcn_mfma_f32_32x32x16_bf16(pa3, PK(3), o[d0], 0, 0, 0);
    #undef PK
  }
}
__device__ __forceinline__ void kbias(f32x16& p0, f32x16& p1, const LAS float* csl, int t, int hi) {
  const LAS f32x4* cb = (const LAS f32x4*)(csl + 64 * t + 4 * hi);
  #pragma unroll
  for (int g = 0; g < 4; ++g) { const f32x4 u0 = cb[2 * g], u1 = cb[8 + 2 * g];
    p0[4 * g + 0] -= u0[0]; p0[4 * g + 1] -= u0[1]; p0[4 * g + 2] -= u0[2]; p0[4 * g + 3] -= u0[3];
    p1[4 * g + 0] -= u1[0]; p1[4 * g + 1] -= u1[1]; p1[4 * g + 2] -= u1[2]; p1[4 * g + 3] -= u1[3]; }
}

template <int THRL> __device__ __forceinline__ void attn_unit(int b, int h, int qb, const __hip_bfloat16* Q, const __hip_bfloat16* __restrict__ K, const __hip_bfloat16* __restrict__ V, __hip_bfloat16* O, char* shm) {
  using bf16h = __hip_bfloat16;
  int tid = threadIdx.x; asm volatile("" : "+v"(tid));
  const int lane = tid & 63, r32 = lane & 31, hi = lane >> 5; const int wid = __builtin_amdgcn_readfirstlane(tid >> 6);
  const long rowbaseQ = (long)b * SEQ, rowbaseK = (long)b * KSEQ; const int q0 = qb * QB;
  const bf16h* Qw = Q + (rowbaseQ + q0 + wid * QBLK) * DMA_ + h * D;
  const bf16h* Kh = K + rowbaseK * DMA_ + h * D, *Vh = V + rowbaseK * DMA_ + h * D;
  const unsigned lds0 = (unsigned)(uintptr_t)shm;
  float* wsf = (float*)(shm + LDS_WS) + wid * 64;
  const LAS float* csl = (const LAS float*)((LAS const char*)shm + LDS_CS);
  const bf16h* ksrc = Kh + (long)lane * DMA_ + wid * 8;
  const bf16h* vsrc = Vh + (long)(16 * (wid & 3) + (lane >> 2)) * DMA_ + (wid >> 2) * 32 + (lane & 3) * 8;
  const unsigned kdst = lds0 + LDS_K + wid * 1024, vdst = lds0 + LDS_V + wid * 1024;
  #define DMA_K(t, slot) glds16(ksrc + (long)(t) * KVBLK * DMA_, (unsigned)__builtin_amdgcn_readfirstlane(kdst + (slot)))
  #define DMA_V(t, slot) glds16(vsrc + (long)(t) * KVBLK * DMA_, (unsigned)__builtin_amdgcn_readfirstlane(vdst + (slot)))
  const int vb0 = (int)(lds0 + LDS_V) + ((lane >> 4) & 1) * 32 + (lane & 3) * 8 + (4 * hi + ((lane & 15) >> 2)) * 64;
  const char* Kbase = shm + LDS_K; bf16x8 kf[8];
  const lds_cptr shm3 = (lds_cptr)shm; const lds_cptr kp0 = shm3 + LDS_K + hi * 1024 + r32 * 16; const lds_cptr vp0 = shm3 + LDS_V + ((lane >> 4) & 1) * 32 + (lane & 3) * 8 + (4 * hi + ((lane & 15) >> 2)) * 64;
  const int NT = (q0 + QB) / KVBLK + 1;
  DMA_K(0, 0); DMA_V(0, 0); DMA_K(1, SLOTB);
  bf16x8 qr[4];
  #pragma unroll
  for (int d0 = 0; d0 < 4; ++d0) qr[d0] = *reinterpret_cast<const bf16x8*>(&Qw[(long)r32 * DMA_ + d0 * 16 + hi * 8]);
  const float cq = csl[64 + q0 + wid * QBLK + r32];
  float mhat = 0.f, l_reg = 0.f; f32x16 o[2]; o[0] = f32x16{}; o[1] = f32x16{}; f32x16 negm;
  #pragma unroll
  for (int r = 0; r < 16; ++r) negm[r] = cq;
  asm volatile("" : "+v"(negm));
  const int qrel = wid * QBLK + r32;
  #define CMASK(P0, P1, t) do { int jb_ = (t) - (NT - 4); if (jb_ >= 0) cmask(P0, P1, jb_, qrel, hi); } while (0)
  bool resc = false;
  #define START(P0, P1) do { const float rm = rowmax(P0, P1); resc = false; \
    { const float dl = rm; mhat = fadd_s(mhat, dl); \
      _Pragma("unroll") for (int r = 0; r < 16; ++r) { P0[r] = fsub_s(P0[r], dl); P1[r] = fsub_s(P1[r], dl); } \
      _Pragma("unroll") for (int r = 0; r < 16; ++r) negm[r] = cq - mhat; asm volatile("" : "+v"(negm)); } \
    _Pragma("unroll") for (int r = 0; r < 16; ++r) P0[r] = __builtin_amdgcn_exp2f(P0[r]); } while (0)
  #define RESC() do { if (resc) { asm volatile("s_waitcnt lgkmcnt(0)" ::: "memory"); \
      _Pragma("unroll") for (int d_ = 0; d_ < 2; ++d_) _Pragma("unroll") for (int r = 0; r < 16; ++r) o[d_][r] *= wsf[crow(r, hi)]; } } while (0)
  f32x16 pA0, pA1, pB0, pB1;
  int sl_prev = 0, sl_cur = 0, sl_next = SLOTB;
  #define ROT() do { sl_prev = sl_cur; sl_cur = sl_next; sl_next = (sl_next == (NSLOT - 1) * SLOTB) ? 0 : sl_next + SLOTB; } while (0)
  DMA_K(2, 2 * SLOTB);
  WAIT_BAR(3);
  qkt(pA0, pA1, Kbase, qr, negm, r32, hi); asm volatile("s_nop 15\n\ts_nop 7" : "+v"(pA0), "+v"(pA1)); kbias(pA0, pA1, csl, 0, hi);
  START(pA0, pA1);
  _Pragma("unroll") for (int r = 0; r < 16; ++r) pA1[r] = __builtin_amdgcn_exp2f(pA1[r]);
  WAIT_BAR(0);
  DMA_K(3, 0); DMA_V(1, SLOTB);
  ROT();
  kload8(kf, kp0 + sl_cur);
  WAIT_BAR(2);
  s16x4 vlo[8], vhi[8]; v4u pw0, pw1, pw2, pw3;
  #define PKW(P, B) cvtpk_s(P[B], P[B + 1])
  #define PAF(k) __builtin_bit_cast(bf16x8, pw##k)
  #define VFR(i) (bf16x8){vlo[i][0], vlo[i][1], vlo[i][2], vlo[i][3], vhi[i][0], vhi[i][1], vhi[i][2], vhi[i][3]}
  #define PIN(x) asm volatile("" : "+v"(x))
  #define MX3(a, b, c) __builtin_fmaxf(__builtin_fmaxf((a), (b)), (c))
  #define GAPA(MF, A0, A1, A2, A3, W0, W1, PW) do { MF; sacc += A0; sacc += A1; sacc += A2; sacc += A3; PIN(sacc); W0; W1; PIN(PW); SBAR(); } while (0)
  #define EX(v) __builtin_amdgcn_exp2f(v)
  #define GAPB(MF, X, B) do { MF; X[B] = EX(X[B]); X[B + 1] = EX(X[B + 1]); X[B + 2] = EX(X[B + 2]); X[B + 3] = EX(X[B + 3]); PIN(X); SBAR(); } while (0)
  #define VRD(i) do { vlo[i] = vtr(vp_ + (((i) >> 2) * 4096 + ((i) & 3) * 1024)); vhi[i] = vtr(vp_ + (((i) >> 2) * 4096 + ((i) & 3) * 1024 + 512)); } while (0)
  #define KRD(G, j) do { if (G) { kload2(kf, kp0 + sl_next, j); SBAR(); } } while (0)
  #define STEP(C0, C1, P0, P1, t, GK, GV, GL) do { SBAR(); \
    const lds_cptr vp_ = vp0 + sl_prev; \
    VRD(0); SBAR(); float sacc = (P0[0] + P0[1]); \
    GAPA(C0 = __builtin_amdgcn_mfma_f32_32x32x16_bf16(kf[0], qr[0], negm, 0, 0, 0), P0[2], P0[3], P0[4], P0[5],     pw0[0] = PKW(P0, 0), pw0[1] = PKW(P0, 2), pw0); \
    VRD(4); SBAR(); GAPA(C1 = __builtin_amdgcn_mfma_f32_32x32x16_bf16(kf[1], qr[0], negm, 0, 0, 0), P0[6], P0[7], P0[8], P0[9],     pw0[2] = PKW(P0, 4), pw0[3] = PKW(P0, 6), pw0); \
    VRD(1); SBAR(); GAPA(C0 = __builtin_amdgcn_mfma_f32_32x32x16_bf16(kf[2], qr[1], C0, 0, 0, 0),   P0[10], P0[11], P0[12], P0[13], pw1[0] = PKW(P0, 8), pw1[1] = PKW(P0, 10), pw1); \
    VRD(5); SBAR(); GAPA(C1 = __builtin_amdgcn_mfma_f32_32x32x16_bf16(kf[3], qr[1], C1, 0, 0, 0),   P0[14], P0[15], P1[0], P1[1],   pw1[2] = PKW(P0, 12), pw1[3] = PKW(P0, 14), pw1); \
    VRD(2); SBAR(); GAPA(C0 = __builtin_amdgcn_mfma_f32_32x32x16_bf16(kf[4], qr[2], C0, 0, 0, 0),   P1[2], P1[3], P1[4], P1[5],     pw2[0] = PKW(P1, 0), pw2[1] = PKW(P1, 2), pw2); \
    VRD(6); SBAR(); GAPA(C1 = __builtin_amdgcn_mfma_f32_32x32x16_bf16(kf[5], qr[2], C1, 0, 0, 0),   P1[6], P1[7], P1[8], P1[9],     pw2[2] = PKW(P1, 4), pw2[3] = PKW(P1, 6), pw2); \
    VRD(3); SBAR(); GAPA(C0 = __builtin_amdgcn_mfma_f32_32x32x16_bf16(kf[6], qr[3], C0, 0, 0, 0),   P1[10], P1[11], P1[12], P1[13], pw3[0] = PKW(P1, 8), pw3[1] = PKW(P1, 10), pw3); \
    VRD(7); SBAR(); GAPA(C1 = __builtin_amdgcn_mfma_f32_32x32x16_bf16(kf[7], qr[3], C1, 0, 0, 0),   P1[14], P1[15], 0.f, 0.f,       pw3[2] = PKW(P1, 12), pw3[3] = PKW(P1, 14), pw3); \
    l_reg += sacc; \
    if (GK) { DMA_K((t) + 3, sl_cur); } if (GV) { DMA_V((t) + 1, sl_next); } \
    kbias(C0, C1, csl, (t), hi); \
    CMASK(C0, C1, t); \
    { float a = MX3(C0[0], C0[1], C1[0]), b = MX3(C0[2], C0[3], C1[1]); a = MX3(a, C1[2], C1[3]); \
      _Pragma("unroll") for (int r = 4; r < 16; r += 4) { a = MX3(a, C0[r], C0[r + 1]); b = MX3(b, C0[r + 2], C0[r + 3]); a = MX3(a, C1[r], C1[r + 1]); b = MX3(b, C1[r + 2], C1[r + 3]); } \
      float rm = __builtin_fmaxf(a, b); { auto rr = __builtin_amdgcn_permlane32_swap(__float_as_uint(rm), __float_as_uint(rm), false, false); rm = __builtin_fmaxf(__uint_as_float(rr[0]), __uint_as_float(rr[1])); } \
      resc = false; \
      if (__builtin_expect(__any(rm > (float)THRL), 0)) { const float dl = __builtin_fmaxf(rm, 0.f); mhat += dl; \
        _Pragma("unroll") for (int r = 0; r < 16; ++r) { C0[r] -= dl; C1[r] -= dl; } \
        _Pragma("unroll") for (int r = 0; r < 16; ++r) negm[r] = cq - mhat; asm volatile("" : "+v"(negm)); \
        const float f = __builtin_amdgcn_exp2f(-dl); l_reg *= f; if (hi == 0) wsf[r32] = f; resc = true; } } \
    SBAR(); \
    GAPB(o[0] = __builtin_amdgcn_mfma_f32_32x32x16_bf16(PAF(0), VFR(0), o[0], 0, 0, 0), C0, 0); \
    GAPB(o[1] = __builtin_amdgcn_mfma_f32_32x32x16_bf16(PAF(0), VFR(4), o[1], 0, 0, 0), C0, 4); \
    KRD(GL, 0); GAPB(o[0] = __builtin_amdgcn_mfma_f32_32x32x16_bf16(PAF(1), VFR(1), o[0], 0, 0, 0), C0, 8); \
    KRD(GL, 1); GAPB(o[1] = __builtin_amdgcn_mfma_f32_32x32x16_bf16(PAF(1), VFR(5), o[1], 0, 0, 0), C0, 12); \
    KRD(GL, 2); GAPB(o[0] = __builtin_amdgcn_mfma_f32_32x32x16_bf16(PAF(2), VFR(2), o[0], 0, 0, 0), C1, 0); \
    KRD(GL, 3); GAPB(o[1] = __builtin_amdgcn_mfma_f32_32x32x16_bf16(PAF(2), VFR(6), o[1], 0, 0, 0), C1, 4); \
    GAPB(o[0] = __builtin_amdgcn_mfma_f32_32x32x16_bf16(PAF(3), VFR(3), o[0], 0, 0, 0), C1, 8); \
    GAPB(o[1] = __builtin_amdgcn_mfma_f32_32x32x16_bf16(PAF(3), VFR(7), o[1], 0, 0, 0), C1, 12); \
    } while (0)
  int t = 1;
  #undef CMASK
  #define CMASK(P0, P1, t) do {} while (0)
  for (; t + 5 < NT; t += 2) {
    STEP(pB0, pB1, pA0, pA1, t, true, true, true);     WAIT_BAR(2); RESC(); ROT();
    STEP(pA0, pA1, pB0, pB1, t + 1, true, true, true); WAIT_BAR(2); RESC(); ROT();
  }
  #undef CMASK
  #define CMASK(P0, P1, t) do { int jb_ = (t) - (NT - 4); if (jb_ >= 0) cmask(P0, P1, jb_, qrel, hi); } while (0)
  #define ENDW(tt) do { if ((tt) + 3 < NT) { WAIT_BAR(2); } else if ((tt) + 2 < NT) { WAIT_BAR(1); } else { WAIT_BAR(0); } } while (0)
  for (; t + 1 < NT; t += 2) {
    STEP(pB0, pB1, pA0, pA1, t, (t + 3 < NT), (t + 1 < NT), (t + 1 < NT));       ENDW(t);     RESC(); ROT();
    STEP(pA0, pA1, pB0, pB1, t + 1, (t + 4 < NT), (t + 2 < NT), (t + 2 < NT));   ENDW(t + 1); RESC(); ROT();
  }
  { float sacc = pA0[0] + pA0[1]; _Pragma("unroll") for (int r = 2; r < 16; ++r) sacc += pA0[r]; _Pragma("unroll") for (int r = 0; r < 16; ++r) sacc += pA1[r]; l_reg += sacc;
    pw0 = (v4u){PKW(pA0, 0), PKW(pA0, 2), PKW(pA0, 4), PKW(pA0, 6)}; pw1 = (v4u){PKW(pA0, 8), PKW(pA0, 10), PKW(pA0, 12), PKW(pA0, 14)}; pw2 = (v4u){PKW(pA1, 0), PKW(pA1, 2), PKW(pA1, 4), PKW(pA1, 6)}; pw3 = (v4u){PKW(pA1, 8), PKW(pA1, 10), PKW(pA1, 12), PKW(pA1, 14)};
    SBAR(); pv(o, vb0 + sl_prev, PAF(0), PAF(1), PAF(2), PAF(3)); }
  #undef PKW
  #undef PAF
  #undef VFR
  #undef PIN
  #undef MX3
  #undef GAPA
  #undef GAPB
  #undef EX
  #undef VRD
  #undef KRD
  #undef STEP
  #undef ENDW
  { auto rr = __builtin_amdgcn_permlane32_swap(__float_as_uint(l_reg), __float_as_uint(l_reg), false, false); l_reg = __uint_as_float(rr[0]) + __uint_as_float(rr[1]); }
  if (hi == 0) wsf[32 + r32] = l_reg; asm volatile("s_waitcnt lgkmcnt(0)" ::: "memory");
  float rli[16];
  #pragma unroll
  for (int r = 0; r < 16; ++r) rli[r] = __builtin_amdgcn_rcpf(wsf[32 + crow(r, hi)]);
  bf16h* Ow = O + (rowbaseQ + q0 + wid * QBLK) * DMA_ + h * D;
  { bf16h* stg = (bf16h*)(shm + LDS_OST) + wid * 2048;
    #pragma unroll
    for (int r = 0; r < 16; ++r) { const int orow = crow(r, hi);
      #pragma unroll
      for (int d0 = 0; d0 < 2; ++d0) stg[orow * 64 + d0 * 32 + r32] = __float2bfloat16(o[d0][r] * rli[r]); }
    asm volatile("s_waitcnt lgkmcnt(0)" ::: "memory");
    #pragma unroll
    for (int i = 0; i < 4; ++i) { const int row = i * 8 + (lane >> 3), ch = lane & 7; const v4u v = *(const v4u*)(stg + row * 64 + ch * 8); *(v4u*)(Ow + (long)row * DMA_ + ch * 8) = v; } }
  asm volatile("s_waitcnt lgkmcnt(0)\n\ts_barrier" ::: "memory");
  #undef DMA_K
  #undef DMA_V
  #undef CMASK
  #undef START
  #undef RESC
  #undef ROT
}
#undef SBAR
#undef WAIT_BAR
}

#define XB_TMO      128
#define XB_XCNT(j)  (256  + 64 * (j))
#define XB_XSUB(j)  (1280 + 64 * (j))
#define XB_XGEN(j)  (2304 + 64 * (j))
#define XB_TOP      3328
#define XB_TOPGEN   3392
#define XCD_BAR_WORDS 3456
#define XB_SPIN_CAP (1u << 18)
__device__ __forceinline__ unsigned xb_ld(unsigned* p)              { return __hip_atomic_load(p, __ATOMIC_RELAXED, __HIP_MEMORY_SCOPE_AGENT); }
__device__ __forceinline__ unsigned xb_add(unsigned* p, unsigned v) { return __hip_atomic_fetch_add(p, v, __ATOMIC_RELAXED, __HIP_MEMORY_SCOPE_AGENT); }
__device__ __forceinline__ unsigned xb_xcc_id() { return (unsigned)__builtin_amdgcn_s_getreg((3 << 11) | 20) & 0xFu; }
#define XB_SPIN(cond, bar) do { unsigned _sp = 0; while (cond) { __builtin_amdgcn_s_sleep(1); \
    if ((++_sp & 255u) == 0u) { if (xb_ld(&(bar)[XB_TMO])) break; if (_sp > XB_SPIN_CAP) { atomicAdd(&(bar)[XB_TMO], 1u); break; } } } } while (0)
struct XcdBarrier { unsigned* bar; unsigned x; volatile LAS unsigned* st; };
__device__ __forceinline__ XcdBarrier xcd_barrier_post(unsigned* bar, volatile LAS unsigned* st) {
    XcdBarrier b; b.bar = bar; b.x = xb_xcc_id(); b.st = st;
    if (threadIdx.x == 0) (void)xb_add(&bar[XB_XCNT(b.x)], 1u);
    return b;
}
__device__ __forceinline__ void xcd_barrier_complete(unsigned* bar, unsigned x, unsigned& nloc, unsigned& nx) {
    const unsigned G = gridDim.x * gridDim.y * gridDim.z;
    unsigned sum, cnt, mine, sp = 0u;
    for (;;) {
        sum = 0u; cnt = 0u; mine = 0u;
#pragma unroll
        for (unsigned j = 0; j < 16; ++j) { const unsigned c = xb_ld(&bar[XB_XCNT(j)]); sum += c; cnt += (c > 0u) ? 1u : 0u; mine = (j == x) ? c : mine; }
        if (sum == G) break;
        __builtin_amdgcn_s_sleep(1);
        if ((++sp & 255u) == 0u) { if (xb_ld(&bar[XB_TMO])) break; if (sp > XB_SPIN_CAP) { atomicAdd(&bar[XB_TMO], 1u); break; } }
    }
    nloc = mine > 0u ? mine : 1u; nx = cnt > 0u ? cnt : 1u;
}
__device__ __forceinline__ void xcd_barrier(const XcdBarrier& b) {
    asm volatile("s_waitcnt vmcnt(0)" ::: "memory");
    __syncthreads();
    if (threadIdx.x == 0) {
        unsigned* bar = b.bar;
        __builtin_amdgcn_s_waitcnt(0);
        unsigned nloc = b.st[0], nx = b.st[1];
        if (nloc == 0u) { xcd_barrier_complete(bar, b.x, nloc, nx); b.st[0] = nloc; b.st[1] = nx; }
        const unsigned old = xb_add(&bar[XB_XSUB(b.x)], 1u);
        const unsigned gen = old / nloc;
        if (old + 1u == (gen + 1u) * nloc) {
            __builtin_amdgcn_fence(__ATOMIC_RELEASE, "agent");
            asm volatile("s_waitcnt vmcnt(0)" ::: "memory");
            const unsigned og = xb_add(&bar[XB_TOP], 1u);
            const unsigned tg = og / nx;
            if (og + 1u == (tg + 1u) * nx) xb_add(&bar[XB_TOPGEN], 1u);
            else XB_SPIN(xb_ld(&bar[XB_TOPGEN]) == tg, bar);
            __builtin_amdgcn_fence(__ATOMIC_ACQUIRE, "agent");
            xb_add(&bar[XB_XGEN(b.x)], 1u);
            asm volatile("s_waitcnt vmcnt(0)" ::: "memory");
        } else {
            XB_SPIN(xb_ld(&bar[XB_XGEN(b.x)]) == gen, bar);
            __builtin_amdgcn_fence(__ATOMIC_ACQUIRE, "agent");
            asm volatile("s_waitcnt vmcnt(0)" ::: "memory");
        }
    }
    __syncthreads();
}

constexpr int RING_OFF = 0, RING_BYTES = 131072;
constexpr int MISC_OFF = RING_BYTES;
constexpr int TAB_OFF = MISC_OFF + 512;
constexpr int GTAB_OFF = TAB_OFF + 512, GTAB_UNITS = 4;
constexpr int LDS_BYTES = RING_BYTES + 8192;
static_assert(GTAB_OFF + GTAB_UNITS * 1024 <= LDS_BYTES && (MAXT * 6 + 255) / 256 <= GTAB_UNITS, "LDS map");
constexpr int NWAVES = 8;

struct Frame {
    LAS unsigned char* lds;
    volatile LAS unsigned* MISC;
    gu32* ctl;
    int tid, lane, wave, vcu, G, gw, NGW;
    unsigned char* ws;
    const float* const* in;
};
#define WSP(T, off) ((T*)(F.ws + (off)))
#define OPAQUE_IDS() int tid_ = F.tid; asm volatile("" : "+v"(tid_)); const int lane_ = tid_ & 63; const int wave_ = __builtin_amdgcn_readfirstlane(tid_ >> 6); (void)lane_; (void)wave_

__device__ __forceinline__ f32x4 mm16(const bf16* X, size_t ldx, const bf16* Y, size_t ldy, int K, f32x4 acc, int lane) {
    const int r = lane & 15, kg = lane >> 4;
    const GAS bf16* xp = (const GAS bf16*)X + (size_t)r * ldx + kg * 8; const GAS bf16* yp = (const GAS bf16*)Y + (size_t)r * ldy + kg * 8;
#pragma unroll 1
    for (int k = 0; k < K; k += 256) {
        bf16x8 xa[8], ya[8];
#pragma unroll
        for (int s = 0; s < 8; ++s) { xa[s] = *(const GAS bf16x8*)(xp + k + 32 * s); ya[s] = *(const GAS bf16x8*)(yp + k + 32 * s); }
#pragma unroll
        for (int s = 0; s < 8; ++s) acc = __builtin_amdgcn_mfma_f32_16x16x32_bf16(xa[s], ya[s], acc, 0, 0, 0);
    }
    return acc;
}

__device__ __forceinline__ f32x4 mm16_f8(const unsigned char* X, size_t ldx, const unsigned char* Y, size_t ldy, int K, f32x4 acc, int lane) {
    const int r = lane & 15, kg = lane >> 4;
    const GAS unsigned char* xp = (const GAS unsigned char*)X + (size_t)r * ldx + kg * 32; const GAS unsigned char* yp = (const GAS unsigned char*)Y + (size_t)r * ldy + kg * 32;
#pragma unroll 1
    for (int k = 0; k < K; k += 512) {
        pg8::v8i_t xa[4], ya[4];
#pragma unroll
        for (int s = 0; s < 4; ++s) { xa[s] = *(const GAS pg8::v8i_t*)(xp + k + 128 * s); ya[s] = *(const GAS pg8::v8i_t*)(yp + k + 128 * s); }
#pragma unroll
        for (int s = 0; s < 4; ++s) acc = __builtin_amdgcn_mfma_scale_f32_16x16x128_f8f6f4(xa[s], ya[s], acc, 0, 0, 0, 0x7f7f7f7f, 0, 0x7f7f7f7f);
    }
    return acc;
}

__device__ __forceinline__ void transpose_item(const float* W, size_t ldw, int K, bf16* WT, int csrc, int drow, int k0, LAS float* scr, int lane) {
    const GAS float* Wg = (const GAS float*)W;
#pragma unroll 8
    for (int i = 0; i < 32; ++i) { const int kk = 2 * i + (lane >> 5); scr[kk * 33 + (lane & 31)] = Wg[(size_t)(k0 + kk) * ldw + csrc + (lane & 31)]; }
    LDS_WAIT(); asm volatile("" ::: "memory");
    const int c = lane & 7;
#pragma unroll
    for (int j = 0; j < 4; ++j) { const int n = (lane >> 3) + 8 * j; const LAS float* s = scr + (8 * c) * 33 + n;
        v4u o; o.x = cvt_pk_bf16(s[0 * 33], s[1 * 33]); o.y = cvt_pk_bf16(s[2 * 33], s[3 * 33]); o.z = cvt_pk_bf16(s[4 * 33], s[5 * 33]); o.w = cvt_pk_bf16(s[6 * 33], s[7 * 33]);
        *(GAS v4u*)(WT + (size_t)(drow + n) * K + k0 + 8 * c) = o; }
    LDS_WAIT(); asm volatile("" ::: "memory");
}
__device__ __forceinline__ unsigned pk4_fp8(float a, float b, float c, float d) { int p = __builtin_amdgcn_cvt_pk_fp8_f32(a, b, 0, false); p = __builtin_amdgcn_cvt_pk_fp8_f32(c, d, p, true); return (unsigned)p; }
__device__ __forceinline__ void transpose_item_f8(const float* W, size_t ldw, int K, unsigned char* WT8, int csrc, int drow, int k0, LAS float* scr, int lane, float scale) {
    const GAS float* Wg = (const GAS float*)W;
#pragma unroll 8
    for (int i = 0; i < 32; ++i) { const int kk = 2 * i + (lane >> 5); scr[kk * 33 + (lane & 31)] = Wg[(size_t)(k0 + kk) * ldw + csrc + (lane & 31)] * scale; }
    LDS_WAIT(); asm volatile("" ::: "memory");
    const int c = lane & 3;
#pragma unroll
    for (int j = 0; j < 2; ++j) { const int n = (lane >> 2) + 16 * j; const LAS float* s = scr + (16 * c) * 33 + n;
        v4u o; o.x = pk4_fp8(s[0 * 33], s[1 * 33], s[2 * 33], s[3 * 33]); o.y = pk4_fp8(s[4 * 33], s[5 * 33], s[6 * 33], s[7 * 33]);
        o.z = pk4_fp8(s[8 * 33], s[9 * 33], s[10 * 33], s[11 * 33]); o.w = pk4_fp8(s[12 * 33], s[13 * 33], s[14 * 33], s[15 * 33]);
        *(GAS v4u*)(WT8 + (size_t)(drow + n) * K + k0 + 16 * c) = o; }
    LDS_WAIT(); asm volatile("" ::: "memory");
}
constexpr int IT_INA = 32 * 96, IT_INB = 32 * 192, IT_AO = 16 * 64, IT_CO = 16 * 64, IT_O = 32 * 64, IT_GU1 = 32 * 48, IT_GU = NE * IT_GU1, IT_DN1 = 12 * 64, IT_DN = NE * IT_DN1;
constexpr int IT_LAYER = IT_INA + IT_INB + IT_AO + IT_CO + IT_O + IT_GU + IT_DN;
__device__ __forceinline__ void p0_convert(Frame& F) {
    OPAQUE_IDS();
    LAS float* scr = (LAS float*)(F.lds + RING_OFF + wave_ * 16384);
    for (int it = F.gw; it < DEPTH * IT_LAYER; it += F.NGW) {
        const int l = it / IT_LAYER; int r = it % IT_LAYER;
        unsigned char* wl = F.ws + WS_W + (size_t)l * W_LSTRIDE;
        if (r < IT_INA) { const int kb = r / 96, nb = r % 96; transpose_item_f8(F.in[3] + (size_t)l * DM * INCOLS, INCOLS, DM, wl + WO_IN, 32 * nb, 32 * nb, 64 * kb, scr, lane_, W8S); continue; } r -= IT_INA;
        if (r < IT_INB) { const int kb = r / 192, nb = r % 192, c = 32 * nb; int drow;
            if (c < 2048) drow = 3072 + ((c & 1023) >> 7) * 256 + (c >> 10) * 128 + (c & 127); else drow = 5120 + (c - 2048);
            transpose_item_f8(F.in[3] + (size_t)l * DM * INCOLS, INCOLS, DM, wl + WO_IN, 3088 + c, drow, 64 * kb, scr, lane_, W8S); continue; } r -= IT_INB;
        if (r < IT_AO) { const int kb = r / 64, nb = r % 64; transpose_item(F.in[5] + (size_t)l * ATTW * DM, DM, ATTW, (bf16*)(wl + WO_AO), 32 * nb, 32 * nb, 64 * kb, scr, lane_); continue; } r -= IT_AO;
        if (r < IT_CO) { const int kb = r / 64, nb = r % 64; transpose_item(F.in[10] + (size_t)l * CONVC * DM, DM, CONVC, (bf16*)(wl + WO_CO), 32 * nb, 32 * nb, 64 * kb, scr, lane_); continue; } r -= IT_CO;
        if (r < IT_O) { const int kb = r / 64, nb = r % 64; transpose_item(F.in[11] + (size_t)l * DM * DM, DM, DM, (bf16*)(wl + WO_O), 32 * nb, 32 * nb, 64 * kb, scr, lane_); continue; } r -= IT_O;
        if (r < IT_GU) { const int e = r / IT_GU1, q = r % IT_GU1, kb = q / 48, nb = q % 48, c = 32 * nb; int drow;
            if (c < DE) drow = (c >> 7) * 256 + (c & 127); else drow = ((c - DE) >> 7) * 256 + 128 + ((c - DE) & 127);
            transpose_item(F.in[17] + ((size_t)l * NE + e) * DM * (2 * DE), 2 * DE, DM, (bf16*)(wl + WO_GU) + (size_t)e * (2 * DE) * DM, c, drow, 64 * kb, scr, lane_); continue; } r -= IT_GU;
        { const int e = r / IT_DN1, q = r % IT_DN1, kb = q / 64, nb = q % 64;
            transpose_item(F.in[18] + ((size_t)l * NE + e) * DE * DM, DM, DE, (bf16*)(wl + WO_DN) + (size_t)e * DM * DE, 32 * nb, 32 * nb, 64 * kb, scr, lane_); }
    }
    const int gt = F.vcu * 512 + tid_, NGT = F.G * 512;
    bf16* WfT = WSP(bf16, WS_WF); bf16* WrT = WSP(bf16, WS_WR);
    for (int i = gt; i < DEPTH * 16 * DM; i += NGT) { const int l = i / (16 * DM), h = (i / DM) % 16, k = i % DM;
        WfT[i] = (bf16)(cvt_pk_bf16(F.in[3][((size_t)l * DM + k) * INCOLS + 3072 + h], 0.f) & 0xffffu); }
    for (int i = gt; i < DEPTH * 48 * DM; i += NGT) { const int l = i / (48 * DM), c = (i / DM) % 48, k = i % DM; float v = 0.f;
        if (c < NGRP) v = F.in[13][((size_t)l * DM + k) * NGRP + c]; else if (c < NGRP + NE) v = F.in[15][((size_t)l * DM + k) * NE + (c - NGRP)];
        WrT[i] = (bf16)(cvt_pk_bf16(v, 0.f) & 0xffffu); }
    { v4u* kb = WSP(v4u, WS_KB); v4u* vb = WSP(v4u, WS_VB);
        for (int i = gt; i < NB * 6144; i += NGT) { const int b = i / 6144, q = i % 6144; const size_t o = (size_t)b * KSEQ * 128 + q; kb[o] = (v4u){0u, 0u, 0u, 0u}; vb[o] = (v4u){0u, 0u, 0u, 0u}; } }
}

template <int MODE> __device__ __forceinline__ void norm_phase(Frame& F, const float* gain, bf16* dst, float* outf) {
    OPAQUE_IDS();
    bf16* RES = WSP(bf16, WS_RES); const bf16* Y0 = WSP(bf16, WS_Y0); const bf16* Y1 = WSP(bf16, WS_Y1);
    f32x4 g[8];
#pragma unroll
    for (int j = 0; j < 8; ++j) g[j] = ((const GAS f32x4*)gain)[lane_ + 64 * j];
    const int mend = (MODE == 3) ? MR : MT;
    for (int m = F.gw; m < mend; m += F.NGW) {
        f32x4 v[8]; float ss = 0.f;
        if (MODE == 0) { const float* src = (m < MR) ? F.in[0] + (size_t)m * DM : F.in[1] + (size_t)(m - MR) * DM; const GAS f32x4* sp = (const GAS f32x4*)src + lane_;
#pragma unroll
            for (int j = 0; j < 8; ++j) v[j] = sp[64 * j];
        } else { const GAS v2u* rp = (const GAS v2u*)(RES + (size_t)m * DM) + lane_;
#pragma unroll
            for (int j = 0; j < 8; ++j) { const v2u a = rp[64 * j]; v[j] = (f32x4){bf_lo(a.x), bf_hi(a.x), bf_lo(a.y), bf_hi(a.y)}; } }
        if (MODE == 1 || MODE == 3) {
            const GAS v2u* y0 = (const GAS v2u*)(Y0 + (size_t)m * DM) + lane_; const GAS v2u* y1 = (const GAS v2u*)(Y1 + (size_t)m * DM) + lane_;
#pragma unroll
            for (int j = 0; j < 8; ++j) { const v2u a = y0[64 * j], b = y1[64 * j];
                v[j].x += bf_lo(a.x) + bf_lo(b.x); v[j].y += bf_hi(a.x) + bf_hi(b.x); v[j].z += bf_lo(a.y) + bf_lo(b.y); v[j].w += bf_hi(a.y) + bf_hi(b.y); }
        }
#pragma unroll
        for (int j = 0; j < 8; ++j) ss += (v[j].x * v[j].x + v[j].y * v[j].y) + (v[j].z * v[j].z + v[j].w * v[j].w);
        const float rstd = 1.0f / sqrtf(wave_sum(ss) * (1.0f / DM) + RMS_EPS);
        if (MODE == 1) { GAS v2u* rp = (GAS v2u*)(RES + (size_t)m * DM) + lane_;
#pragma unroll
            for (int j = 0; j < 8; ++j) { v2u w; w.x = cvt_pk_bf16(v[j].x, v[j].y); w.y = cvt_pk_bf16(v[j].z, v[j].w); rp[64 * j] = w; } }
        if (MODE == 3) { GAS f32x4* op = (GAS f32x4*)(outf + (size_t)m * DM) + lane_;
#pragma unroll
            for (int j = 0; j < 8; ++j) op[64 * j] = v[j] * rstd * g[j];
        } else { GAS v2u* op = (GAS v2u*)(dst + (size_t)m * DM) + lane_;
#pragma unroll
            for (int j = 0; j < 8; ++j) { const f32x4 o = v[j] * rstd * g[j]; v2u w; w.x = cvt_pk_bf16(o.x, o.y); w.y = cvt_pk_bf16(o.z, o.w); op[64 * j] = w; }
            if (MODE == 0 || MODE == 1) { GAS unsigned* o8 = (GAS unsigned*)(F.ws + WS_XN8 + (size_t)m * DM) + lane_;
#pragma unroll
                for (int j = 0; j < 8; ++j) { const f32x4 o = v[j] * rstd * g[j]; o8[64 * j] = pk4_fp8(o.x, o.y, o.z, o.w); } } }
    }
}

__device__ __forceinline__ void pb_side(Frame& F, int l) {
    OPAQUE_IDS();
    const bf16* XN = WSP(bf16, WS_XN); const unsigned char* WinT = F.ws + WS_W + (size_t)l * W_LSTRIDE + WO_IN;
    const int g4 = (lane_ >> 4) * 4, y_ = lane_ & 15;
    if (F.gw < MT / 16) {
        const int rb = F.gw;
        const f32x4 a = mm16(WSP(bf16, WS_WF) + (size_t)l * 16 * DM, DM, XN + (size_t)rb * 16 * DM, DM, DM, (f32x4){0.f, 0.f, 0.f, 0.f}, lane_);
        float* LOGF = WSP(float, WS_LOGF); int y = y_; asm volatile("" : "+v"(y));
#pragma unroll 1
        for (int r = 0; r < 4; ++r) { const int h = g4 + r; const float x = a[r] + F.in[4][l * NH + h];
            const float lf = (fminf(x, 0.f) - log1pf(expf(-fabsf(x)))) * LOG2E;
            if (rb < MR / 16) { const int m = rb * 16 + y, b = m >> 11, t = m & 2047; LOGF[(size_t)(b * NH + h) * KSEQ + 64 + t] = lf; }
            else { float* lp = LOGF + (size_t)h * KSEQ + 48 + y;
_Pragma("unroll 1")
                for (int bb = 0; bb < NB; ++bb) { *lp = lf; lp += (size_t)NH * KSEQ; } } }
    }
    const int j = F.NGW - 1 - F.gw;
    if (j < 576) {
        const int tile = j >> 4, sub = j & 15;
        const unsigned char* Ym = F.ws + WS_XN8 + (size_t)MR * DM;
        if (tile >= 12 && tile < 20) {
            if (sub < 8) {
                const f32x4 a = mm16_f8(WinT + (size_t)(tile * 256 + sub * 16) * DM, DM, Ym, DM, DM, (f32x4){0.f, 0.f, 0.f, 0.f}, lane_) * W8I;
                const f32x4 bq = mm16_f8(WinT + (size_t)(tile * 256 + 128 + sub * 16) * DM, DM, Ym, DM, DM, (f32x4){0.f, 0.f, 0.f, 0.f}, lane_) * W8I;
                int y = y_; asm volatile("" : "+v"(y));
                v2u w; w.x = cvt_pk_bf16(a[0] * sigmoidf_fast(bq[0]), a[1] * sigmoidf_fast(bq[1])); w.y = cvt_pk_bf16(a[2] * sigmoidf_fast(bq[2]), a[3] * sigmoidf_fast(bq[3]));
                bf16* ZG = WSP(bf16, WS_ZG);
                bf16* zp = ZG + (size_t)y * CONVC + (tile - 12) * 128 + sub * 16 + g4;
_Pragma("unroll 1")
                for (int bb = 0; bb < NB; ++bb) { *(v2u*)zp = w; zp += (size_t)ZSEQ * CONVC; }
            }
        } else {
            f32x4 a = mm16_f8(WinT + (size_t)(tile * 256 + sub * 16) * DM, DM, Ym, DM, DM, (f32x4){0.f, 0.f, 0.f, 0.f}, lane_) * W8I;
            const int n = sub * 16 + g4;
            int y = y_; asm volatile("" : "+v"(y));
            if (tile < 4) { a = a * C2; v2u w; w.x = cvt_pk_bf16(a[0], a[1]); w.y = cvt_pk_bf16(a[2], a[3]); *(v2u*)(WSP(bf16, WS_QO) + (size_t)(MR + y) * ATTW + tile * 256 + n) = w; }
            else if (tile < 12) { v2u w; w.x = cvt_pk_bf16(a[0], a[1]); w.y = cvt_pk_bf16(a[2], a[3]); bf16* KV = (tile < 8) ? WSP(bf16, WS_KB) : WSP(bf16, WS_VB);
                bf16* kp = KV + (size_t)(48 + y) * ATTW + (tile & 3) * 256 + n;
_Pragma("unroll 1")
                for (int bb = 0; bb < NB; ++bb) { *(v2u*)kp = w; kp += (size_t)KSEQ * ATTW; } }
            else { v2u w; w.x = cvt_pk_bf16(sigmoidf_fast(a[0]), sigmoidf_fast(a[1])); w.y = cvt_pk_bf16(sigmoidf_fast(a[2]), sigmoidf_fast(a[3]));
                bf16* SG = (tile < 28) ? WSP(bf16, WS_SGA) : WSP(bf16, WS_SGC); *(v2u*)(SG + (size_t)(MR + y) * DM + ((tile - 20) & 7) * 256 + n) = w; }
        }
    }
}

struct GridSched {
    pg8::GridOrder go; const char* A; const char* B; size_t tstep;
    __device__ __forceinline__ unsigned goff(int, int) const { return 0u; }
    __device__ __forceinline__ bool next(int i, pg8::Unit& u) const { u.aux = 0; return go.tile(i, u.pm, u.pn); }
    __device__ __forceinline__ const char* opA(const pg8::Unit& u) const { return A + (size_t)u.pm * tstep; }
    __device__ __forceinline__ const char* opB(const pg8::Unit& u) const { return B + (size_t)u.pn * tstep; }
};
struct DualSched {
    pg8::GridOrder go; const char *A0, *B0, *A1, *B1; size_t tstep;
    __device__ __forceinline__ unsigned goff(int, int) const { return 0u; }
    __device__ __forceinline__ bool next(int i, pg8::Unit& u) const { u.aux = i & 1; return go.tile(i >> 1, u.pm, u.pn); }
    __device__ __forceinline__ const char* opA(const pg8::Unit& u) const { return (u.aux ? A1 : A0) + (size_t)u.pm * tstep; }
    __device__ __forceinline__ const char* opB(const pg8::Unit& u) const { return (u.aux ? B1 : B0) + (size_t)u.pn * tstep; }
};
struct MoeSched {
    const LAS int* tb; int npn, G, c; const char* A; const char* W; size_t a_tstep, w_estride, w_tstep; const LAS unsigned* gtab;
    __device__ __forceinline__ unsigned goff(int ui, int row) const { return gtab[ui * 256 + row]; }
    __device__ __forceinline__ bool next(int i, pg8::Unit& u) const {
        const int L = i * G + c, T = L / npn; if (T >= tb[32]) return false;
        int e = 0;
#pragma unroll 1
        for (int q = 1; q < 32; ++q) e += (tb[q] <= T) ? 1 : 0;
        u.pm = T; u.pn = L - T * npn; u.aux = e; return true; }
    __device__ __forceinline__ const char* opA(const pg8::Unit& u) const { return A + (size_t)u.pm * a_tstep; }
    __device__ __forceinline__ const char* opB(const pg8::Unit& u) const { return W + (size_t)u.aux * w_estride + (size_t)u.pn * w_tstep; }
};
typedef f32x4 Acc[2][2][4][2];
__device__ __forceinline__ v4u pack8(const f32x4 a, const f32x4 b) { v4u w; w.x = cvt_pk_bf16(a[0], a[1]); w.y = cvt_pk_bf16(a[2], a[3]); w.z = cvt_pk_bf16(b[0], b[1]); w.w = cvt_pk_bf16(b[2], b[3]); return w; }
__device__ __forceinline__ f32x4 sig4(const f32x4 a) { return (f32x4){sigmoidf_fast(a[0]), sigmoidf_fast(a[1]), sigmoidf_fast(a[2]), sigmoidf_fast(a[3])}; }
struct EpiIn {
    static constexpr bool PERM = true;
    bf16 *Q, *KB, *VB, *ZG, *SGA, *SGC;
    __device__ __forceinline__ bool keep(const pg8::Unit&) const { return false; }
    __device__ __forceinline__ void operator()(Acc& acc, const pg8::Unit& u, int wr, int wc, int fr, int fq) const {
        const int pn = u.pn, m0 = u.pm * 256, b = m0 >> 11, rl = wr * 64 + fr, cw = wc * 32 + 8 * fq;
        if (pn < 12) {
            const int which = pn >> 2; bf16* base; size_t row0; float sc = W8I;
            if (which == 0) { base = Q; row0 = (size_t)m0; sc = C2 * W8I; } else { base = (which == 1) ? KB : VB; row0 = (size_t)m0 + 64 * (b + 1); }
            base += (pn & 3) * 256 + cw;
#pragma unroll
            for (int ai = 0; ai < 2; ++ai)
#pragma unroll
                for (int m = 0; m < 4; ++m) { bf16* rowp = base + (row0 + rl + ai * 128 + m * 16) * ATTW;
#pragma unroll
                    for (int bj = 0; bj < 2; ++bj) *(GAS v4u*)(rowp + bj * 128) = pack8(acc[ai][bj][m][0] * sc, acc[ai][bj][m][1] * sc); }
        } else if (pn < 20) {
            bf16* base = ZG + (pn - 12) * 128 + cw; const size_t row0 = (size_t)m0 + 16 * (b + 1);
#pragma unroll
            for (int ai = 0; ai < 2; ++ai)
#pragma unroll
                for (int m = 0; m < 4; ++m) { bf16* rowp = base + (row0 + rl + ai * 128 + m * 16) * CONVC;
                    *(GAS v4u*)rowp = pack8(acc[ai][0][m][0] * W8I * sig4(acc[ai][1][m][0] * W8I), acc[ai][0][m][1] * W8I * sig4(acc[ai][1][m][1] * W8I)); }
        } else {
            bf16* base = ((pn < 28) ? SGA : SGC) + ((pn - 20) & 7) * 256 + cw;
#pragma unroll
            for (int ai = 0; ai < 2; ++ai)
#pragma unroll
                for (int m = 0; m < 4; ++m) { bf16* rowp = base + (size_t)(m0 + rl + ai * 128 + m * 16) * DM;
#pragma unroll
                    for (int bj = 0; bj < 2; ++bj) *(GAS v4u*)(rowp + bj * 128) = pack8(sig4(acc[ai][bj][m][0] * W8I), sig4(acc[ai][bj][m][1] * W8I)); }
        }
    }
};
struct EpiDual {
    static constexpr bool PERM = true;
    const bf16 *SGA, *SGC; bf16* MG;
    __device__ __forceinline__ bool keep(const pg8::Unit& u) const { return u.aux == 0; }
    __device__ __forceinline__ void operator()(Acc& acc, const pg8::Unit& u, int wr, int wc, int fr, int fq) const {
        const size_t off0 = (size_t)(u.pm * 256 + wr * 64 + fr) * DM + u.pn * 256 + wc * 32 + 8 * fq;
        if (u.aux == 0) {
#pragma unroll
            for (int ai = 0; ai < 2; ++ai)
#pragma unroll
                for (int m = 0; m < 4; ++m)
#pragma unroll
                    for (int bj = 0; bj < 2; ++bj) { const size_t off = off0 + (size_t)(ai * 128 + m * 16) * DM + bj * 128;
                        const v4u c = *(const GAS v4u*)(SGC + off), a = *(const GAS v4u*)(SGA + off);
                        const f32x4 c0 = {bf_lo(c.x), bf_hi(c.x), bf_lo(c.y), bf_hi(c.y)}, c1 = {bf_lo(c.z), bf_hi(c.z), bf_lo(c.w), bf_hi(c.w)};
                        const f32x4 a0 = {bf_lo(a.x), bf_hi(a.x), bf_lo(a.y), bf_hi(a.y)}, a1 = {bf_lo(a.z), bf_hi(a.z), bf_lo(a.w), bf_hi(a.w)};
#pragma unroll
                        for (int q = 0; q < 4; ++q) { acc[ai][bj][m][0][q] *= a0[q] * __builtin_amdgcn_rcpf(c0[q]); acc[ai][bj][m][1][q] *= a1[q] * __builtin_amdgcn_rcpf(c1[q]); } }
        } else {
#pragma unroll
            for (int ai = 0; ai < 2; ++ai)
#pragma unroll
                for (int m = 0; m < 4; ++m)
#pragma unroll
                    for (int bj = 0; bj < 2; ++bj) { const size_t off = off0 + (size_t)(ai * 128 + m * 16) * DM + bj * 128;
                        const v4u c = *(const GAS v4u*)(SGC + off);
                        const f32x4 c0 = {bf_lo(c.x), bf_hi(c.x), bf_lo(c.y), bf_hi(c.y)}, c1 = {bf_lo(c.z), bf_hi(c.z), bf_lo(c.w), bf_hi(c.w)};
                        *(GAS v4u*)(MG + off) = pack8(acc[ai][bj][m][0] * c0, acc[ai][bj][m][1] * c1); }
        }
    }
};
struct EpiRes {
    static constexpr bool PERM = true;
    const float* basef; bf16* res;
    __device__ __forceinline__ bool keep(const pg8::Unit&) const { return false; }
    __device__ __forceinline__ void operator()(Acc& acc, const pg8::Unit& u, int wr, int wc, int fr, int fq) const {
        const size_t off0 = (size_t)(u.pm * 256 + wr * 64 + fr) * DM + u.pn * 256 + wc * 32 + 8 * fq;
#pragma unroll
        for (int ai = 0; ai < 2; ++ai)
#pragma unroll
            for (int m = 0; m < 4; ++m)
#pragma unroll
                for (int bj = 0; bj < 2; ++bj) { const size_t off = off0 + (size_t)(ai * 128 + m * 16) * DM + bj * 128; f32x4 b0, b1;
                    if (basef) { b0 = *(const GAS f32x4*)(basef + off); b1 = *(const GAS f32x4*)(basef + off + 4); }
                    else { const v4u c = *(const GAS v4u*)(res + off); b0 = (f32x4){bf_lo(c.x), bf_hi(c.x), bf_lo(c.y), bf_hi(c.y)}; b1 = (f32x4){bf_lo(c.z), bf_hi(c.z), bf_lo(c.w), bf_hi(c.w)}; }
                    *(GAS v4u*)(res + off) = pack8(b0 + acc[ai][bj][m][0], b1 + acc[ai][bj][m][1]); }
    }
};
struct EpiGlu {
    static constexpr bool PERM = true;
    bf16* H;
    __device__ __forceinline__ bool keep(const pg8::Unit&) const { return false; }
    __device__ __forceinline__ void operator()(Acc& acc, const pg8::Unit& u, int wr, int wc, int fr, int fq) const {
        bf16* base = H + (size_t)(u.pm * 256 + wr * 64 + fr) * DE + u.pn * 128 + wc * 32 + 8 * fq;
#pragma unroll
        for (int ai = 0; ai < 2; ++ai)
#pragma unroll
            for (int m = 0; m < 4; ++m) { const f32x4 g0 = acc[ai][0][m][0], g1 = acc[ai][0][m][1];
                *(GAS v4u*)(base + (size_t)(ai * 128 + m * 16) * DE) = pack8(g0 * sig4(g0) * acc[ai][1][m][0], g1 * sig4(g1) * acc[ai][1][m][1]); }
    }
};
struct EpiDown {
    static constexpr bool PERM = true;
    const LAS int* tb; const LAS int* cn; const int* perm; const float* wts; bf16 *Y0, *Y1;
    __device__ __forceinline__ bool keep(const pg8::Unit&) const { return false; }
    __device__ __forceinline__ void operator()(Acc& acc, const pg8::Unit& u, int wr, int wc, int fr, int fq) const {
        const int e = u.aux, r0 = (u.pm - tb[e]) * 256 + wr * 64 + fr, cnt = cn[e], col = u.pn * 256 + wc * 32 + 8 * fq;
#pragma unroll
        for (int ai = 0; ai < 2; ++ai)
#pragma unroll
            for (int m = 0; m < 4; ++m) { const int r = r0 + ai * 128 + m * 16;
                if (r < cnt) { const int id = perm[(size_t)e * PCAP + r]; const float w = wts[id]; bf16* rowp = ((id & 1) ? Y1 : Y0) + (size_t)(id >> 1) * DM + col;
#pragma unroll
                    for (int bj = 0; bj < 2; ++bj) *(GAS v4u*)(rowp + bj * 128) = pack8(acc[ai][bj][m][0] * w, acc[ai][bj][m][1] * w); } }
    }
};

__device__ __forceinline__ void cum_table(Frame& F, int bh) {
    int tid_ = F.tid; asm volatile("" : "+v"(tid_)); const int lane = tid_ & 63, wave = __builtin_amdgcn_readfirstlane(tid_ >> 6);
    LAS float* cs = (LAS float*)(F.lds + RING_OFF + attn_body::LDS_CS); LAS float* tot = (LAS float*)(F.lds + RING_OFF + attn_body::LDS_TOT);
    const GAS float* lf = (const GAS float*)WSP(float, WS_LOGF) + (size_t)bh * KSEQ;
    constexpr int NCH = KSEQ / 64;
    for (int c = wave; c < NCH; c += NWAVES) { const int row = 64 * c + lane; float v = (row >= 48) ? lf[row] : 0.f;
#pragma unroll
        for (int o = 1; o < 64; o <<= 1) { const float t = shfl_idx(v, lane - o); if (lane >= o) v += t; }
        cs[row] = v; if (lane == 63) tot[c] = v; }
    LDS_WAIT(); __syncthreads();
    float tv = (lane < NCH) ? tot[lane] : 0.f, inc = tv;
#pragma unroll
    for (int o = 1; o < 64; o <<= 1) { const float t = shfl_idx(inc, lane - o); if (lane >= o) inc += t; }
    const float exc = inc - tv;
    for (int c = wave; c < NCH; c += NWAVES) { const int row = 64 * c + lane; const float off = __int_as_float(__builtin_amdgcn_readlane(__float_as_int(exc), c));
        cs[row] = (row >= 48) ? cs[row] + off : INFINITY; }
    LDS_WAIT(); __syncthreads();
}
__device__ __forceinline__ void meta_attn_head(Frame& F, int h) {
    OPAQUE_IDS();
    const bf16* Qm = WSP(bf16, WS_QO) + (size_t)MR * ATTW + h * HD; const bf16* Km = WSP(bf16, WS_KB) + (size_t)48 * ATTW + h * HD; const bf16* Vm = WSP(bf16, WS_VB) + (size_t)48 * ATTW + h * HD;
    const float* lf = WSP(float, WS_LOGF) + (size_t)h * KSEQ + 48;
    const int i = lane_ & 15, qd = (lane_ >> 4) * 16;
    float q[16];
#pragma unroll
    for (int d = 0; d < 16; ++d) q[d] = bf_lo((unsigned)Qm[(size_t)i * ATTW + qd + d]);
    float cum[16]; { float c = 0.f;
#pragma unroll
        for (int j = 0; j < 16; ++j) { c += lf[j]; cum[j] = c; } }
    float ci = 0.f;
#pragma unroll
    for (int j = 0; j < 16; ++j) ci = (j == i) ? cum[j] : ci;
    float s[16], mx = -INFINITY;
#pragma unroll
    for (int j = 0; j < 16; ++j) { float p = 0.f;
#pragma unroll
        for (int d = 0; d < 16; ++d) p += q[d] * bf_lo((unsigned)Km[(size_t)j * ATTW + qd + d]);
        p += swz_xor<16>(p); p = xor32_sum(p);
        s[j] = (j <= i) ? p + ci - cum[j] : -INFINITY; mx = fmaxf(mx, s[j]); }
    float den = 0.f, o[16];
#pragma unroll
    for (int d = 0; d < 16; ++d) o[d] = 0.f;
#pragma unroll
    for (int j = 0; j < 16; ++j) { const float p = __builtin_amdgcn_exp2f(s[j] - mx); den += p;
#pragma unroll
        for (int d = 0; d < 16; ++d) o[d] += p * bf_lo((unsigned)Vm[(size_t)j * ATTW + qd + d]); }
    const float inv = 1.0f / den;
    bf16* Om = WSP(bf16, WS_O) + (size_t)(MR + i) * ATTW + h * HD + qd;
#pragma unroll
    for (int d = 0; d < 16; d += 2) *(unsigned*)(Om + d) = cvt_pk_bf16(o[d] * inv, o[d + 1] * inv);
}
__device__ __forceinline__ void conv_item(Frame& F, int l, int b, int p0, int out_row0) {
    int tid_ = F.tid; asm volatile("" : "+v"(tid_));
    const int c2 = tid_ * 2;
    const float* cw = F.in[6] + (size_t)l * CONVK * CONVC; const float cb0 = F.in[7][l * CONVC + c2], cb1 = F.in[7][l * CONVC + c2 + 1];
    LAS float* zb = (LAS float*)(F.lds + RING_OFF);
    f32x2 w[CONVK];
#pragma unroll
    for (int j = 0; j < CONVK; ++j) w[j] = *(const GAS f32x2*)(cw + (size_t)j * CONVC + c2);
    LAS unsigned char* win = F.lds + RING_OFF;
    { const GAS char* zsrc = (const GAS char*)WSP(bf16, WS_ZG) + ((size_t)b * ZSEQ + p0 - 30) * (CONVC * 2);
#pragma unroll
      for (int k = 0; k < 12; ++k) { const int q = tid_ + 512 * k; if (q < 46 * 128) { v4u v = {0u, 0u, 0u, 0u}; if (p0 - 30 + (q >> 7) >= 0) v = *(const GAS v4u*)(zsrc + (size_t)q * 16); *(LAS v4u*)(win + q * 16) = v; } } }
    LDS_WAIT(); __syncthreads();
    f32x2 a[16];
#pragma unroll
    for (int o = 0; o < 16; ++o) a[o] = (f32x2){cb0, cb1};
#pragma unroll
    for (int i = 0; i < 46; ++i) { const unsigned u = *(const LAS unsigned*)(win + i * (CONVC * 2) + tid_ * 4);
        const f32x2 x = {bf_lo(u), bf_hi(u)};
#pragma unroll
        for (int o = 0; o < 16; ++o) if (i - o >= 0 && i - o < CONVK) a[o] += w[i - o] * x; }
    LDS_WAIT(); __syncthreads();
#pragma unroll
    for (int o = 0; o < 16; ++o) *(LAS f32x2*)(zb + o * CONVC + c2) = a[o];
    LDS_WAIT(); __syncthreads();
    const int ln = tid_ & 63, wv_ = tid_ >> 6;
    const float* lg = F.in[8] + (size_t)l * CONVC; const float* lb = F.in[9] + (size_t)l * CONVC;
#pragma unroll
    for (int rr = 0; rr < 2; ++rr) { const int o = wv_ * 2 + rr;
        f32x4 v[4]; float s = 0.f;
#pragma unroll
        for (int j = 0; j < 4; ++j) { v[j] = *(const LAS f32x4*)(zb + o * CONVC + 4 * (ln + 64 * j)); s += (v[j].x + v[j].y) + (v[j].z + v[j].w); }
        const float mu = wave_sum(s) * (1.0f / CONVC); float q = 0.f;
#pragma unroll
        for (int j = 0; j < 4; ++j) { v[j] = v[j] - mu; q += (v[j].x * v[j].x + v[j].y * v[j].y) + (v[j].z * v[j].z + v[j].w * v[j].w); }
        const float rstd = 1.0f / sqrtf(wave_sum(q) * (1.0f / CONVC) + LN_EPS);
        bf16* op = WSP(bf16, WS_CV) + (size_t)(out_row0 + o) * CONVC;
#pragma unroll
        for (int j = 0; j < 4; ++j) { const int c = 4 * (ln + 64 * j); const f32x4 gg = *(const GAS f32x4*)(lg + c), bb = *(const GAS f32x4*)(lb + c);
            f32x4 z = v[j] * rstd * gg + bb; z = z * sig4(z); v2u wv; wv.x = cvt_pk_bf16(z.x, z.y); wv.y = cvt_pk_bf16(z.z, z.w); *(GAS v2u*)(op + c) = wv; } }
    __syncthreads();
}
__device__ __forceinline__ void pc_phase(Frame& F, int l, char* ldsg) {
    for (int rep3 = 0; rep3 < ((REP_PHASE == 3) ? 2 : 1); ++rep3)
    for (int v = F.vcu; v < 2 * NB * NH; v += F.G) {
        const int bh = v >> 1, s0 = 2 * (v & 1);
        cum_table(F, bh);
        const __hip_bfloat16* Q = (const __hip_bfloat16*)WSP(bf16, WS_QO); const __hip_bfloat16* K = (const __hip_bfloat16*)WSP(bf16, WS_KB); const __hip_bfloat16* V = (const __hip_bfloat16*)WSP(bf16, WS_VB);
#pragma unroll 1
        for (int i = 0; i < 4; ++i) { const int qb = (i == 0) ? s0 : (i == 1) ? 7 - s0 : (i == 2) ? s0 + 1 : 6 - s0;
#ifndef NO_ATTN
            attn_body::attn_unit<8>(bh / NH, bh % NH, qb, Q, K, V, (__hip_bfloat16*)WSP(bf16, WS_O), ldsg + RING_OFF);
#endif
        }
        __syncthreads();
    }
#ifndef NO_MATTN
    if (F.vcu >= F.G - 2) meta_attn_head(F, (F.vcu - (F.G - 2)) * 8 + F.wave);
#endif
    __syncthreads();
#ifndef NO_CONV
    for (int rep30 = 0; rep30 < ((REP_PHASE == 30) ? 2 : 1); ++rep30)
    for (int it = F.vcu; it < MR / 16 + 1; it += F.G) {
        const bool real = it < MR / 16; const int b = real ? it >> 7 : 0, t0 = (it & 127) * 16;
        conv_item(F, l, b, real ? NMETA + t0 : 0, real ? b * SEQ + t0 : MR);
    }
#endif
}
__device__ __forceinline__ void pd_side(Frame& F, int l) {
    OPAQUE_IDS();
    const int j = F.NGW - 1 - F.gw; if (j >= DM / 16) return;
    const unsigned char* wl = F.ws + WS_W + (size_t)l * W_LSTRIDE; const int g4 = (lane_ >> 4) * 4, y = lane_ & 15;
    const f32x4 a1 = mm16((const bf16*)(wl + WO_AO) + (size_t)j * 16 * ATTW, ATTW, WSP(bf16, WS_O) + (size_t)MR * ATTW, ATTW, ATTW, (f32x4){0.f, 0.f, 0.f, 0.f}, lane_);
    const f32x4 a2 = mm16((const bf16*)(wl + WO_CO) + (size_t)j * 16 * CONVC, CONVC, WSP(bf16, WS_CV) + (size_t)MR * CONVC, CONVC, CONVC, (f32x4){0.f, 0.f, 0.f, 0.f}, lane_);
    const size_t off = (size_t)(MR + y) * DM + j * 16 + g4;
    const v2u ga = *(const GAS v2u*)(WSP(bf16, WS_SGA) + off), gc = *(const GAS v2u*)(WSP(bf16, WS_SGC) + off);
    v2u w; w.x = cvt_pk_bf16(bf_lo(ga.x) * a1[0] + bf_lo(gc.x) * a2[0], bf_hi(ga.x) * a1[1] + bf_hi(gc.x) * a2[1]);
    w.y = cvt_pk_bf16(bf_lo(ga.y) * a1[2] + bf_lo(gc.y) * a2[2], bf_hi(ga.y) * a1[3] + bf_hi(gc.y) * a2[3]);
    *(GAS v2u*)(WSP(bf16, WS_MG) + off) = w;
}
__device__ __forceinline__ void pe_side(Frame& F, int l) {
    OPAQUE_IDS();
    const int j = F.NGW - 1 - F.gw; if (j >= DM / 16) return;
    const unsigned char* wl = F.ws + WS_W + (size_t)l * W_LSTRIDE; const int g4 = (lane_ >> 4) * 4, y = lane_ & 15;
    const f32x4 a = mm16((const bf16*)(wl + WO_O) + (size_t)j * 16 * DM, DM, WSP(bf16, WS_MG) + (size_t)MR * DM, DM, DM, (f32x4){0.f, 0.f, 0.f, 0.f}, lane_);
    bf16* rp = WSP(bf16, WS_RES) + (size_t)(MR + y) * DM + j * 16 + g4; f32x4 bv;
    if (l == 0) bv = *(const GAS f32x4*)(F.in[1] + (size_t)y * DM + j * 16 + g4);
    else { const v2u c = *(const GAS v2u*)rp; bv = (f32x4){bf_lo(c.x), bf_hi(c.x), bf_lo(c.y), bf_hi(c.y)}; }
    bv = bv + a; v2u w; w.x = cvt_pk_bf16(bv[0], bv[1]); w.y = cvt_pk_bf16(bv[2], bv[3]); *(GAS v2u*)rp = w;
}
__device__ __forceinline__ void pg_router(Frame& F, int l) {
    OPAQUE_IDS();
    if (F.gw >= MT / 16) return;
    const int rb = F.gw, g4 = (lane_ >> 4) * 4, y = lane_ & 15;
    LAS float* scr = (LAS float*)(F.lds + RING_OFF) + wave_ * (16 * 49);
    const bf16* Yp = WSP(bf16, WS_N2) + (size_t)rb * 16 * DM; const bf16* WrT = WSP(bf16, WS_WR) + (size_t)l * 48 * DM;
#pragma unroll
    for (int blk = 0; blk < 3; ++blk) { const f32x4 a = mm16(WrT + (size_t)blk * 16 * DM, DM, Yp, DM, DM, (f32x4){0.f, 0.f, 0.f, 0.f}, lane_);
#pragma unroll
        for (int r = 0; r < 4; ++r) scr[y * 49 + blk * 16 + g4 + r] = a[r]; }
    LDS_WAIT(); asm volatile("" ::: "memory");
    if (lane_ < 16) {
        const LAS float* lg = scr + lane_ * 49; const int m = rb * 16 + lane_;
        float gl[NGRP]; int gi = 0;
#pragma unroll
        for (int g = 0; g < NGRP; ++g) gl[g] = lg[g] + F.in[14][l * NGRP + g];
#pragma unroll
        for (int g = 1; g < NGRP; ++g) if (gl[g] > gl[gi]) gi = g;
        float gmax = gl[0];
#pragma unroll
        for (int g = 1; g < NGRP; ++g) gmax = fmaxf(gmax, gl[g]);
        float den = 0.f;
#pragma unroll
        for (int g = 0; g < NGRP; ++g) den += expf(gl[g] - gmax);
        const float gw = 1.0f / den;
        float ev[EPG];
#pragma unroll
        for (int i = 0; i < EPG; ++i) ev[i] = lg[NGRP + gi * EPG + i] + F.in[16][l * NE + gi * EPG + i];
        int i0 = 0;
#pragma unroll
        for (int i = 1; i < EPG; ++i) if (ev[i] > ev[i0]) i0 = i;
        float v0 = ev[0];
#pragma unroll
        for (int i = 1; i < EPG; ++i) v0 = fmaxf(v0, ev[i]);
        int i1 = (i0 == 0) ? 1 : 0; float v1 = -INFINITY;
#pragma unroll
        for (int i = 0; i < EPG; ++i) if (i != i0 && ev[i] > v1) { v1 = ev[i]; i1 = i; }
        const float w0 = gw / (1.0f + expf(v1 - v0)), w1 = gw - w0;
        unsigned* cnt = (unsigned*)(F.ctl + CW_CNT + l * 64); int* perm = WSP(int, WS_PERM); float* wts = WSP(float, WS_WTS);
        const int e0 = gi * EPG + i0, e1 = gi * EPG + i1;
        const unsigned q0 = __hip_atomic_fetch_add(cnt + e0, 1u, RLX_AGENT), q1 = __hip_atomic_fetch_add(cnt + e1, 1u, RLX_AGENT);
        perm[(size_t)e0 * PCAP + q0] = 2 * m; perm[(size_t)e1 * PCAP + q1] = 2 * m + 1; wts[2 * m] = w0; wts[2 * m + 1] = w1;
    }
}
__device__ __forceinline__ void moe_tables(Frame& F, int l) {
    OPAQUE_IDS();
    LAS int* tb = (LAS int*)(F.lds + TAB_OFF); LAS int* cn = tb + 40;
    if (wave_ == 0) { const int c = (lane_ < NE) ? (int)__hip_atomic_load((unsigned*)(F.ctl + CW_CNT + l * 64 + lane_), RLX_AGENT) : 0; int nt = (c + 255) >> 8, inc = nt;
#pragma unroll
        for (int o = 1; o < 64; o <<= 1) { const int t = shfl_idx_i(inc, lane_ - o); if (lane_ >= o) inc += t; }
        if (lane_ < NE) { tb[lane_] = inc - nt; cn[lane_] = c; } if (lane_ == NE) tb[NE] = inc; }
    LDS_WAIT(); __syncthreads();
}
__device__ __forceinline__ void moe_gather_table(Frame& F, int npn) {
    OPAQUE_IDS();
    const LAS int* tb = (const LAS int*)(F.lds + TAB_OFF); const LAS int* cn = tb + 40; LAS unsigned* gt = (LAS unsigned*)(F.lds + GTAB_OFF);
    const int* perm = WSP(int, WS_PERM);
    for (int i = 0; i < GTAB_UNITS; ++i) { const int L = i * F.G + (int)blockIdx.x, T = L / npn; if (T >= tb[NE]) break;
        int e = 0;
#pragma unroll 1
        for (int q = 1; q < NE; ++q) e += (tb[q] <= T) ? 1 : 0;
        if (tid_ < 256) { const int r = (T - tb[e]) * 256 + tid_; const int tok = (r < cn[e]) ? (perm[(size_t)e * PCAP + r] >> 1) : 0; gt[i * 256 + tid_] = (unsigned)tok * (unsigned)(DM * 2); } }
    LDS_WAIT(); __syncthreads();
}

struct Args { const float* in[20]; float* out; unsigned char* ws; int ph_lo, ph_hi; };
constexpr int N_PHASES = 22;
__global__ void __launch_bounds__(NWAVES * 64, 2) fox_fwd(Args args) {
    extern __shared__ __attribute__((aligned(16))) unsigned char lds[];
#ifdef USE_AGPR_HINT
    { float dummy_ = 0.f; asm volatile("" :: "a"(dummy_)); }
#endif
    Frame F;
    F.lds = (LAS unsigned char*)lds; F.MISC = (volatile LAS unsigned*)(F.lds + MISC_OFF);
    F.tid = threadIdx.x; F.lane = F.tid & 63; F.wave = __builtin_amdgcn_readfirstlane(F.tid >> 6);
    F.G = gridDim.x; { const int bx = blockIdx.x; F.vcu = (F.G % 8 == 0) ? (bx % 8) * (F.G / 8) + bx / 8 : bx; }
    F.gw = F.vcu * NWAVES + F.wave; F.NGW = F.G * NWAVES;
    F.ws = args.ws; F.in = args.in; F.ctl = (gu32*)(args.ws + WS_CTL);
    for (int u = F.tid; u < (LDS_BYTES - MISC_OFF) / 4; u += NWAVES * 64) ((LAS unsigned*)(F.lds + MISC_OFF))[u] = 0u;
    __syncthreads();
    const int lo = args.ph_lo, hi = args.ph_hi;
    const bool one_launch = (hi - lo) > 1;
    XcdBarrier bar; bar.bar = (unsigned*)(F.ctl + CW_BAR); bar.x = 0; bar.st = nullptr;
    if (one_launch) bar = xcd_barrier_post((unsigned*)(F.ctl + CW_BAR), F.MISC + 8);
#ifndef PH_MASK
#define PH_MASK 0xffffffffu
#endif
#define IN(k) (((PH_MASK >> ((k) > 10 ? (k) - 10 : (k))) & 1u) && lo <= (k) && (k) < hi)
#define SEAM(k) do { if (IN(k) && IN((k) + 1)) xcd_barrier(bar); } while (0)
#define REPS(j) (((REP_PHASE) == (j)) ? 2 : 1)
#define REPBAR(rep) do { if ((rep) == 0 && one_launch) xcd_barrier(bar); } while (0)
    LAS unsigned char* ring = F.lds + RING_OFF;
    const int bx = (int)blockIdx.x;

    if (IN(0)) for (int rep = 0; rep < REPS(0); ++rep) { p0_convert(F); norm_phase<0>(F, F.in[2], WSP(bf16, WS_XN), nullptr); if (REPS(0) > 1) REPBAR(rep); }
    SEAM(0);
#pragma unroll 1
    for (int l = 0; l < DEPTH; ++l) {
        const int P = 1 + 10 * l;
        const unsigned char* wl = F.ws + WS_W + (size_t)l * W_LSTRIDE;
        if (l > 0) { if (IN(P)) norm_phase<1>(F, F.in[2] + (size_t)l * DM, WSP(bf16, WS_XN), nullptr); SEAM(P); }
        if (IN(P + 1)) for (int rep = 0; rep < REPS(2); ++rep) {
            if (rep > 0) REPBAR(0);
#ifndef NO_PBSIDE
            pb_side(F, l); VM_WAIT(); __syncthreads();
#endif
            GridSched S; S.go.init(MR / 256, 36, F.G, bx); S.A = (const char*)(F.ws + WS_XN8); S.B = (const char*)(wl + WO_IN); S.tstep = (size_t)256 * DM;
            EpiIn E{WSP(bf16, WS_QO), WSP(bf16, WS_KB), WSP(bf16, WS_VB), WSP(bf16, WS_ZG), WSP(bf16, WS_SGA), WSP(bf16, WS_SGC)};
#ifndef NO_PBGEMM
            pg8::gemm_phase<EpiIn, GridSched, true, true>(ring, DM, S, E);
#endif
        }
        SEAM(P + 1);
        if (IN(P + 2)) pc_phase(F, l, (char*)lds);
        SEAM(P + 2);
        if (IN(P + 3)) for (int rep = 0; rep < REPS(4); ++rep) {
            if (rep > 0) REPBAR(0);
            pd_side(F, l); VM_WAIT(); __syncthreads();
            DualSched S; S.go.init(MR / 256, DM / 256, F.G, bx); S.A0 = (const char*)WSP(bf16, WS_O); S.B0 = (const char*)(wl + WO_AO); S.A1 = (const char*)WSP(bf16, WS_CV); S.B1 = (const char*)(wl + WO_CO); S.tstep = (size_t)256 * ATTW * 2;
            EpiDual E{WSP(bf16, WS_SGA), WSP(bf16, WS_SGC), WSP(bf16, WS_MG)};
            pg8::gemm_phase<EpiDual, DualSched, true>(ring, ATTW * 2, S, E);
        }
        SEAM(P + 3);
        if (IN(P + 4)) for (int rep = 0; rep < ((l == 0) ? REPS(5) : 1); ++rep) {
            if (rep > 0) REPBAR(0);
            pe_side(F, l); VM_WAIT(); __syncthreads();
            GridSched S; S.go.init(MR / 256, DM / 256, F.G, bx); S.A = (const char*)WSP(bf16, WS_MG); S.B = (const char*)(wl + WO_O); S.tstep = (size_t)256 * DM * 2;
            EpiRes E{(l == 0) ? F.in[0] : nullptr, WSP(bf16, WS_RES)};
            pg8::gemm_phase<EpiRes, GridSched, true>(ring, DM * 2, S, E);
        }
        SEAM(P + 4);
        if (IN(P + 5)) for (int rep = 0; rep < REPS(6); ++rep) { if (rep > 0) REPBAR(0); norm_phase<2>(F, F.in[12] + (size_t)l * DM, WSP(bf16, WS_N2), nullptr); }
        SEAM(P + 5);
        if (IN(P + 6)) pg_router(F, l);
        SEAM(P + 6);
        if (IN(P + 8)) for (int rep = 0; rep < REPS(9); ++rep) {
            if (rep > 0) REPBAR(0);
            moe_tables(F, l); moe_gather_table(F, DE / 128);
            MoeSched S; S.tb = (const LAS int*)(F.lds + TAB_OFF); S.npn = DE / 128; S.G = F.G; S.c = bx; S.A = (const char*)WSP(bf16, WS_N2); S.W = (const char*)(wl + WO_GU);
            S.a_tstep = 0; S.w_estride = (size_t)(2 * DE) * DM * 2; S.w_tstep = (size_t)256 * DM * 2; S.gtab = (const LAS unsigned*)(F.lds + GTAB_OFF);
            EpiGlu E{WSP(bf16, WS_H)};
            pg8::gemm_phase<EpiGlu, MoeSched, true, false, true>(ring, DM * 2, S, E);
        }
        SEAM(P + 8);
        if (IN(P + 9)) for (int rep = 0; rep < REPS(10); ++rep) {
            if (rep > 0) REPBAR(0);
            moe_tables(F, l);
            MoeSched S; S.tb = (const LAS int*)(F.lds + TAB_OFF); S.npn = DM / 256; S.G = F.G; S.c = bx; S.A = (const char*)WSP(bf16, WS_H); S.W = (const char*)(wl + WO_DN);
            S.a_tstep = (size_t)256 * DE * 2; S.w_estride = (size_t)DM * DE * 2; S.w_tstep = (size_t)256 * DE * 2; S.gtab = nullptr;
            EpiDown E{(const LAS int*)(F.lds + TAB_OFF), (const LAS int*)(F.lds + TAB_OFF) + 40, WSP(int, WS_PERM), WSP(float, WS_WTS), WSP(bf16, WS_Y0), WSP(bf16, WS_Y1)};
            pg8::gemm_phase<EpiDown, MoeSched, true>(ring, DE * 2, S, E);
        }
        SEAM(P + 9);
    }
#if DBG_DUMP == 0
    if (IN(21)) for (int rep = 0; rep < REPS(21); ++rep) { if (rep > 0) REPBAR(0); norm_phase<3>(F, F.in[19], nullptr, args.out); }
#else
    if (IN(21)) {
        for (size_t i = (size_t)blockIdx.x * 512 + threadIdx.x; i < (size_t)MR * DM; i += (size_t)gridDim.x * 512) { const size_t m = i / DM, c = i % DM; float v = 0.f;
            if (DBG_DUMP == 1) v = bf_lo(WSP(bf16, WS_RES)[i]);
            else if (DBG_DUMP == 2) v = bf_lo(WSP(bf16, WS_Y0)[i]) + bf_lo(WSP(bf16, WS_Y1)[i]);
            else if (DBG_DUMP == 3) v = bf_lo(WSP(bf16, WS_MG)[i]);
            else if (DBG_DUMP == 4) v = (c < 1024) ? bf_lo(WSP(bf16, WS_O)[m * 1024 + c]) : bf_lo(WSP(bf16, WS_CV)[m * 1024 + c - 1024]);
            else if (DBG_DUMP == 5) v = bf_lo(WSP(bf16, WS_XN)[i]);
            else if (DBG_DUMP == 6) v = bf_lo(WSP(bf16, WS_SGA)[i]) + bf_lo(WSP(bf16, WS_SGC)[i]);
            else if (DBG_DUMP == 7) v = bf_lo(WSP(bf16, WS_N2)[i]);
            else if (DBG_DUMP == 8) { const size_t b = m >> 11, t = m & 2047; v = (c < 1024) ? bf_lo(WSP(bf16, WS_KB)[(b * KSEQ + 64 + t) * 1024 + c]) : bf_lo(WSP(bf16, WS_ZG)[(b * ZSEQ + 16 + t) * 1024 + c - 1024]); }
            args.out[i] = v; }
    }
#endif
#undef IN
#undef SEAM
}

extern "C" void kernel_launch(void* const* d_in, const int* in_sizes, int n_in, void* d_out, int out_size, void* d_ws, size_t ws_size, hipStream_t stream) {
    static int grid = 0;
    if (grid == 0) {
        if (n_in != 20 || out_size != MR * DM || ws_size < WS_END) { fprintf(stderr, "kernel_launch: unexpected problem (n_in %d, out %d, ws %zu); nothing launched\n", n_in, out_size, ws_size); grid = -1; return; }
        int dev = 0, cus = 0, per_cu = 0;
        if (hipGetDevice(&dev) != hipSuccess || hipDeviceGetAttribute(&cus, hipDeviceAttributeMultiprocessorCount, dev) != hipSuccess) { grid = -1; return; }
        if (hipFuncSetAttribute((const void*)fox_fwd, hipFuncAttributeMaxDynamicSharedMemorySize, LDS_BYTES) != hipSuccess) { fprintf(stderr, "kernel_launch: hipFuncSetAttribute failed\n"); grid = -1; return; }
        if (hipOccupancyMaxActiveBlocksPerMultiprocessor(&per_cu, (const void*)fox_fwd, NWAVES * 64, LDS_BYTES) != hipSuccess || per_cu < 1) { fprintf(stderr, "kernel_launch: occupancy query says %d\n", per_cu); }
        (void)hipGetLastError();
        grid = cus;
    }
    if (grid < 0) return;
    if (hipMemsetAsync((char*)d_ws + WS_CTL, 0, CTL_ZERO_BYTES, stream) != hipSuccess) return;
    Args a{};
    for (int i = 0; i < 20; ++i) a.in[i] = (const float*)d_in[i];
    a.out = (float*)d_out; a.ws = (unsigned char*)d_ws;
#if MK_N_LAUNCHES == 1
    a.ph_lo = 0; a.ph_hi = N_PHASES;
    hipLaunchKernelGGL(fox_fwd, dim3(grid), dim3(NWAVES * 64), LDS_BYTES, stream, a);
#else
    for (int p = 0; p < N_PHASES; ++p) { if (p == 1 || p == 8 || p == 18 || (p > DBG_STOP && p != N_PHASES - 1)) continue; a.ph_lo = p; a.ph_hi = p + 1; hipLaunchKernelGGL(fox_fwd, dim3(grid), dim3(NWAVES * 64), LDS_BYTES, stream, a); }
#endif
}
```

```cpp
#include <hip/hip_runtime.h>
#include <hip/hip_bf16.h>
#include <cstdio>
#include <cstdint>
#include <cmath>

#ifndef MK_N_LAUNCHES
#define MK_N_LAUNCHES 1
#endif

#ifndef DBG_DUMP
#define DBG_DUMP 0
#endif
#ifndef DBG_STOP
#define DBG_STOP 100
#endif
#ifndef REP_PHASE
#define REP_PHASE -1
#endif
#define LAS __attribute__((address_space(3)))
#define GAS __attribute__((address_space(1)))
typedef unsigned short bf16;
typedef unsigned v4u __attribute__((ext_vector_type(4)));
typedef unsigned v2u __attribute__((ext_vector_type(2)));
typedef float f32x4 __attribute__((ext_vector_type(4)));
typedef float f32x2 __attribute__((ext_vector_type(2)));
typedef short bf16x8 __attribute__((ext_vector_type(8)));
typedef float f32x16 __attribute__((ext_vector_type(16)));
typedef short s16x4 __attribute__((ext_vector_type(4)));
typedef GAS unsigned gu32;

constexpr int NB = 8, SEQ = 2048, DM = 2048, NMETA = 16, NH = 16, HD = 64, ATTW = 1024, CONVC = 1024, CONVK = 31;
constexpr int NGRP = 4, EPG = 8, NE = 32, DE = 768, INCOLS = 9232, DEPTH = 2;
constexpr int MR = NB * SEQ;
constexpr int MT = MR + NMETA;
constexpr int MALLOC = 16640;
constexpr int KSEQ = 64 + SEQ;
constexpr int ZSEQ = NMETA + SEQ;
constexpr int PCAP = MT;
constexpr int MAXT = 162;
constexpr float RMS_EPS = 1e-6f, LN_EPS = 1e-5f;
constexpr float LOG2E = 1.4426950408889634f;
constexpr float C2 = 0.125f * 1.4426950408889634f;
constexpr float W8S = 32.0f, W8I = 1.0f / 32.0f;

constexpr size_t MiB = 1u << 20;
constexpr size_t WS_CTL = 0, CTL_ZERO_BYTES = 64 * 1024;
constexpr size_t WS_RSTD = 256 * 1024;
constexpr size_t WS_WF = 1 * MiB, WS_WR = 2 * MiB, WS_LOGF = 3 * MiB, WS_PERM = 6 * MiB, WS_WTS = 9 * MiB;
constexpr size_t WS_W = 16 * MiB, W_LSTRIDE = 340 * MiB;
constexpr size_t WO_IN = 0, WO_AO = 36 * MiB, WO_CO = 40 * MiB, WO_O = 44 * MiB, WO_GU = 52 * MiB, WO_DN = 244 * MiB;
constexpr size_t WS_XN = 696 * MiB, WS_QO = 761 * MiB, WS_KB = 794 * MiB, WS_VB = 827 * MiB, WS_ZG = 860 * MiB, WS_SGA = 893 * MiB, WS_SGC = 958 * MiB;
constexpr size_t WS_CV = 1023 * MiB, WS_MG = 1056 * MiB, WS_RES = 1121 * MiB, WS_N2 = 1251 * MiB, WS_XS = 1316 * MiB, WS_H = 1478 * MiB, WS_Y0 = 1539 * MiB, WS_Y1 = 1604 * MiB;
constexpr size_t WS_XN8 = 1669 * MiB;
constexpr size_t WS_O = 1702 * MiB;
constexpr size_t WS_END = 1735 * MiB;
constexpr int CW_TMO = 0, CW_BAR = 4096, CW_CNT = 8192;

#define RLX_AGENT __ATOMIC_RELAXED, __HIP_MEMORY_SCOPE_AGENT
#define LDS_WAIT() asm volatile("s_waitcnt lgkmcnt(0)" ::: "memory")
#define VM_WAIT() asm volatile("s_waitcnt vmcnt(0)" ::: "memory")
typedef __bf16 bf16x2_t __attribute__((ext_vector_type(2)));
__device__ __forceinline__ unsigned cvt_pk_bf16(float lo, float hi) { f32x2 v = {lo, hi}; bf16x2_t b = __builtin_convertvector(v, bf16x2_t); return __builtin_bit_cast(unsigned, b); }
__device__ __forceinline__ float bf_lo(unsigned u) { return __uint_as_float(u << 16); }
__device__ __forceinline__ float bf_hi(unsigned u) { return __uint_as_float(u & 0xffff0000u); }
__device__ __forceinline__ float sigmoidf_fast(float x) { return __builtin_amdgcn_rcpf(1.0f + __builtin_amdgcn_exp2f(-x * LOG2E)); }
template <int X> __device__ __forceinline__ float swz_xor(float v) { return __int_as_float(__builtin_amdgcn_ds_swizzle(__float_as_int(v), 0x1f | (X << 10))); }
__device__ __forceinline__ float xor32_sum(float v) { auto rr = __builtin_amdgcn_permlane32_swap(__float_as_uint(v), __float_as_uint(v), false, false); return __uint_as_float(rr[0]) + __uint_as_float(rr[1]); }
__device__ __forceinline__ float wave_sum(float v) {
    v += swz_xor<1>(v); v += swz_xor<2>(v); v += swz_xor<4>(v); v += swz_xor<8>(v); v += swz_xor<16>(v);
    return xor32_sum(v);
}
__device__ __forceinline__ float shfl_idx(float v, int src_lane) { return __int_as_float(__builtin_amdgcn_ds_bpermute(src_lane << 2, __float_as_int(v))); }
__device__ __forceinline__ int shfl_idx_i(int v, int src_lane) { return __builtin_amdgcn_ds_bpermute(src_lane << 2, v); }

namespace pg8 {
constexpr int BM = 256, BK = 64, HALF = 128, HTB = HALF * BK * 2, STAGE_BYTES = 8 * HTB, NXCD = 8, WGM = 8;
__host__ __device__ __forceinline__ int lds_byte(int r, int c) { const int st = (r >> 4) * 2 + (c >> 5), rr = r & 15, cc = c & 31, ob = rr * 64 + cc * 2; return st * 1024 + (ob ^ (((ob >> 9) & 1) << 5)); }
__host__ __device__ __forceinline__ void stage_rc(int b, int& R, int& C) { const int st = b / 1024, sb = b % 1024, swz = sb ^ (((sb >> 9) & 1) << 5); R = (st >> 1) * 16 + swz / 64; C = (st & 1) * 32 + (swz % 64) / 2; }
__host__ __device__ __forceinline__ int perm32(int rho) { const int n = rho >> 4, i = rho & 15; return 8 * (i >> 2) + 4 * n + (i & 3); }

struct Unit { int pm, pn, aux, idx; };

struct GridOrder {
    int nM, nN, nwg, G, c;
    __device__ __forceinline__ void init(int nM_, int nN_, int G_, int c_) { nM = nM_; nN = nN_; nwg = nM * nN; G = G_; c = c_; }
    __device__ __forceinline__ bool tile(int i, int& pm, int& pn) const {
        const long L = (long)i * G + c; if (L >= nwg) return false;
        int wgid = (int)L; { const int q = nwg / NXCD, r = nwg % NXCD, xcd = wgid % NXCD, off = wgid / NXCD; wgid = (xcd < r ? xcd * (q + 1) : r * (q + 1) + (xcd - r) * q) + off; }
        const int nig = WGM * nN, gid = wgid / nig, fm = gid * WGM, gsz = (nM - fm) < WGM ? (nM - fm) : WGM;
        pm = fm + ((wgid % nig) % gsz); pn = (wgid % nig) / gsz; return true;
    }
};

typedef int v8i_t __attribute__((ext_vector_type(8)));
template <class Epi, class Sched, bool ALIGN_EPI, bool FP8 = false, bool GATHER = false>
__device__ __forceinline__ void gemm_phase(LAS unsigned char* lds, const int KB, const Sched& S, const Epi& E) {
    int tid = threadIdx.x; asm volatile("" : "+v"(tid));
    const int wid = __builtin_amdgcn_readfirstlane(tid >> 6), lane = tid & 63, wr = wid >> 2, wc = wid & 3, fr = lane & 15, fq = lane >> 4;
    const int nt = KB / (BK * 2);
    unsigned voffB[2], cvo[2][2], nvo[2][2]; int RA[2], CA[2];
    const size_t kstep = (size_t)(BK * 2);
    const size_t hstep = (size_t)HALF * KB;
#pragma unroll
    for (int i = 0; i < 2; ++i) { int R, C; stage_rc(tid * 16 + i * 8192, R, C); const int Rb = Epi::PERM ? ((R & ~31) + perm32(R & 31)) : R; RA[i] = R; CA[i] = C * 2;
        voffB[i] = (unsigned)(Rb * KB + C * 2);
#pragma unroll
        for (int h = 0; h < 2; ++h) { cvo[h][i] = GATHER ? 0u : (unsigned)(R * KB + C * 2) + (unsigned)(h * hstep); nvo[h][i] = cvo[h][i]; } }
    const unsigned ldsw = (unsigned)wid * 1024u;
    const int aoff = lds_byte(wr * 64 + fr, fq * 8), boff = lds_byte(wc * 32 + fr, fq * 8);
#define PG8_SA(b, h) (((b) * 2 + (h)) * HTB)
#define PG8_SB(b, h) ((4 + (b) * 2 + (h)) * HTB)
#define PG8_STAGE(bufoff, gbase, voff) do { _Pragma("unroll") for (int _i = 0; _i < 2; ++_i) \
        __builtin_amdgcn_global_load_lds((const unsigned*)((const char*)(gbase) + (voff)[_i]), (LAS unsigned*)(lds + (bufoff) + ldsw + _i * 8192), 16, 0, 0); } while (0)
#define PG8_LD32(off) __builtin_shufflevector(*(const LAS v4u*)(lds + (off)), *(const LAS v4u*)(lds + (off) + 1024), 0, 1, 2, 3, 4, 5, 6, 7)
#define PG8_LDA(dst, b, h) do { _Pragma("unroll") for (int m = 0; m < 4; ++m) { if constexpr (FP8) dst##8[m] = __builtin_bit_cast(v8i_t, PG8_LD32(PG8_SA(b, h) + aoff + m * 2048)); else { _Pragma("unroll") for (int k = 0; k < 2; ++k) dst[m][k] = *(const LAS bf16x8*)(lds + PG8_SA(b, h) + aoff + m * 2048 + k * 1024); } } } while (0)
#define PG8_LDB(dst, b, h) do { _Pragma("unroll") for (int n = 0; n < 2; ++n) { if constexpr (FP8) dst##8[n] = __builtin_bit_cast(v8i_t, PG8_LD32(PG8_SB(b, h) + boff + n * 2048)); else { _Pragma("unroll") for (int k = 0; k < 2; ++k) dst[n][k] = *(const LAS bf16x8*)(lds + PG8_SB(b, h) + boff + n * 2048 + k * 1024); } } } while (0)
#define PG8_CAT(x) __builtin_shufflevector(__builtin_bit_cast(v4u, (x)[0]), __builtin_bit_cast(v4u, (x)[1]), 0, 1, 2, 3, 4, 5, 6, 7)
#define PG8_MMA(ai, bj, At, Bt) do { __builtin_amdgcn_s_setprio(1); _Pragma("unroll") for (int m = 0; m < 4; ++m) _Pragma("unroll") for (int n = 0; n < 2; ++n) { \
        if constexpr (FP8) asm volatile("v_mfma_scale_f32_16x16x128_f8f6f4 %0, %1, %2, %0, %3, %3 op_sel_hi:[0,0,0]" : "+v"(acc[ai][bj][m][n]) : "v"(Bt##8[n]), "v"(At##8[m]), "v"(sc1_)); \
        else { _Pragma("unroll") for (int k = 0; k < 2; ++k) acc[ai][bj][m][n] = __builtin_amdgcn_mfma_f32_16x16x32_bf16(Bt[n][k], At[m][k], acc[ai][bj][m][n], 0, 0, 0); } } \
        __builtin_amdgcn_s_setprio(0); } while (0)
#define PG8_WAIT_V(n) asm volatile("s_waitcnt vmcnt(" #n ")" ::: "memory")
#define PG8_WAIT_L(n) asm volatile("s_waitcnt lgkmcnt(" #n ")" ::: "memory")
#define PG8_BAR __builtin_amdgcn_s_barrier()
#define PG8_SCHED __builtin_amdgcn_sched_barrier(0)
#define PG8_ZERO() do { float zf_; asm volatile("v_mov_b32 %0, 0" : "=v"(zf_)); const f32x4 z4_ = {zf_, zf_, zf_, zf_}; _Pragma("unroll") for (int a = 0; a < 2; ++a) _Pragma("unroll") for (int b = 0; b < 2; ++b) _Pragma("unroll") for (int m = 0; m < 4; ++m) _Pragma("unroll") for (int n = 0; n < 2; ++n) acc[a][b][m][n] = z4_; } while (0)
    Unit cur, nxt; int ui = 0;
    if (!S.next(0, cur)) return;
    f32x4 acc[2][2][4][2];
    PG8_ZERO();
    bf16x8 At[4][2], B0[2][2], B1[2][2]; v8i_t At8[4], B08[2], B18[2];
    int sc1_ = 0x7f7f7f7f; asm volatile("" : "+v"(sc1_));
    const char* cA = S.opA(cur); const char* cB = S.opB(cur);
    if constexpr (GATHER) {
#pragma unroll
        for (int h = 0; h < 2; ++h)
#pragma unroll
            for (int i = 0; i < 2; ++i) { cvo[h][i] = S.goff(0, h * HALF + RA[i]) + (unsigned)CA[i]; nvo[h][i] = cvo[h][i]; } }
    PG8_STAGE(PG8_SB(0, 0), cB, voffB); PG8_STAGE(PG8_SB(0, 1), cB + hstep, voffB); PG8_STAGE(PG8_SA(0, 0), cA, cvo[0]); PG8_STAGE(PG8_SA(0, 1), cA, cvo[1]);
    if (wr == 1) PG8_BAR;
    PG8_WAIT_V(2); PG8_BAR;
    PG8_STAGE(PG8_SB(1, 0), cB + kstep, voffB); PG8_STAGE(PG8_SA(1, 0), cA + kstep, cvo[0]); PG8_STAGE(PG8_SB(1, 1), cB + hstep + kstep, voffB);
    PG8_WAIT_V(6); PG8_BAR;
    for (;;) {
        const bool has_next = S.next(ui + 1, nxt);
        const char* nA = has_next ? S.opA(nxt) : cA; const char* nB = has_next ? S.opB(nxt) : cB;
        if constexpr (GATHER) { if (has_next) {
#pragma unroll
            for (int h = 0; h < 2; ++h)
#pragma unroll
                for (int i = 0; i < 2; ++i) nvo[h][i] = S.goff(ui + 1, h * HALF + RA[i]) + (unsigned)CA[i]; } }
        for (int t = 0; t < nt; t += 2) {
            const bool last = (t == nt - 2);
            const char* a1 = cA + (size_t)(t + 1) * kstep;
            const char* a2 = last ? nA : cA + (size_t)(t + 2) * kstep; const char* b2 = last ? nB : cB + (size_t)(t + 2) * kstep;
            const char* a3 = a2 + kstep; const char* b3 = b2 + kstep;
            unsigned o2[2][2];
#pragma unroll
            for (int h = 0; h < 2; ++h)
#pragma unroll
                for (int i = 0; i < 2; ++i) o2[h][i] = (GATHER && last) ? nvo[h][i] : cvo[h][i];
            PG8_LDB(B0, 0, 0); PG8_LDB(B1, 0, 1); PG8_SCHED; PG8_LDA(At, 0, 0); PG8_STAGE(PG8_SA(1, 1), a1, cvo[1]);
            PG8_WAIT_V(8); PG8_WAIT_L(0); PG8_BAR; PG8_MMA(0, 0, At, B0); PG8_MMA(0, 1, At, B1); PG8_BAR; PG8_SCHED;
            PG8_LDA(At, 0, 1); PG8_STAGE(PG8_SB(0, 0), b2, voffB); PG8_STAGE(PG8_SB(0, 1), b2 + hstep, voffB); PG8_STAGE(PG8_SA(0, 0), a2, o2[0]);
            PG8_WAIT_V(8); PG8_WAIT_L(0); PG8_BAR; PG8_MMA(1, 0, At, B0); PG8_MMA(1, 1, At, B1); PG8_BAR; PG8_SCHED;
            PG8_LDB(B0, 1, 0); PG8_LDB(B1, 1, 1); PG8_SCHED; PG8_LDA(At, 1, 0); PG8_STAGE(PG8_SA(0, 1), a2, o2[1]);
            PG8_WAIT_V(8); PG8_WAIT_L(0); PG8_BAR; PG8_MMA(0, 0, At, B0); PG8_MMA(0, 1, At, B1); PG8_BAR; PG8_SCHED;
            PG8_LDA(At, 1, 1); PG8_STAGE(PG8_SB(1, 0), b3, voffB); PG8_STAGE(PG8_SB(1, 1), b3 + hstep, voffB); PG8_STAGE(PG8_SA(1, 0), a3, o2[0]);
            PG8_WAIT_V(8); PG8_WAIT_L(0); PG8_BAR; PG8_MMA(1, 0, At, B0); PG8_MMA(1, 1, At, B1); PG8_BAR; PG8_SCHED;
        }
        if constexpr (ALIGN_EPI) { if (wr == 0) PG8_BAR; }
        if constexpr (FP8) asm volatile("s_nop 15\n\ts_nop 15" ::: "memory");
        E(acc, cur, wr, wc, fr, fq);
        if (!has_next) break;
        if (!E.keep(cur)) PG8_ZERO();
        cur = nxt; cA = nA; cB = nB; ++ui;
        if constexpr (GATHER) {
#pragma unroll
            for (int h = 0; h < 2; ++h)
#pragma unroll
                for (int i = 0; i < 2; ++i) cvo[h][i] = nvo[h][i]; }
        if constexpr (ALIGN_EPI) { if (wr == 1) PG8_BAR; }
    }
    PG8_WAIT_V(0);
    if constexpr (!ALIGN_EPI) { if (wr == 0) PG8_BAR; }
    PG8_BAR;
#undef PG8_SA
#undef PG8_SB
#undef PG8_STAGE
#undef PG8_LDA
#undef PG8_LD32
#undef PG8_LDB
#undef PG8_MMA
#undef PG8_CAT
#undef PG8_WAIT_V
#undef PG8_WAIT_L
#undef PG8_BAR
#undef PG8_SCHED
#undef PG8_ZERO
}
}

namespace attn_body {
constexpr int D = 64, DMA_ = NH * D;
constexpr int NW = 8, QBLK = 32, QB = QBLK * NW, KVBLK = 64;
__device__ __forceinline__ int crow(int r, int hi) { return (r & 3) + 8 * (r >> 2) + 4 * hi; }
#define SBAR() __builtin_amdgcn_sched_barrier(0)
__device__ __forceinline__ void cmask(f32x16& p0, f32x16& p1, int jb, int qrel, int hi) {
  const float NEG = -INFINITY; int kb = 64 * jb + 4 * hi;
  #pragma unroll
  for (int r = 0; r < 16; ++r) { int kv = kb + (r & 3) + 8 * (r >> 2); if (kv > qrel) p0[r] = NEG; if (kv + 32 > qrel) p1[r] = NEG; }
}
constexpr int NSLOT = 3, SLOTB = 8192;
constexpr int LDS_K = 0, LDS_V = NSLOT * SLOTB, LDS_WS = 2 * NSLOT * SLOTB, LDS_OST = LDS_WS + NW * 64 * 4, LDS_BYTES = LDS_OST + NW * 4096;
constexpr int LDS_CS = LDS_BYTES, LDS_TOT = LDS_CS + KSEQ * 4, LDS_ALL = LDS_TOT + 256;
__device__ __forceinline__ void glds16(const void* gsrc, unsigned lds_dst) { unsigned keep;
  asm volatile("s_mov_b32 %0, m0\n\ts_mov_b32 m0, %2\n\ts_nop 0\n\tglobal_load_lds_dwordx4 %1, off\n\ts_mov_b32 m0, %0" : "=&s"(keep) : "v"(gsrc), "s"(lds_dst) : "memory"); }
__device__ __forceinline__ float max3f(float a, float b, float c) { float r; asm("v_max3_f32 %0, %1, %2, %3" : "=v"(r) : "v"(a), "v"(b), "v"(c)); return r; }
__device__ __forceinline__ float max2f(float a, float b) { float r; asm("v_max_f32_e32 %0, %1, %2" : "=v"(r) : "v"(a), "v"(b)); return r; }
__device__ __forceinline__ float fadd_s(float a, float b) { float r; asm("v_add_f32_e32 %0, %1, %2" : "=v"(r) : "v"(a), "v"(b)); return r; }
__device__ __forceinline__ float fsub_s(float a, float b) { float r; asm("v_sub_f32_e32 %0, %1, %2" : "=v"(r) : "v"(a), "v"(b)); return r; }
__device__ __forceinline__ unsigned cvtpk_s(float lo, float hi) { f32x2 v = {lo, hi}; bf16x2_t b = __builtin_convertvector(v, bf16x2_t); return __builtin_bit_cast(unsigned, b); }
#define WAIT_BAR(N) asm volatile("s_waitcnt vmcnt(" #N ") lgkmcnt(0)\n\ts_barrier" ::: "memory")

__device__ __forceinline__ void qkt(f32x16& p0, f32x16& p1, const char* Kslot, const bf16x8* qr, const f32x16& negm, int r32, int hi) {
  const char* kb = Kslot + hi * 1024 + r32 * 16;
  #pragma unroll
  for (int d0 = 0; d0 < 4; ++d0) {
    const bf16x8 b0 = *reinterpret_cast<const bf16x8*>(kb + d0 * 2048);
    const bf16x8 b1 = *reinterpret_cast<const bf16x8*>(kb + d0 * 2048 + 512);
    if (d0 == 0) { p0 = __builtin_amdgcn_mfma_f32_32x32x16_bf16(b0, qr[0], negm, 0, 0, 0); p1 = __builtin_amdgcn_mfma_f32_32x32x16_bf16(b1, qr[0], negm, 0, 0, 0); }
    else { p0 = __builtin_amdgcn_mfma_f32_32x32x16_bf16(b0, qr[d0], p0, 0, 0, 0); p1 = __builtin_amdgcn_mfma_f32_32x32x16_bf16(b1, qr[d0], p1, 0, 0, 0); } }
}
typedef LAS const char* lds_cptr;
typedef short v4i16_t __attribute__((ext_vector_type(4)));
__device__ __forceinline__ void kload8(bf16x8* kf, lds_cptr kp) {
  kf[0] = *(const LAS bf16x8*)(kp);        kf[1] = *(const LAS bf16x8*)(kp + 512);
  kf[2] = *(const LAS bf16x8*)(kp + 2048); kf[3] = *(const LAS bf16x8*)(kp + 2560);
  kf[4] = *(const LAS bf16x8*)(kp + 4096); kf[5] = *(const LAS bf16x8*)(kp + 4608);
  kf[6] = *(const LAS bf16x8*)(kp + 6144); kf[7] = *(const LAS bf16x8*)(kp + 6656);
}
__device__ __forceinline__ void kload2(bf16x8* kf, lds_cptr kp, int j) { kf[2 * j] = *(const LAS bf16x8*)(kp + j * 2048); kf[2 * j + 1] = *(const LAS bf16x8*)(kp + j * 2048 + 512); }
__device__ __forceinline__ s16x4 vtr(lds_cptr p) { return __builtin_bit_cast(s16x4, __builtin_amdgcn_ds_read_tr16_b64_v4i16((LAS v4i16_t*)p)); }
__device__ __forceinline__ float rowmax(const f32x16& p0, const f32x16& p1) {
  float a = max3f(p0[0], p0[1], p1[0]), b = max3f(p0[2], p0[3], p1[1]); a = max3f(a, p1[2], p1[3]);
  #pragma unroll
  for (int r = 4; r < 16; r += 4) { a = max3f(a, p0[r], p0[r + 1]); b = max3f(b, p0[r + 2], p0[r + 3]); a = max3f(a, p1[r], p1[r + 1]); b = max3f(b, p1[r + 2], p1[r + 3]); }
  const float m = max2f(a, b);
  auto rr = __builtin_amdgcn_permlane32_swap(__float_as_uint(m), __float_as_uint(m), false, false);
  return max2f(__uint_as_float(rr[0]), __uint_as_float(rr[1]));
}
__device__ __forceinline__ void pv(f32x16* o, int vb, bf16x8 pa0, bf16x8 pa1, bf16x8 pa2, bf16x8 pa3) {
  #pragma unroll
  for (int d0 = 0; d0 < 2; ++d0) { s16x4 lo[4], hi[4];
    #pragma unroll
    for (int ks = 0; ks < 4; ++ks) {
      asm volatile("ds_read_b64_tr_b16 %0,%1 offset:%c2" : "=&v"(lo[ks]) : "v"(vb), "i"(d0 * 4096 + ks * 1024) : "memory");
      asm volatile("ds_read_b64_tr_b16 %0,%1 offset:%c2" : "=&v"(hi[ks]) : "v"(vb), "i"(d0 * 4096 + ks * 1024 + 512) : "memory"); }
    asm volatile("s_waitcnt lgkmcnt(0)" ::: "memory"); SBAR();
    #define PK(k) (bf16x8){lo[k][0], lo[k][1], lo[k][2], lo[k][3], hi[k][0], hi[k][1], hi[k][2], hi[k][3]}
    o[d0] = __builtin_amdgcn_mfma_f32_32x32x16_bf16(pa0, PK(0), o[d0], 0, 0, 0);
    o[d0] = __builtin_amdgcn_mfma_f32_32x32x16_bf16(pa1, PK(1), o[d0], 0, 0, 0);
    o[d0] = __builtin_amdgcn_mfma_f32_32x32x16_bf16(pa2, PK(2), o[d0], 0, 0, 0);
    o[d0] = __builtin_amdgcn_mfma_f32_32x32x16_bf16(pa3, PK(3), o[d0], 0, 0, 0);
    #undef PK
  }
}
__device__ __forceinline__ void kbias(f32x16& p0, f32x16& p1, const LAS float* csl, int t, int hi) {
  const LAS f32x4* cb = (const LAS f32x4*)(csl + 64 * t + 4 * hi);
  #pragma unroll
  for (int g = 0; g < 4; ++g) { const f32x4 u0 = cb[2 * g], u1 = cb[8 + 2 * g];
    p0[4 * g + 0] -= u0[0]; p0[4 * g + 1] -= u0[1]; p0[4 * g + 2] -= u0[2]; p0[4 * g + 3] -= u0[3];
    p1[4 * g + 0] -= u1[0]; p1[4 * g + 1] -= u1[1]; p1[4 * g + 2] -= u1[2]; p1[4 * g + 3] -= u1[3]; }
}

template <int THRL> __device__ __forceinline__ void attn_unit(int b, int h, int qb, const __hip_bfloat16* Q, const __hip_bfloat16* __restrict__ K, const __hip_bfloat16* __restrict__ V, __hip_bfloat16* O, char* shm) {
  using bf16h = __hip_bfloat16;
  int tid = threadIdx.x; asm volatile("" : "+v"(tid));
  const int lane = tid & 63, r32 = lane & 31, hi = lane >> 5; const int wid = __builtin_amdgcn_readfirstlane(tid >> 6);
  const long rowbaseQ = (long)b * SEQ, rowbaseK = (long)b * KSEQ; const int q0 = qb * QB;
  const bf16h* Qw = Q + (rowbaseQ + q0 + wid * QBLK) * DMA_ + h * D;
  const bf16h* Kh = K + rowbaseK * DMA_ + h * D, *Vh = V + rowbaseK * DMA_ + h * D;
  const unsigned lds0 = (unsigned)(uintptr_t)shm;
  float* wsf = (float*)(shm + LDS_WS) + wid * 64;
  const LAS float* csl = (const LAS float*)((LAS const char*)shm + LDS_CS);
  const bf16h* ksrc = Kh + (long)lane * DMA_ + wid * 8;
  const bf16h* vsrc = Vh + (long)(16 * (wid & 3) + (lane >> 2)) * DMA_ + (wid >> 2) * 32 + (lane & 3) * 8;
  const unsigned kdst = lds0 + LDS_K + wid * 1024, vdst = lds0 + LDS_V + wid * 1024;
  #define DMA_K(t, slot) glds16(ksrc + (long)(t) * KVBLK * DMA_, (unsigned)__builtin_amdgcn_readfirstlane(kdst + (slot)))
  #define DMA_V(t, slot) glds16(vsrc + (long)(t) * KVBLK * DMA_, (unsigned)__builtin_amdgcn_readfirstlane(vdst + (slot)))
  const int vb0 = (int)(lds0 + LDS_V) + ((lane >> 4) & 1) * 32 + (lane & 3) * 8 + (4 * hi + ((lane & 15) >> 2)) * 64;
  const char* Kbase = shm + LDS_K; bf16x8 kf[8];
  const lds_cptr shm3 = (lds_cptr)shm; const lds_cptr kp0 = shm3 + LDS_K + hi * 1024 + r32 * 16; const lds_cptr vp0 = shm3 + LDS_V + ((lane >> 4) & 1) * 32 + (lane & 3) * 8 + (4 * hi + ((lane & 15) >> 2)) * 64;
  const int NT = (q0 + QB) / KVBLK + 1;
  DMA_K(0, 0); DMA_V(0, 0); DMA_K(1, SLOTB);
  bf16x8 qr[4];
  #pragma unroll
  for (int d0 = 0; d0 < 4; ++d0) qr[d0] = *reinterpret_cast<const bf16x8*>(&Qw[(long)r32 * DMA_ + d0 * 16 + hi * 8]);
  const float cq = csl[64 + q0 + wid * QBLK + r32];
  float mhat = 0.f, l_reg = 0.f; f32x16 o[2]; o[0] = f32x16{}; o[1] = f32x16{}; f32x16 negm;
  #pragma unroll
  for (int r = 0; r < 16; ++r) negm[r] = cq;
  asm volatile("" : "+v"(negm));
  const int qrel = wid * QBLK + r32;
  #define CMASK(P0, P1, t) do { int jb_ = (t) - (NT - 4); if (jb_ >= 0) cmask(P0, P1, jb_, qrel, hi); } while (0)
  bool resc = false;
  #define START(P0, P1) do { const float rm = rowmax(P0, P1); resc = false; \
    { const float dl = rm; mhat = fadd_s(mhat, dl); \
      _Pragma("unroll") for (int r = 0; r < 16; ++r) { P0[r] = fsub_s(P0[r], dl); P1[r] = fsub_s(P1[r], dl); } \
      _Pragma("unroll") for (int r = 0; r < 16; ++r) negm[r] = cq - mhat; asm volatile("" : "+v"(negm)); } \
    _Pragma("unroll") for (int r = 0; r < 16; ++r) P0[r] = __builtin_amdgcn_exp2f(P0[r]); } while (0)
  #define RESC() do { if (resc) { asm volatile("s_waitcnt lgkmcnt(0)" ::: "memory"); \
      _Pragma("unroll") for (int d_ = 0; d_ < 2; ++d_) _Pragma("unroll") for (int r = 0; r < 16; ++r) o[d_][r] *= wsf[crow(r, hi)]; } } while (0)
  f32x16 pA0, pA1, pB0, pB1;
  int sl_prev = 0, sl_cur = 0, sl_next = SLOTB;
  #define ROT() do { sl_prev = sl_cur; sl_cur = sl_next; sl_next = (sl_next == (NSLOT - 1) * SLOTB) ? 0 : sl_next + SLOTB; } while (0)
  DMA_K(2, 2 * SLOTB);
  WAIT_BAR(3);
  qkt(pA0, pA1, Kbase, qr, negm, r32, hi); asm volatile("s_nop 15\n\ts_nop 7" : "+v"(pA0), "+v"(pA1)); kbias(pA0, pA1, csl, 0, hi);
  START(pA0, pA1);
  _Pragma("unroll") for (int r = 0; r < 16; ++r) pA1[r] = __builtin_amdgcn_exp2f(pA1[r]);
  WAIT_BAR(0);
  DMA_K(3, 0); DMA_V(1, SLOTB);
  ROT();
  kload8(kf, kp0 + sl_cur);
  WAIT_BAR(2);
  s16x4 vlo[8], vhi[8]; v4u pw0, pw1, pw2, pw3;
  #define PKW(P, B) cvtpk_s(P[B], P[B + 1])
  #define PAF(k) __builtin_bit_cast(bf16x8, pw##k)
  #define VFR(i) (bf16x8){vlo[i][0], vlo[i][1], vlo[i][2], vlo[i][3], vhi[i][0], vhi[i][1], vhi[i][2], vhi[i][3]}
  #define PIN(x) asm volatile("" : "+v"(x))
  #define MX3(a, b, c) __builtin_fmaxf(__builtin_fmaxf((a), (b)), (c))
  #define GAPA(MF, A0, A1, A2, A3, W0, W1, PW) do { MF; sacc += A0; sacc += A1; sacc += A2; sacc += A3; PIN(sacc); W0; W1; PIN(PW); SBAR(); } while (0)
  #define EX(v) __builtin_amdgcn_exp2f(v)
  #define GAPB(MF, X, B) do { MF; X[B] = EX(X[B]); X[B + 1] = EX(X[B + 1]); X[B + 2] = EX(X[B + 2]); X[B + 3] = EX(X[B + 3]); PIN(X); SBAR(); } while (0)
  #define VRD(i) do { vlo[i] = vtr(vp_ + (((i) >> 2) * 4096 + ((i) & 3) * 1024)); vhi[i] = vtr(vp_ + (((i) >> 2) * 4096 + ((i) & 3) * 1024 + 512)); } while (0)
  #define KRD(G, j) do { if (G) { kload2(kf, kp0 + sl_next, j); SBAR(); } } while (0)
  #define STEP(C0, C1, P0, P1, t, GK, GV, GL) do { SBAR(); \
    const lds_cptr vp_ = vp0 + sl_prev; \
    VRD(0); SBAR(); float sacc = (P0[0] + P0[1]); \
    GAPA(C0 = __builtin_amdgcn_mfma_f32_32x32x16_bf16(kf[0], qr[0], negm, 0, 0, 0), P0[2], P0[3], P0[4], P0[5],     pw0[0] = PKW(P0, 0), pw0[1] = PKW(P0, 2), pw0); \
    VRD(4); SBAR(); GAPA(C1 = __builtin_amdgcn_mfma_f32_32x32x16_bf16(kf[1], qr[0], negm, 0, 0, 0), P0[6], P0[7], P0[8], P0[9],     pw0[2] = PKW(P0, 4), pw0[3] = PKW(P0, 6), pw0); \
    VRD(1); SBAR(); GAPA(C0 = __builtin_amdgcn_mfma_f32_32x32x16_bf16(kf[2], qr[1], C0, 0, 0, 0),   P0[10], P0[11], P0[12], P0[13], pw1[0] = PKW(P0, 8), pw1[1] = PKW(P0, 10), pw1); \
    VRD(5); SBAR(); GAPA(C1 = __builtin_amdgcn_mfma_f32_32x32x16_bf16(kf[3], qr[1], C1, 0, 0, 0),   P0[14], P0[15], P1[0], P1[1],   pw1[2] = PKW(P0, 12), pw1[3] = PKW(P0, 14), pw1); \
    VRD(2); SBAR(); GAPA(C0 = __builtin_amdgcn_mfma_f32_32x32x16_bf16(kf[4], qr[2], C0, 0, 0, 0),   P1[2], P1[3], P1[4], P1[5],     pw2[0] = PKW(P1, 0), pw2[1] = PKW(P1, 2), pw2); \
    VRD(6); SBAR(); GAPA(C1 = __builtin_amdgcn_mfma_f32_32x32x16_bf16(kf[5], qr[2], C1, 0, 0, 0),   P1[6], P1[7], P1[8], P1[9],     pw2[2] = PKW(P1, 4), pw2[3] = PKW(P1, 6), pw2); \
    VRD(3); SBAR(); GAPA(C0 = __builtin_amdgcn_mfma_f32_32x32x16_bf16(kf[6], qr[3], C0, 0, 0, 0),   P1[10], P1[11], P1[12], P1[13], pw3[0] = PKW(P1, 8), pw3[1] = PKW(P1, 10), pw3); \
    VRD(7); SBAR(); GAPA(C1 = __builtin_amdgcn_mfma_f32_32x32x16_bf16(kf[7], qr[3], C1, 0, 0, 0),   P1[14], P1[15], 0.f, 0.f,       pw3[2] = PKW(P1, 12), pw3[3] = PKW(P1, 14), pw3); \
    l_reg += sacc; \
    if (GK) { DMA_K((t) + 3, sl_cur); } if (GV) { DMA_V((t) + 1, sl_next); } \
    kbias(C0, C1, csl, (t), hi); \
    CMASK(C0, C1, t); \
    { float a = MX3(C0[0], C0[1], C1[0]), b = MX3(C0[2], C0[3], C1[1]); a = MX3(a, C1[2], C1[3]); \
      _Pragma("unroll") for (int r = 4; r < 16; r += 4) { a = MX3(a, C0[r], C0[r + 1]); b = MX3(b, C0[r + 2], C0[r + 3]); a = MX3(a, C1[r], C1[r + 1]); b = MX3(b, C1[r + 2], C1[r + 3]); } \
      float rm = __builtin_fmaxf(a, b); { auto rr = __builtin_amdgcn_permlane32_swap(__float_as_uint(rm), __float_as_uint(rm), false, false); rm = __builtin_fmaxf(__uint_as_float(rr[0]), __uint_as_float(rr[1])); } \
      resc = false; \
      if (__builtin_expect(__any(rm > (float)THRL), 0)) { const float dl = __builtin_fmaxf(rm, 0.f); mhat += dl; \
        _Pragma("unroll") for (int r = 0; r < 16; ++r) { C0[r] -= dl; C1[r] -= dl; } \
        _Pragma("unroll") for (int r = 0; r < 16; ++r) negm[r] = cq - mhat; asm volatile("" : "+v"(negm)); \
        const float f = __builtin_amdgcn_exp2f(-dl); l_reg *= f; if (hi == 0) wsf[r32] = f; resc = true; } } \
    SBAR(); \
    GAPB(o[0] = __builtin_amdgcn_mfma_f32_32x32x16_bf16(PAF(0), VFR(0), o[0], 0, 0, 0), C0, 0); \
    GAPB(o[1] = __builtin_amdgcn_mfma_f32_32x32x16_bf16(PAF(0), VFR(4), o[1], 0, 0, 0), C0, 4); \
    KRD(GL, 0); GAPB(o[0] = __builtin_amdgcn_mfma_f32_32x32x16_bf16(PAF(1), VFR(1), o[0], 0, 0, 0), C0, 8); \
    KRD(GL, 1); GAPB(o[1] = __builtin_amdgcn_mfma_f32_32x32x16_bf16(PAF(1), VFR(5), o[1], 0, 0, 0), C0, 12); \
    KRD(GL, 2); GAPB(o[0] = __builtin_amdgcn_mfma_f32_32x32x16_bf16(PAF(2), VFR(2), o[0], 0, 0, 0), C1, 0); \
    KRD(GL, 3); GAPB(o[1] = __builtin_amdgcn_mfma_f32_32x32x16_bf16(PAF(2), VFR(6), o[1], 0, 0, 0), C1, 4); \
    GAPB(o[0] = __builtin_amdgcn_mfma_f32_32x32x16_bf16(PAF(3), VFR(3), o[0], 0, 0, 0), C1, 8); \
    GAPB(o[1] = __builtin_amdgcn_mfma_f32_32x32x16_bf16(PAF(3), VFR(7), o[1], 0, 0, 0), C1, 12); \
    } while (0)
  int t = 1;
  #undef CMASK
  #define CMASK(P0, P1, t) do {} while (0)
  for (; t + 5 < NT; t += 2) {
    STEP(pB0, pB1, pA0, pA1, t, true, true, true);     WAIT_BAR(2); RESC(); ROT();
    STEP(pA0, pA1, pB0, pB1, t + 1, true, true, true); WAIT_BAR(2); RESC(); ROT();
  }
  #undef CMASK
  #define CMASK(P0, P1, t) do { int jb_ = (t) - (NT - 4); if (jb_ >= 0) cmask(P0, P1, jb_, qrel, hi); } while (0)
  #define ENDW(tt) do { if ((tt) + 3 < NT) { WAIT_BAR(2); } else if ((tt) + 2 < NT) { WAIT_BAR(1); } else { WAIT_BAR(0); } } while (0)
  for (; t + 1 < NT; t += 2) {
    STEP(pB0, pB1, pA0, pA1, t, (t + 3 < NT), (t + 1 < NT), (t + 1 < NT));       ENDW(t);     RESC(); ROT();
    STEP(pA0, pA1, pB0, pB1, t + 1, (t + 4 < NT), (t + 2 < NT), (t + 2 < NT));   ENDW(t + 1); RESC(); ROT();
  }
  { float sacc = pA0[0] + pA0[1]; _Pragma("unroll") for (int r = 2; r < 16; ++r) sacc += pA0[r]; _Pragma("unroll") for (int r = 0; r < 16; ++r) sacc += pA1[r]; l_reg += sacc;
    pw0 = (v4u){PKW(pA0, 0), PKW(pA0, 2), PKW(pA0, 4), PKW(pA0, 6)}; pw1 = (v4u){PKW(pA0, 8), PKW(pA0, 10), PKW(pA0, 12), PKW(pA0, 14)}; pw2 = (v4u){PKW(pA1, 0), PKW(pA1, 2), PKW(pA1, 4), PKW(pA1, 6)}; pw3 = (v4u){PKW(pA1, 8), PKW(pA1, 10), PKW(pA1, 12), PKW(pA1, 14)};
    SBAR(); pv(o, vb0 + sl_prev, PAF(0), PAF(1), PAF(2), PAF(3)); }
  #undef PKW
  #undef PAF
  #undef VFR
  #undef PIN
  #undef MX3
  #undef GAPA
  #undef GAPB
  #undef EX
  #undef VRD
  #undef KRD
  #undef STEP
  #undef ENDW
  { auto rr = __builtin_amdgcn_permlane32_swap(__float_as_uint(l_reg), __float_as_uint(l_reg), false, false); l_reg = __uint_as_float(rr[0]) + __uint_as_float(rr[1]); }
  if (hi == 0) wsf[32 + r32] = l_reg; asm volatile("s_waitcnt lgkmcnt(0)" ::: "memory");
  float rli[16];
  #pragma unroll
  for (int r = 0; r < 16; ++r) rli[r] = __builtin_amdgcn_rcpf(wsf[32 + crow(r, hi)]);
  bf16h* Ow = O + (rowbaseQ + q0 + wid * QBLK) * DMA_ + h * D;
  { bf16h* stg = (bf16h*)(shm + LDS_OST) + wid * 2048;
    #pragma unroll
    for (int r = 0; r < 16; ++r) { const int orow = crow(r, hi);
      #pragma unroll
      for (int d0 = 0; d0 < 2; ++d0) stg[orow * 64 + d0 * 32 + r32] = __float2bfloat16(o[d0][r] * rli[r]); }
    asm volatile("s_waitcnt lgkmcnt(0)" ::: "memory");
    #pragma unroll
    for (int i = 0; i < 4; ++i) { const int row = i * 8 + (lane >> 3), ch = lane & 7; const v4u v = *(const v4u*)(stg + row * 64 + ch * 8); *(v4u*)(Ow + (long)row * DMA_ + ch * 8) = v; } }
  asm volatile("s_waitcnt lgkmcnt(0)\n\ts_barrier" ::: "memory");
  #undef DMA_K
  #undef DMA_V
  #undef CMASK
  #undef START
  #undef RESC
  #undef ROT
}
#undef SBAR
#undef WAIT_BAR
}

#define XB_TMO      128
#define XB_XCNT(j)  (256  + 64 * (j))
#define XB_XSUB(j)  (1280 + 64 * (j))
#define XB_XGEN(j)  (2304 + 64 * (j))
#define XB_TOP      3328
#define XB_TOPGEN   3392
#define XCD_BAR_WORDS 3456
#define XB_SPIN_CAP (1u << 18)
__device__ __forceinline__ unsigned xb_ld(unsigned* p)              { return __hip_atomic_load(p, __ATOMIC_RELAXED, __HIP_MEMORY_SCOPE_AGENT); }
__device__ __forceinline__ unsigned xb_add(unsigned* p, unsigned v) { return __hip_atomic_fetch_add(p, v, __ATOMIC_RELAXED, __HIP_MEMORY_SCOPE_AGENT); }
__device__ __forceinline__ unsigned xb_xcc_id() { return (unsigned)__builtin_amdgcn_s_getreg((3 << 11) | 20) & 0xFu; }
#define XB_SPIN(cond, bar) do { unsigned _sp = 0; while (cond) { __builtin_amdgcn_s_sleep(1); \
    if ((++_sp & 255u) == 0u) { if (xb_ld(&(bar)[XB_TMO])) break; if (_sp > XB_SPIN_CAP) { atomicAdd(&(bar)[XB_TMO], 1u); break; } } } } while (0)
struct XcdBarrier { unsigned* bar; unsigned x; volatile LAS unsigned* st; };
__device__ __forceinline__ XcdBarrier xcd_barrier_post(unsigned* bar, volatile LAS unsigned* st) {
    XcdBarrier b; b.bar = bar; b.x = xb_xcc_id(); b.st = st;
    if (threadIdx.x == 0) (void)xb_add(&bar[XB_XCNT(b.x)], 1u);
    return b;
}
__device__ __forceinline__ void xcd_barrier_complete(unsigned* bar, unsigned x, unsigned& nloc, unsigned& nx) {
    const unsigned G = gridDim.x * gridDim.y * gridDim.z;
    unsigned sum, cnt, mine, sp = 0u;
    for (;;) {
        sum = 0u; cnt = 0u; mine = 0u;
#pragma unroll
        for (unsigned j = 0; j < 16; ++j) { const unsigned c = xb_ld(&bar[XB_XCNT(j)]); sum += c; cnt += (c > 0u) ? 1u : 0u; mine = (j == x) ? c : mine; }
        if (sum == G) break;
        __builtin_amdgcn_s_sleep(1);
        if ((++sp & 255u) == 0u) { if (xb_ld(&bar[XB_TMO])) break; if (sp > XB_SPIN_CAP) { atomicAdd(&bar[XB_TMO], 1u); break; } }
    }
    nloc = mine > 0u ? mine : 1u; nx = cnt > 0u ? cnt : 1u;
}
__device__ __forceinline__ void xcd_barrier(const XcdBarrier& b) {
    asm volatile("s_waitcnt vmcnt(0)" ::: "memory");
    __syncthreads();
    if (threadIdx.x == 0) {
        unsigned* bar = b.bar;
        __builtin_amdgcn_s_waitcnt(0);
        unsigned nloc = b.st[0], nx = b.st[1];
        if (nloc == 0u) { xcd_barrier_complete(bar, b.x, nloc, nx); b.st[0] = nloc; b.st[1] = nx; }
        const unsigned old = xb_add(&bar[XB_XSUB(b.x)], 1u);
        const unsigned gen = old / nloc;
        if (old + 1u == (gen + 1u) * nloc) {
            __builtin_amdgcn_fence(__ATOMIC_RELEASE, "agent");
            asm volatile("s_waitcnt vmcnt(0)" ::: "memory");
            const unsigned og = xb_add(&bar[XB_TOP], 1u);
            const unsigned tg = og / nx;
            if (og + 1u == (tg + 1u) * nx) xb_add(&bar[XB_TOPGEN], 1u);
            else XB_SPIN(xb_ld(&bar[XB_TOPGEN]) == tg, bar);
            __builtin_amdgcn_fence(__ATOMIC_ACQUIRE, "agent");
            xb_add(&bar[XB_XGEN(b.x)], 1u);
            asm volatile("s_waitcnt vmcnt(0)" ::: "memory");
        } else {
            XB_SPIN(xb_ld(&bar[XB_XGEN(b.x)]) == gen, bar);
            __builtin_amdgcn_fence(__ATOMIC_ACQUIRE, "agent");
            asm volatile("s_waitcnt vmcnt(0)" ::: "memory");
        }
    }
    __syncthreads();
}

constexpr int RING_OFF = 0, RING_BYTES = 131072;
constexpr int MISC_OFF = RING_BYTES;
constexpr int TAB_OFF = MISC_OFF + 512;
constexpr int GTAB_OFF = TAB_OFF + 512, GTAB_UNITS = 4;
constexpr int RSTAB_OFF = GTAB_OFF + GTAB_UNITS * 1024;
constexpr int LDS_BYTES = RING_BYTES + 12288;
static_assert(RSTAB_OFF + GTAB_UNITS * 1024 <= LDS_BYTES && (MAXT * 6 + 255) / 256 <= GTAB_UNITS, "LDS map");
constexpr int NWAVES = 8;

struct Frame {
    LAS unsigned char* lds;
    volatile LAS unsigned* MISC;
    gu32* ctl;
    int tid, lane, wave, vcu, G, gw, NGW;
    unsigned char* ws;
    const float* const* in;
};
#define WSP(T, off) ((T*)(F.ws + (off)))
#define OPAQUE_IDS() int tid_ = F.tid; asm volatile("" : "+v"(tid_)); const int lane_ = tid_ & 63; const int wave_ = __builtin_amdgcn_readfirstlane(tid_ >> 6); (void)lane_; (void)wave_

__device__ __forceinline__ f32x4 mm16(const bf16* X, size_t ldx, const bf16* Y, size_t ldy, int K, f32x4 acc, int lane) {
    const int r = lane & 15, kg = lane >> 4;
    const GAS bf16* xp = (const GAS bf16*)X + (size_t)r * ldx + kg * 8; const GAS bf16* yp = (const GAS bf16*)Y + (size_t)r * ldy + kg * 8;
#pragma unroll 1
    for (int k = 0; k < K; k += 256) {
        bf16x8 xa[8], ya[8];
#pragma unroll
        for (int s = 0; s < 8; ++s) { xa[s] = *(const GAS bf16x8*)(xp + k + 32 * s); ya[s] = *(const GAS bf16x8*)(yp + k + 32 * s); }
#pragma unroll
        for (int s = 0; s < 8; ++s) acc = __builtin_amdgcn_mfma_f32_16x16x32_bf16(xa[s], ya[s], acc, 0, 0, 0);
    }
    return acc;
}

__device__ __forceinline__ f32x4 mm16_gram(const bf16* X, size_t ldx, const bf16* Y, size_t ldy, int K, f32x4 acc, f32x4& gram, int lane) {
    const int r = lane & 15, kg = lane >> 4;
    const GAS bf16* xp = (const GAS bf16*)X + (size_t)r * ldx + kg * 8; const GAS bf16* yp = (const GAS bf16*)Y + (size_t)r * ldy + kg * 8;
#pragma unroll 1
    for (int k = 0; k < K; k += 256) {
        bf16x8 xa[8], ya[8];
#pragma unroll
        for (int s = 0; s < 8; ++s) { xa[s] = *(const GAS bf16x8*)(xp + k + 32 * s); ya[s] = *(const GAS bf16x8*)(yp + k + 32 * s); }
#pragma unroll
        for (int s = 0; s < 8; ++s) { acc = __builtin_amdgcn_mfma_f32_16x16x32_bf16(xa[s], ya[s], acc, 0, 0, 0); gram = __builtin_amdgcn_mfma_f32_16x16x32_bf16(ya[s], ya[s], gram, 0, 0, 0); }
    }
    return acc;
}
__device__ __forceinline__ f32x4 mm16_f8(const unsigned char* X, size_t ldx, const unsigned char* Y, size_t ldy, int K, f32x4 acc, int lane) {
    const int r = lane & 15, kg = lane >> 4;
    const GAS unsigned char* xp = (const GAS unsigned char*)X + (size_t)r * ldx + kg * 32; const GAS unsigned char* yp = (const GAS unsigned char*)Y + (size_t)r * ldy + kg * 32;
#pragma unroll 1
    for (int k = 0; k < K; k += 512) {
        pg8::v8i_t xa[4], ya[4];
#pragma unroll
        for (int s = 0; s < 4; ++s) { xa[s] = *(const GAS pg8::v8i_t*)(xp + k + 128 * s); ya[s] = *(const GAS pg8::v8i_t*)(yp + k + 128 * s); }
#pragma unroll
        for (int s = 0; s < 4; ++s) acc = __builtin_amdgcn_mfma_scale_f32_16x16x128_f8f6f4(xa[s], ya[s], acc, 0, 0, 0, 0x7f7f7f7f, 0, 0x7f7f7f7f);
    }
    return acc;
}

template <int NX, int NY, int BS, bool GRAM>
__device__ __forceinline__ void skinny_slice(const bf16* X, size_t ldx, size_t xstride, const bf16* Y, size_t ldy, size_t ystride, int k0, int nsteps, f32x4 (&acc)[NX * NY], f32x4 (&gram)[NY], int lane) {
    const int r = lane & 15, kg = lane >> 4;
    const GAS bf16* xp = (const GAS bf16*)X + (size_t)r * ldx + k0 + kg * 8; const GAS bf16* yp = (const GAS bf16*)Y + (size_t)r * ldy + k0 + kg * 8;
#pragma unroll 1
    for (int s0 = 0; s0 < nsteps; s0 += BS) {
        bf16x8 xa[BS][NX], ya[BS][NY];
#pragma unroll
        for (int s = 0; s < BS; ++s) {
#pragma unroll
            for (int x = 0; x < NX; ++x) xa[s][x] = *(const GAS bf16x8*)(xp + x * xstride + (s0 + s) * 32);
#pragma unroll
            for (int y = 0; y < NY; ++y) ya[s][y] = *(const GAS bf16x8*)(yp + y * ystride + (s0 + s) * 32); }
#pragma unroll
        for (int s = 0; s < BS; ++s)
#pragma unroll
            for (int y = 0; y < NY; ++y) {
#pragma unroll
                for (int x = 0; x < NX; ++x) acc[x * NY + y] = __builtin_amdgcn_mfma_f32_16x16x32_bf16(xa[s][x], ya[s][y], acc[x * NY + y], 0, 0, 0);
                if (GRAM) gram[y] = __builtin_amdgcn_mfma_f32_16x16x32_bf16(ya[s][y], ya[s][y], gram[y], 0, 0, 0); }
    }
}
template <int NACC> __device__ __forceinline__ void put_part(LAS f32x4* part, const f32x4* v, int n, int base, int wave, int lane) {
#pragma unroll
    for (int a = 0; a < n; ++a) part[(wave * NACC + base + a) * 64 + lane] = v[a];
}
template <int NACC> __device__ __forceinline__ f32x4 sum_part(const LAS f32x4* part, int a, int lane) {
    f32x4 t = part[a * 64 + lane];
#pragma unroll
    for (int w = 1; w < NWAVES; ++w) t += part[(w * NACC + a) * 64 + lane];
    return t;
}

__device__ __forceinline__ void transpose_item(const float* W, size_t ldw, int K, bf16* WT, int csrc, int drow, int k0, LAS float* scr, int lane, const float* kgain = nullptr) {
    const GAS float* Wg = (const GAS float*)W;
    const int c = lane & 7;
    f32x4 g0 = {1.f, 1.f, 1.f, 1.f}, g1 = g0;
    if (kgain) { g0 = *(const GAS f32x4*)(kgain + k0 + 8 * c); g1 = *(const GAS f32x4*)(kgain + k0 + 8 * c + 4); }
#pragma unroll
    for (int i = 0; i < 32; ++i) { const int kk = 2 * i + (lane >> 5); scr[kk * 33 + (lane & 31)] = Wg[(size_t)(k0 + kk) * ldw + csrc + (lane & 31)]; }
    LDS_WAIT(); asm volatile("" ::: "memory");
#pragma unroll
    for (int j = 0; j < 4; ++j) { const int n = (lane >> 3) + 8 * j; const LAS float* s = scr + (8 * c) * 33 + n;
        v4u o; o.x = cvt_pk_bf16(s[0 * 33] * g0[0], s[1 * 33] * g0[1]); o.y = cvt_pk_bf16(s[2 * 33] * g0[2], s[3 * 33] * g0[3]); o.z = cvt_pk_bf16(s[4 * 33] * g1[0], s[5 * 33] * g1[1]); o.w = cvt_pk_bf16(s[6 * 33] * g1[2], s[7 * 33] * g1[3]);
        *(GAS v4u*)(WT + (size_t)(drow + n) * K + k0 + 8 * c) = o; }
    LDS_WAIT(); asm volatile("" ::: "memory");
}
__device__ __forceinline__ unsigned pk4_fp8(float a, float b, float c, float d) { int p = __builtin_amdgcn_cvt_pk_fp8_f32(a, b, 0, false); p = __builtin_amdgcn_cvt_pk_fp8_f32(c, d, p, true); return (unsigned)p; }
__device__ __forceinline__ void transpose_item_f8(const float* W, size_t ldw, int K, unsigned char* WT8, int csrc, int drow, int k0, LAS float* scr, int lane, float scale) {
    const GAS float* Wg = (const GAS float*)W;
#pragma unroll
    for (int i = 0; i < 32; ++i) { const int kk = 2 * i + (lane >> 5); scr[kk * 33 + (lane & 31)] = Wg[(size_t)(k0 + kk) * ldw + csrc + (lane & 31)] * scale; }
    LDS_WAIT(); asm volatile("" ::: "memory");
    const int c = lane & 3;
#pragma unroll
    for (int j = 0; j < 2; ++j) { const int n = (lane >> 2) + 16 * j; const LAS float* s = scr + (16 * c) * 33 + n;
        v4u o; o.x = pk4_fp8(s[0 * 33], s[1 * 33], s[2 * 33], s[3 * 33]); o.y = pk4_fp8(s[4 * 33], s[5 * 33], s[6 * 33], s[7 * 33]);
        o.z = pk4_fp8(s[8 * 33], s[9 * 33], s[10 * 33], s[11 * 33]); o.w = pk4_fp8(s[12 * 33], s[13 * 33], s[14 * 33], s[15 * 33]);
        *(GAS v4u*)(WT8 + (size_t)(drow + n) * K + k0 + 16 * c) = o; }
    LDS_WAIT(); asm volatile("" ::: "memory");
}
constexpr int IT_INA = 32 * 96, IT_INB = 32 * 192, IT_AO = 16 * 64, IT_CO = 16 * 64, IT_O = 32 * 64, IT_GU1 = 32 * 48, IT_GU = NE * IT_GU1, IT_DN1 = 12 * 64, IT_DN = NE * IT_DN1;
constexpr int IT_LAYER = IT_INA + IT_INB + IT_AO + IT_CO + IT_O + IT_GU + IT_DN;
__device__ __forceinline__ void p0_convert(Frame& F) {
    OPAQUE_IDS();
    LAS float* scr = (LAS float*)(F.lds + RING_OFF + wave_ * 16384);
    for (int it = F.gw; it < DEPTH * IT_LAYER; it += F.NGW) {
        const int l = it / IT_LAYER; int r = it % IT_LAYER;
        unsigned char* wl = F.ws + WS_W + (size_t)l * W_LSTRIDE;
        if (r < IT_INA) { const int kb = r / 96, nb = r % 96; transpose_item_f8(F.in[3] + (size_t)l * DM * INCOLS, INCOLS, DM, wl + WO_IN, 32 * nb, 32 * nb, 64 * kb, scr, lane_, W8S); continue; } r -= IT_INA;
        if (r < IT_INB) { const int kb = r / 192, nb = r % 192, c = 32 * nb; int drow;
            if (c < 2048) drow = 3072 + ((c & 1023) >> 7) * 256 + (c >> 10) * 128 + (c & 127); else drow = 5120 + (c - 2048);
            transpose_item_f8(F.in[3] + (size_t)l * DM * INCOLS, INCOLS, DM, wl + WO_IN, 3088 + c, drow, 64 * kb, scr, lane_, W8S); continue; } r -= IT_INB;
        if (r < IT_AO) { const int kb = r / 64, nb = r % 64; transpose_item(F.in[5] + (size_t)l * ATTW * DM, DM, ATTW, (bf16*)(wl + WO_AO), 32 * nb, 32 * nb, 64 * kb, scr, lane_); continue; } r -= IT_AO;
        if (r < IT_CO) { const int kb = r / 64, nb = r % 64; transpose_item(F.in[10] + (size_t)l * CONVC * DM, DM, CONVC, (bf16*)(wl + WO_CO), 32 * nb, 32 * nb, 64 * kb, scr, lane_); continue; } r -= IT_CO;
        if (r < IT_O) { const int kb = r / 64, nb = r % 64; transpose_item(F.in[11] + (size_t)l * DM * DM, DM, DM, (bf16*)(wl + WO_O), 32 * nb, 32 * nb, 64 * kb, scr, lane_); continue; } r -= IT_O;
        if (r < IT_GU) { const int e = r / IT_GU1, q = r % IT_GU1, kb = q / 48, nb = q % 48, c = 32 * nb; int drow;
            if (c < DE) drow = (c >> 7) * 256 + (c & 127); else drow = ((c - DE) >> 7) * 256 + 128 + ((c - DE) & 127);
            transpose_item(F.in[17] + ((size_t)l * NE + e) * DM * (2 * DE), 2 * DE, DM, (bf16*)(wl + WO_GU) + (size_t)e * (2 * DE) * DM, c, drow, 64 * kb, scr, lane_, F.in[12] + (size_t)l * DM); continue; } r -= IT_GU;
        { const int e = r / IT_DN1, q = r % IT_DN1, kb = q / 64, nb = q % 64;
            transpose_item(F.in[18] + ((size_t)l * NE + e) * DE * DM, DM, DE, (bf16*)(wl + WO_DN) + (size_t)e * DM * DE, 32 * nb, 32 * nb, 64 * kb, scr, lane_); }
    }
    const int gt = F.vcu * 512 + tid_, NGT = F.G * 512;
    bf16* WfT = WSP(bf16, WS_WF); bf16* WrT = WSP(bf16, WS_WR);
    for (int i = gt; i < DEPTH * 16 * DM; i += NGT) { const int l = i / (16 * DM), h = (i / DM) % 16, k = i % DM;
        WfT[i] = (bf16)(cvt_pk_bf16(F.in[3][((size_t)l * DM + k) * INCOLS + 3072 + h], 0.f) & 0xffffu); }
    for (int i = gt; i < DEPTH * 48 * DM; i += NGT) { const int l = i / (48 * DM), c = (i / DM) % 48, k = i % DM; float v = 0.f;
        if (c < NGRP) v = F.in[13][((size_t)l * DM + k) * NGRP + c]; else if (c < NGRP + NE) v = F.in[15][((size_t)l * DM + k) * NE + (c - NGRP)];
        v *= F.in[12][(size_t)l * DM + k];
        WrT[i] = (bf16)(cvt_pk_bf16(v, 0.f) & 0xffffu); }
    { v4u* kb = WSP(v4u, WS_KB); v4u* vb = WSP(v4u, WS_VB);
        for (int i = gt; i < NB * 6144; i += NGT) { const int b = i / 6144, q = i % 6144; const size_t o = (size_t)b * KSEQ * 128 + q; kb[o] = (v4u){0u, 0u, 0u, 0u}; vb[o] = (v4u){0u, 0u, 0u, 0u}; } }
}

template <int MODE> __device__ __forceinline__ void norm_phase(Frame& F, const float* gain, bf16* dst, float* outf) {
    OPAQUE_IDS();
    bf16* RES = WSP(bf16, WS_RES); const bf16* Y0 = WSP(bf16, WS_Y0); const bf16* Y1 = WSP(bf16, WS_Y1);
    f32x4 g[8];
#pragma unroll
    for (int j = 0; j < 8; ++j) g[j] = ((const GAS f32x4*)gain)[lane_ + 64 * j];
    const int mend = (MODE == 3) ? MR : MT;
    for (int m = F.gw; m < mend; m += F.NGW) {
        f32x4 v[8]; float ss = 0.f;
        if (MODE == 0) { const float* src = (m < MR) ? F.in[0] + (size_t)m * DM : F.in[1] + (size_t)(m - MR) * DM; const GAS f32x4* sp = (const GAS f32x4*)src + lane_;
#pragma unroll
            for (int j = 0; j < 8; ++j) v[j] = sp[64 * j];
        } else { const GAS v2u* rp = (const GAS v2u*)(RES + (size_t)m * DM) + lane_;
#pragma unroll
            for (int j = 0; j < 8; ++j) { const v2u a = rp[64 * j]; v[j] = (f32x4){bf_lo(a.x), bf_hi(a.x), bf_lo(a.y), bf_hi(a.y)}; } }
        if (MODE == 1 || MODE == 3) {
            const GAS v2u* y0 = (const GAS v2u*)(Y0 + (size_t)m * DM) + lane_; const GAS v2u* y1 = (const GAS v2u*)(Y1 + (size_t)m * DM) + lane_;
#pragma unroll
            for (int j = 0; j < 8; ++j) { const v2u a = y0[64 * j], b = y1[64 * j];
                v[j].x += bf_lo(a.x) + bf_lo(b.x); v[j].y += bf_hi(a.x) + bf_hi(b.x); v[j].z += bf_lo(a.y) + bf_lo(b.y); v[j].w += bf_hi(a.y) + bf_hi(b.y); }
        }
#pragma unroll
        for (int j = 0; j < 8; ++j) ss += (v[j].x * v[j].x + v[j].y * v[j].y) + (v[j].z * v[j].z + v[j].w * v[j].w);
        const float rstd = 1.0f / sqrtf(wave_sum(ss) * (1.0f / DM) + RMS_EPS);
        if (MODE == 1) { GAS v2u* rp = (GAS v2u*)(RES + (size_t)m * DM) + lane_;
#pragma unroll
            for (int j = 0; j < 8; ++j) { v2u w; w.x = cvt_pk_bf16(v[j].x, v[j].y); w.y = cvt_pk_bf16(v[j].z, v[j].w); rp[64 * j] = w; } }
        if (MODE == 3) { GAS f32x4* op = (GAS f32x4*)(outf + (size_t)m * DM) + lane_;
#pragma unroll
            for (int j = 0; j < 8; ++j) op[64 * j] = v[j] * rstd * g[j];
        } else { GAS v2u* op = (GAS v2u*)(dst + (size_t)m * DM) + lane_;
#pragma unroll
            for (int j = 0; j < 8; ++j) { const f32x4 o = v[j] * rstd * g[j]; v2u w; w.x = cvt_pk_bf16(o.x, o.y); w.y = cvt_pk_bf16(o.z, o.w); op[64 * j] = w; }
            if (MODE == 0 || MODE == 1) { GAS unsigned* o8 = (GAS unsigned*)(F.ws + WS_XN8 + (size_t)m * DM) + lane_;
#pragma unroll
                for (int j = 0; j < 8; ++j) { const f32x4 o = v[j] * rstd * g[j]; o8[64 * j] = pk4_fp8(o.x, o.y, o.z, o.w); } } }
    }
}

__device__ __forceinline__ void pb_side(Frame& F, int l) {
    OPAQUE_IDS();
    const bf16* XN = WSP(bf16, WS_XN); const unsigned char* WinT = F.ws + WS_W + (size_t)l * W_LSTRIDE + WO_IN;
    const int g4 = (lane_ >> 4) * 4, y = lane_ & 15;
    LAS f32x4* part = (LAS f32x4*)(F.lds + RING_OFF);
    for (int rnd = F.vcu; rnd * 4 < MT / 16; rnd += F.G) {
        const int b0 = rnd * 4, nblk = (MT / 16 - b0) < 4 ? (MT / 16 - b0) : 4;
        f32x4 acc[4] = {{0.f, 0.f, 0.f, 0.f}, {0.f, 0.f, 0.f, 0.f}, {0.f, 0.f, 0.f, 0.f}, {0.f, 0.f, 0.f, 0.f}}, gdummy[4];
        skinny_slice<1, 4, 4, false>(WSP(bf16, WS_WF) + (size_t)l * 16 * DM, DM, 0, XN + (size_t)b0 * 16 * DM, DM, (nblk == 4) ? (size_t)16 * DM : 0, wave_ * 256, 8, acc, gdummy, lane_);
        put_part<4>(part, acc, 4, 0, wave_, lane_);
        LDS_WAIT(); __syncthreads();
        if (wave_ < nblk) {
            const f32x4 a = sum_part<4>(part, wave_, lane_); const int rb = b0 + wave_;
            float* LOGF = WSP(float, WS_LOGF);
#pragma unroll 1
            for (int r = 0; r < 4; ++r) { const int h = g4 + r; const float x = a[r] + F.in[4][l * NH + h];
                const float lf = (fminf(x, 0.f) - log1pf(expf(-fabsf(x)))) * LOG2E;
                if (rb < MR / 16) { const int m = rb * 16 + y, b = m >> 11, t = m & 2047; LOGF[(size_t)(b * NH + h) * KSEQ + 64 + t] = lf; }
                else { float* lp = LOGF + (size_t)h * KSEQ + 48 + y;
#pragma unroll 1
                    for (int bb = 0; bb < NB; ++bb) { *lp = lf; lp += (size_t)NH * KSEQ; } } }
        }
        __syncthreads();
    }
    const unsigned char* Ym = F.ws + WS_XN8 + (size_t)MR * DM;
    for (int rnd = F.vcu; rnd * 2 < 576; rnd += F.G) {
        const int j = rnd * 2 + (wave_ >> 2), tile = j >> 4, sub = j & 15, ks = (wave_ & 3) * 512;
        const bool glu = (tile >= 12 && tile < 20), live = !(glu && sub >= 8);
        f32x4 acc[2] = {{0.f, 0.f, 0.f, 0.f}, {0.f, 0.f, 0.f, 0.f}};
        if (live) { acc[0] = mm16_f8(WinT + (size_t)(tile * 256 + sub * 16) * DM + ks, DM, Ym + ks, DM, 512, acc[0], lane_);
            if (glu) acc[1] = mm16_f8(WinT + (size_t)(tile * 256 + 128 + sub * 16) * DM + ks, DM, Ym + ks, DM, 512, acc[1], lane_); }
        put_part<2>(part, acc, 2, 0, wave_, lane_);
        LDS_WAIT(); __syncthreads();
        if ((wave_ & 3) == 0 && live) {
            const int w0 = wave_;
            f32x4 a = part[(w0 * 2) * 64 + lane_], bq = part[(w0 * 2 + 1) * 64 + lane_];
#pragma unroll
            for (int w = 1; w < 4; ++w) { a += part[((w0 + w) * 2) * 64 + lane_]; bq += part[((w0 + w) * 2 + 1) * 64 + lane_]; }
            a = a * W8I; bq = bq * W8I;
            const int n = sub * 16 + g4;
            if (glu) { v2u w; w.x = cvt_pk_bf16(a[0] * sigmoidf_fast(bq[0]), a[1] * sigmoidf_fast(bq[1])); w.y = cvt_pk_bf16(a[2] * sigmoidf_fast(bq[2]), a[3] * sigmoidf_fast(bq[3]));
                bf16* zp = WSP(bf16, WS_ZG) + (size_t)y * CONVC + (tile - 12) * 128 + n;
#pragma unroll 1
                for (int bb = 0; bb < NB; ++bb) { *(v2u*)zp = w; zp += (size_t)ZSEQ * CONVC; }
            } else if (tile < 4) { a = a * C2; v2u w; w.x = cvt_pk_bf16(a[0], a[1]); w.y = cvt_pk_bf16(a[2], a[3]); *(v2u*)(WSP(bf16, WS_QO) + (size_t)(MR + y) * ATTW + tile * 256 + n) = w; }
            else if (tile < 12) { v2u w; w.x = cvt_pk_bf16(a[0], a[1]); w.y = cvt_pk_bf16(a[2], a[3]); bf16* kp = ((tile < 8) ? WSP(bf16, WS_KB) : WSP(bf16, WS_VB)) + (size_t)(48 + y) * ATTW + (tile & 3) * 256 + n;
#pragma unroll 1
                for (int bb = 0; bb < NB; ++bb) { *(v2u*)kp = w; kp += (size_t)KSEQ * ATTW; } }
            else { v2u w; w.x = cvt_pk_bf16(sigmoidf_fast(a[0]), sigmoidf_fast(a[1])); w.y = cvt_pk_bf16(sigmoidf_fast(a[2]), sigmoidf_fast(a[3]));
                bf16* SG = (tile < 28) ? WSP(bf16, WS_SGA) : WSP(bf16, WS_SGC); *(v2u*)(SG + (size_t)(MR + y) * DM + ((tile - 20) & 7) * 256 + n) = w; }
        }
        __syncthreads();
    }
}

struct GridSched {
    pg8::GridOrder go; const char* A; const char* B; size_t tstep;
    __device__ __forceinline__ unsigned goff(int, int) const { return 0u; }
    __device__ __forceinline__ bool next(int i, pg8::Unit& u) const { u.aux = 0; u.idx = i; return go.tile(i, u.pm, u.pn); }
    __device__ __forceinline__ const char* opA(const pg8::Unit& u) const { return A + (size_t)u.pm * tstep; }
    __device__ __forceinline__ const char* opB(const pg8::Unit& u) const { return B + (size_t)u.pn * tstep; }
};
struct DualSched {
    pg8::GridOrder go; const char *A0, *B0, *A1, *B1; size_t tstep;
    __device__ __forceinline__ unsigned goff(int, int) const { return 0u; }
    __device__ __forceinline__ bool next(int i, pg8::Unit& u) const { u.aux = i & 1; u.idx = i; return go.tile(i >> 1, u.pm, u.pn); }
    __device__ __forceinline__ const char* opA(const pg8::Unit& u) const { return (u.aux ? A1 : A0) + (size_t)u.pm * tstep; }
    __device__ __forceinline__ const char* opB(const pg8::Unit& u) const { return (u.aux ? B1 : B0) + (size_t)u.pn * tstep; }
};
struct MoeSched {
    const LAS int* tb; int npn, G, c; const char* A; const char* W; size_t a_tstep, w_estride, w_tstep; const LAS unsigned* gtab;
    __device__ __forceinline__ unsigned goff(int ui, int row) const { return gtab[ui * 256 + row]; }
    __device__ __forceinline__ bool next(int i, pg8::Unit& u) const {
        const int L = i * G + c, T = L / npn; if (T >= tb[32]) return false;
        int e = 0;
#pragma unroll 1
        for (int q = 1; q < 32; ++q) e += (tb[q] <= T) ? 1 : 0;
        u.pm = T; u.pn = L - T * npn; u.aux = e; u.idx = i; return true; }
    __device__ __forceinline__ const char* opA(const pg8::Unit& u) const { return A + (size_t)u.pm * a_tstep; }
    __device__ __forceinline__ const char* opB(const pg8::Unit& u) const { return W + (size_t)u.aux * w_estride + (size_t)u.pn * w_tstep; }
};
typedef f32x4 Acc[2][2][4][2];
__device__ __forceinline__ v4u pack8(const f32x4 a, const f32x4 b) { v4u w; w.x = cvt_pk_bf16(a[0], a[1]); w.y = cvt_pk_bf16(a[2], a[3]); w.z = cvt_pk_bf16(b[0], b[1]); w.w = cvt_pk_bf16(b[2], b[3]); return w; }
__device__ __forceinline__ f32x4 sig4(const f32x4 a) { return (f32x4){sigmoidf_fast(a[0]), sigmoidf_fast(a[1]), sigmoidf_fast(a[2]), sigmoidf_fast(a[3])}; }
struct EpiIn {
    static constexpr bool PERM = true;
    bf16 *Q, *KB, *VB, *ZG, *SGA, *SGC;
    __device__ __forceinline__ bool keep(const pg8::Unit&) const { return false; }
    __device__ __forceinline__ void operator()(Acc& acc, const pg8::Unit& u, int wr, int wc, int fr, int fq) const {
        const int pn = u.pn, m0 = u.pm * 256, b = m0 >> 11, rl = wr * 64 + fr, cw = wc * 32 + 8 * fq;
        if (pn < 12) {
            const int which = pn >> 2; bf16* base; size_t row0; float sc = W8I;
            if (which == 0) { base = Q; row0 = (size_t)m0; sc = C2 * W8I; } else { base = (which == 1) ? KB : VB; row0 = (size_t)m0 + 64 * (b + 1); }
            base += (pn & 3) * 256 + cw;
#pragma unroll
            for (int ai = 0; ai < 2; ++ai)
#pragma unroll
                for (int m = 0; m < 4; ++m) { bf16* rowp = base + (row0 + rl + ai * 128 + m * 16) * ATTW;
#pragma unroll
                    for (int bj = 0; bj < 2; ++bj) *(GAS v4u*)(rowp + bj * 128) = pack8(acc[ai][bj][m][0] * sc, acc[ai][bj][m][1] * sc); }
        } else if (pn < 20) {
            bf16* base = ZG + (pn - 12) * 128 + cw; const size_t row0 = (size_t)m0 + 16 * (b + 1);
#pragma unroll
            for (int ai = 0; ai < 2; ++ai)
#pragma unroll
                for (int m = 0; m < 4; ++m) { bf16* rowp = base + (row0 + rl + ai * 128 + m * 16) * CONVC;
                    *(GAS v4u*)rowp = pack8(acc[ai][0][m][0] * W8I * sig4(acc[ai][1][m][0] * W8I), acc[ai][0][m][1] * W8I * sig4(acc[ai][1][m][1] * W8I)); }
        } else {
            bf16* base = ((pn < 28) ? SGA : SGC) + ((pn - 20) & 7) * 256 + cw;
#pragma unroll
            for (int ai = 0; ai < 2; ++ai)
#pragma unroll
                for (int m = 0; m < 4; ++m) { bf16* rowp = base + (size_t)(m0 + rl + ai * 128 + m * 16) * DM;
#pragma unroll
                    for (int bj = 0; bj < 2; ++bj) *(GAS v4u*)(rowp + bj * 128) = pack8(sig4(acc[ai][bj][m][0] * W8I), sig4(acc[ai][bj][m][1] * W8I)); }
        }
    }
};
struct EpiDual {
    static constexpr bool PERM = true;
    const bf16 *SGA, *SGC; bf16* MG;
    __device__ __forceinline__ bool keep(const pg8::Unit& u) const { return u.aux == 0; }
    __device__ __forceinline__ void operator()(Acc& acc, const pg8::Unit& u, int wr, int wc, int fr, int fq) const {
        const size_t off0 = (size_t)(u.pm * 256 + wr * 64 + fr) * DM + u.pn * 256 + wc * 32 + 8 * fq;
        if (u.aux == 0) {
#pragma unroll
            for (int ai = 0; ai < 2; ++ai)
#pragma unroll
                for (int m = 0; m < 4; ++m)
#pragma unroll
                    for (int bj = 0; bj < 2; ++bj) { const size_t off = off0 + (size_t)(ai * 128 + m * 16) * DM + bj * 128;
                        const v4u c = *(const GAS v4u*)(SGC + off), a = *(const GAS v4u*)(SGA + off);
                        const f32x4 c0 = {bf_lo(c.x), bf_hi(c.x), bf_lo(c.y), bf_hi(c.y)}, c1 = {bf_lo(c.z), bf_hi(c.z), bf_lo(c.w), bf_hi(c.w)};
                        const f32x4 a0 = {bf_lo(a.x), bf_hi(a.x), bf_lo(a.y), bf_hi(a.y)}, a1 = {bf_lo(a.z), bf_hi(a.z), bf_lo(a.w), bf_hi(a.w)};
#pragma unroll
                        for (int q = 0; q < 4; ++q) { acc[ai][bj][m][0][q] *= a0[q] * __builtin_amdgcn_rcpf(c0[q]); acc[ai][bj][m][1][q] *= a1[q] * __builtin_amdgcn_rcpf(c1[q]); } }
        } else {
#pragma unroll
            for (int ai = 0; ai < 2; ++ai)
#pragma unroll
                for (int m = 0; m < 4; ++m)
#pragma unroll
                    for (int bj = 0; bj < 2; ++bj) { const size_t off = off0 + (size_t)(ai * 128 + m * 16) * DM + bj * 128;
                        const v4u c = *(const GAS v4u*)(SGC + off);
                        const f32x4 c0 = {bf_lo(c.x), bf_hi(c.x), bf_lo(c.y), bf_hi(c.y)}, c1 = {bf_lo(c.z), bf_hi(c.z), bf_lo(c.w), bf_hi(c.w)};
                        *(GAS v4u*)(MG + off) = pack8(acc[ai][bj][m][0] * c0, acc[ai][bj][m][1] * c1); }
        }
    }
};
struct EpiRes {
    static constexpr bool PERM = true;
    const float* basef; bf16* res;
    __device__ __forceinline__ bool keep(const pg8::Unit&) const { return false; }
    __device__ __forceinline__ void operator()(Acc& acc, const pg8::Unit& u, int wr, int wc, int fr, int fq) const {
        const size_t off0 = (size_t)(u.pm * 256 + wr * 64 + fr) * DM + u.pn * 256 + wc * 32 + 8 * fq;
#pragma unroll
        for (int ai = 0; ai < 2; ++ai)
#pragma unroll
            for (int m = 0; m < 4; ++m)
#pragma unroll
                for (int bj = 0; bj < 2; ++bj) { const size_t off = off0 + (size_t)(ai * 128 + m * 16) * DM + bj * 128; f32x4 b0, b1;
                    if (basef) { b0 = *(const GAS f32x4*)(basef + off); b1 = *(const GAS f32x4*)(basef + off + 4); }
                    else { const v4u c = *(const GAS v4u*)(res + off); b0 = (f32x4){bf_lo(c.x), bf_hi(c.x), bf_lo(c.y), bf_hi(c.y)}; b1 = (f32x4){bf_lo(c.z), bf_hi(c.z), bf_lo(c.w), bf_hi(c.w)}; }
                    *(GAS v4u*)(res + off) = pack8(b0 + acc[ai][bj][m][0], b1 + acc[ai][bj][m][1]); }
    }
};
struct EpiGlu {
    static constexpr bool PERM = true;
    bf16* H; const LAS float* rst;
    __device__ __forceinline__ bool keep(const pg8::Unit&) const { return false; }
    __device__ __forceinline__ void operator()(Acc& acc, const pg8::Unit& u, int wr, int wc, int fr, int fq) const {
        bf16* base = H + (size_t)(u.pm * 256 + wr * 64 + fr) * DE + u.pn * 128 + wc * 32 + 8 * fq;
#pragma unroll
        for (int ai = 0; ai < 2; ++ai)
#pragma unroll
            for (int m = 0; m < 4; ++m) { const float rs = rst[u.idx * 256 + wr * 64 + fr + ai * 128 + m * 16];
                const f32x4 g0 = acc[ai][0][m][0] * rs, g1 = acc[ai][0][m][1] * rs;
                *(GAS v4u*)(base + (size_t)(ai * 128 + m * 16) * DE) = pack8(g0 * sig4(g0) * (acc[ai][1][m][0] * rs), g1 * sig4(g1) * (acc[ai][1][m][1] * rs)); }
    }
};
struct EpiDown {
    static constexpr bool PERM = true;
    const LAS int* tb; const LAS int* cn; const int* perm; const float* wts; bf16 *Y0, *Y1;
    __device__ __forceinline__ bool keep(const pg8::Unit&) const { return false; }
    __device__ __forceinline__ void operator()(Acc& acc, const pg8::Unit& u, int wr, int wc, int fr, int fq) const {
        const int e = u.aux, r0 = (u.pm - tb[e]) * 256 + wr * 64 + fr, cnt = cn[e], col = u.pn * 256 + wc * 32 + 8 * fq;
#pragma unroll
        for (int ai = 0; ai < 2; ++ai)
#pragma unroll
            for (int m = 0; m < 4; ++m) { const int r = r0 + ai * 128 + m * 16;
                if (r < cnt) { const int id = perm[(size_t)e * PCAP + r]; const float w = wts[id]; bf16* rowp = ((id & 1) ? Y1 : Y0) + (size_t)(id >> 1) * DM + col;
#pragma unroll
                    for (int bj = 0; bj < 2; ++bj) *(GAS v4u*)(rowp + bj * 128) = pack8(acc[ai][bj][m][0] * w, acc[ai][bj][m][1] * w); } }
    }
};

__device__ __forceinline__ void cum_table(Frame& F, int bh) {
    int tid_ = F.tid; asm volatile("" : "+v"(tid_)); const int lane = tid_ & 63, wave = __builtin_amdgcn_readfirstlane(tid_ >> 6);
    LAS float* cs = (LAS float*)(F.lds + RING_OFF + attn_body::LDS_CS); LAS float* tot = (LAS float*)(F.lds + RING_OFF + attn_body::LDS_TOT);
    const GAS float* lf = (const GAS float*)WSP(float, WS_LOGF) + (size_t)bh * KSEQ;
    constexpr int NCH = KSEQ / 64;
    for (int c = wave; c < NCH; c += NWAVES) { const int row = 64 * c + lane; float v = (row >= 48) ? lf[row] : 0.f;
#pragma unroll
        for (int o = 1; o < 64; o <<= 1) { const float t = shfl_idx(v, lane - o); if (lane >= o) v += t; }
        cs[row] = v; if (lane == 63) tot[c] = v; }
    LDS_WAIT(); __syncthreads();
    float tv = (lane < NCH) ? tot[lane] : 0.f, inc = tv;
#pragma unroll
    for (int o = 1; o < 64; o <<= 1) { const float t = shfl_idx(inc, lane - o); if (lane >= o) inc += t; }
    const float exc = inc - tv;
    for (int c = wave; c < NCH; c += NWAVES) { const int row = 64 * c + lane; const float off = __int_as_float(__builtin_amdgcn_readlane(__float_as_int(exc), c));
        cs[row] = (row >= 48) ? cs[row] + off : INFINITY; }
    LDS_WAIT(); __syncthreads();
}
__device__ __forceinline__ void meta_attn_head(Frame& F, int h) {
    OPAQUE_IDS();
    const bf16* Qm = WSP(bf16, WS_QO) + (size_t)MR * ATTW + h * HD; const bf16* Km = WSP(bf16, WS_KB) + (size_t)48 * ATTW + h * HD; const bf16* Vm = WSP(bf16, WS_VB) + (size_t)48 * ATTW + h * HD;
    const float* lf = WSP(float, WS_LOGF) + (size_t)h * KSEQ + 48;
    const int i = lane_ & 15, qd = (lane_ >> 4) * 16;
    float q[16];
#pragma unroll
    for (int d = 0; d < 16; ++d) q[d] = bf_lo((unsigned)Qm[(size_t)i * ATTW + qd + d]);
    float cum[16]; { float c = 0.f;
#pragma unroll
        for (int j = 0; j < 16; ++j) { c += lf[j]; cum[j] = c; } }
    float ci = 0.f;
#pragma unroll
    for (int j = 0; j < 16; ++j) ci = (j == i) ? cum[j] : ci;
    float s[16], mx = -INFINITY;
#pragma unroll
    for (int j = 0; j < 16; ++j) { float p = 0.f;
#pragma unroll
        for (int d = 0; d < 16; ++d) p += q[d] * bf_lo((unsigned)Km[(size_t)j * ATTW + qd + d]);
        p += swz_xor<16>(p); p = xor32_sum(p);
        s[j] = (j <= i) ? p + ci - cum[j] : -INFINITY; mx = fmaxf(mx, s[j]); }
    float den = 0.f, o[16];
#pragma unroll
    for (int d = 0; d < 16; ++d) o[d] = 0.f;
#pragma unroll
    for (int j = 0; j < 16; ++j) { const float p = __builtin_amdgcn_exp2f(s[j] - mx); den += p;
#pragma unroll
        for (int d = 0; d < 16; ++d) o[d] += p * bf_lo((unsigned)Vm[(size_t)j * ATTW + qd + d]); }
    const float inv = 1.0f / den;
    bf16* Om = WSP(bf16, WS_O) + (size_t)(MR + i) * ATTW + h * HD + qd;
#pragma unroll
    for (int d = 0; d < 16; d += 2) *(unsigned*)(Om + d) = cvt_pk_bf16(o[d] * inv, o[d + 1] * inv);
}
__device__ __forceinline__ void conv_item(Frame& F, int l, int b, int p0, int out_row0) {
    int tid_ = F.tid; asm volatile("" : "+v"(tid_));
    const int c2 = tid_ * 2;
    const float* cw = F.in[6] + (size_t)l * CONVK * CONVC; const float cb0 = F.in[7][l * CONVC + c2], cb1 = F.in[7][l * CONVC + c2 + 1];
    LAS float* zb = (LAS float*)(F.lds + RING_OFF);
    f32x2 w[CONVK];
#pragma unroll
    for (int j = 0; j < CONVK; ++j) w[j] = *(const GAS f32x2*)(cw + (size_t)j * CONVC + c2);
    LAS unsigned char* win = F.lds + RING_OFF;
    { const GAS char* zsrc = (const GAS char*)WSP(bf16, WS_ZG) + ((size_t)b * ZSEQ + p0 - 30) * (CONVC * 2);
#pragma unroll
      for (int k = 0; k < 12; ++k) { const int q = tid_ + 512 * k; if (q < 46 * 128) { v4u v = {0u, 0u, 0u, 0u}; if (p0 - 30 + (q >> 7) >= 0) v = *(const GAS v4u*)(zsrc + (size_t)q * 16); *(LAS v4u*)(win + q * 16) = v; } } }
    LDS_WAIT(); __syncthreads();
    f32x2 a[16];
#pragma unroll
    for (int o = 0; o < 16; ++o) a[o] = (f32x2){cb0, cb1};
#pragma unroll
    for (int i = 0; i < 46; ++i) { const unsigned u = *(const LAS unsigned*)(win + i * (CONVC * 2) + tid_ * 4);
        const f32x2 x = {bf_lo(u), bf_hi(u)};
#pragma unroll
        for (int o = 0; o < 16; ++o) if (i - o >= 0 && i - o < CONVK) a[o] += w[i - o] * x; }
    LDS_WAIT(); __syncthreads();
#pragma unroll
    for (int o = 0; o < 16; ++o) *(LAS f32x2*)(zb + o * CONVC + c2) = a[o];
    LDS_WAIT(); __syncthreads();
    const int ln = tid_ & 63, wv_ = tid_ >> 6;
    const float* lg = F.in[8] + (size_t)l * CONVC; const float* lb = F.in[9] + (size_t)l * CONVC;
#pragma unroll
    for (int rr = 0; rr < 2; ++rr) { const int o = wv_ * 2 + rr;
        f32x4 v[4]; float s = 0.f;
#pragma unroll
        for (int j = 0; j < 4; ++j) { v[j] = *(const LAS f32x4*)(zb + o * CONVC + 4 * (ln + 64 * j)); s += (v[j].x + v[j].y) + (v[j].z + v[j].w); }
        const float mu = wave_sum(s) * (1.0f / CONVC); float q = 0.f;
#pragma unroll
        for (int j = 0; j < 4; ++j) { v[j] = v[j] - mu; q += (v[j].x * v[j].x + v[j].y * v[j].y) + (v[j].z * v[j].z + v[j].w * v[j].w); }
        const float rstd = 1.0f / sqrtf(wave_sum(q) * (1.0f / CONVC) + LN_EPS);
        bf16* op = WSP(bf16, WS_CV) + (size_t)(out_row0 + o) * CONVC;
#pragma unroll
        for (int j = 0; j < 4; ++j) { const int c = 4 * (ln + 64 * j); const f32x4 gg = *(const GAS f32x4*)(lg + c), bb = *(const GAS f32x4*)(lb + c);
            f32x4 z = v[j] * rstd * gg + bb; z = z * sig4(z); v2u wv; wv.x = cvt_pk_bf16(z.x, z.y); wv.y = cvt_pk_bf16(z.z, z.w); *(GAS v2u*)(op + c) = wv; } }
    __syncthreads();
}
__device__ __forceinline__ void pc_phase(Frame& F, int l, char* ldsg) {
    for (int rep3 = 0; rep3 < ((REP_PHASE == 3) ? 2 : 1); ++rep3)
    for (int v = F.vcu; v < 2 * NB * NH; v += F.G) {
        const int bh = v >> 1, s0 = 2 * (v & 1);
        cum_table(F, bh);
        const __hip_bfloat16* Q = (const __hip_bfloat16*)WSP(bf16, WS_QO); const __hip_bfloat16* K = (const __hip_bfloat16*)WSP(bf16, WS_KB); const __hip_bfloat16* V = (const __hip_bfloat16*)WSP(bf16, WS_VB);
#pragma unroll 1
        for (int i = 0; i < 4; ++i) { const int qb = (i == 0) ? s0 : (i == 1) ? 7 - s0 : (i == 2) ? s0 + 1 : 6 - s0;
#ifndef NO_ATTN
            attn_body::attn_unit<8>(bh / NH, bh % NH, qb, Q, K, V, (__hip_bfloat16*)WSP(bf16, WS_O), ldsg + RING_OFF);
#endif
        }
        __syncthreads();
    }
#ifndef NO_MATTN
    if (F.vcu >= F.G - 2) meta_attn_head(F, (F.vcu - (F.G - 2)) * 8 + F.wave);
#endif
    __syncthreads();
#ifndef NO_CONV
    for (int rep30 = 0; rep30 < ((REP_PHASE == 30) ? 2 : 1); ++rep30)
    for (int it = F.vcu; it < MR / 16 + 1; it += F.G) {
        const bool real = it < MR / 16; const int b = real ? it >> 7 : 0, t0 = (it & 127) * 16;
        conv_item(F, l, b, real ? NMETA + t0 : 0, real ? b * SEQ + t0 : MR);
    }
#endif
}
__device__ __forceinline__ void pd_side(Frame& F, int l) {
    OPAQUE_IDS();
    const int j = F.vcu; if (j >= DM / 16) return;
    const unsigned char* wl = F.ws + WS_W + (size_t)l * W_LSTRIDE; const int g4 = (lane_ >> 4) * 4, y = lane_ & 15;
    LAS f32x4* part = (LAS f32x4*)(F.lds + RING_OFF);
    f32x4 acc[2] = {{0.f, 0.f, 0.f, 0.f}, {0.f, 0.f, 0.f, 0.f}}, gd[1];
    { f32x4 (&a0)[1] = *(f32x4(*)[1])&acc[0]; f32x4 (&a1)[1] = *(f32x4(*)[1])&acc[1];
      skinny_slice<1, 1, 4, false>((const bf16*)(wl + WO_AO) + (size_t)j * 16 * ATTW, ATTW, 0, WSP(bf16, WS_O) + (size_t)MR * ATTW, ATTW, 0, wave_ * 128, 4, a0, gd, lane_);
      skinny_slice<1, 1, 4, false>((const bf16*)(wl + WO_CO) + (size_t)j * 16 * CONVC, CONVC, 0, WSP(bf16, WS_CV) + (size_t)MR * CONVC, CONVC, 0, wave_ * 128, 4, a1, gd, lane_); }
    put_part<2>(part, acc, 2, 0, wave_, lane_);
    LDS_WAIT(); __syncthreads();
    if (wave_ == 0) {
        const f32x4 a1 = sum_part<2>(part, 0, lane_), a2 = sum_part<2>(part, 1, lane_);
        const size_t off = (size_t)(MR + y) * DM + j * 16 + g4;
        const v2u ga = *(const GAS v2u*)(WSP(bf16, WS_SGA) + off), gc = *(const GAS v2u*)(WSP(bf16, WS_SGC) + off);
        v2u w; w.x = cvt_pk_bf16(bf_lo(ga.x) * a1[0] + bf_lo(gc.x) * a2[0], bf_hi(ga.x) * a1[1] + bf_hi(gc.x) * a2[1]);
        w.y = cvt_pk_bf16(bf_lo(ga.y) * a1[2] + bf_lo(gc.y) * a2[2], bf_hi(ga.y) * a1[3] + bf_hi(gc.y) * a2[3]);
        *(GAS v2u*)(WSP(bf16, WS_MG) + off) = w;
    }
    __syncthreads();
}
__device__ __forceinline__ void pe_side(Frame& F, int l) {
    OPAQUE_IDS();
    const int j = F.vcu; if (j >= DM / 16) return;
    const unsigned char* wl = F.ws + WS_W + (size_t)l * W_LSTRIDE; const int g4 = (lane_ >> 4) * 4, y = lane_ & 15;
    LAS f32x4* part = (LAS f32x4*)(F.lds + RING_OFF);
    f32x4 acc[1] = {{0.f, 0.f, 0.f, 0.f}}, gd[1];
    skinny_slice<1, 1, 8, false>((const bf16*)(wl + WO_O) + (size_t)j * 16 * DM, DM, 0, WSP(bf16, WS_MG) + (size_t)MR * DM, DM, 0, wave_ * 256, 8, acc, gd, lane_);
    put_part<1>(part, acc, 1, 0, wave_, lane_);
    LDS_WAIT(); __syncthreads();
    if (wave_ == 0) {
        const f32x4 a = sum_part<1>(part, 0, lane_);
        bf16* rp = WSP(bf16, WS_RES) + (size_t)(MR + y) * DM + j * 16 + g4; f32x4 bv;
        if (l == 0) bv = *(const GAS f32x4*)(F.in[1] + (size_t)y * DM + j * 16 + g4);
        else { const v2u c = *(const GAS v2u*)rp; bv = (f32x4){bf_lo(c.x), bf_hi(c.x), bf_lo(c.y), bf_hi(c.y)}; }
        bv = bv + a; v2u w; w.x = cvt_pk_bf16(bv[0], bv[1]); w.y = cvt_pk_bf16(bv[2], bv[3]); *(GAS v2u*)rp = w;
    }
    __syncthreads();
}
__device__ __forceinline__ void pg_router(Frame& F, int l) {
    OPAQUE_IDS();
    const int g4 = (lane_ >> 4) * 4, y = lane_ & 15;
    LAS f32x4* part = (LAS f32x4*)(F.lds + RING_OFF);
    const bf16* WrT = WSP(bf16, WS_WR) + (size_t)l * 48 * DM;
    for (int rnd = F.vcu; rnd * 4 < MT / 16; rnd += F.G) {
        const int b0 = rnd * 4, nblk = (MT / 16 - b0) < 4 ? (MT / 16 - b0) : 4;
        f32x4 acc[12], gram[4];
#pragma unroll
        for (int a = 0; a < 12; ++a) acc[a] = (f32x4){0.f, 0.f, 0.f, 0.f};
#pragma unroll
        for (int a = 0; a < 4; ++a) gram[a] = (f32x4){0.f, 0.f, 0.f, 0.f};
        skinny_slice<3, 4, 4, true>(WrT, DM, (size_t)16 * DM, WSP(bf16, WS_RES) + (size_t)b0 * 16 * DM, DM, (nblk == 4) ? (size_t)16 * DM : 0, wave_ * 256, 8, acc, gram, lane_);
        put_part<16>(part, acc, 12, 0, wave_, lane_); put_part<16>(part, gram, 4, 12, wave_, lane_);
        LDS_WAIT(); __syncthreads();
        f32x4 lgt[3], gr;
        if (wave_ < nblk) {
#pragma unroll
            for (int x = 0; x < 3; ++x) lgt[x] = sum_part<16>(part, x * 4 + wave_, lane_);
            gr = sum_part<16>(part, 12 + wave_, lane_); }
        __syncthreads();
        if (wave_ < nblk) {
            const int rb = b0 + wave_;
            LAS float* scr = (LAS float*)(F.lds + RING_OFF) + wave_ * (16 * 49);
#pragma unroll
            for (int blk = 0; blk < 3; ++blk)
#pragma unroll
                for (int r = 0; r < 4; ++r) scr[y * 49 + blk * 16 + g4 + r] = lgt[blk][r];
            if ((lane_ >> 4) == (y >> 2)) scr[y * 49 + 48] = (y & 3) == 0 ? gr[0] : (y & 3) == 1 ? gr[1] : (y & 3) == 2 ? gr[2] : gr[3];
            LDS_WAIT(); asm volatile("" ::: "memory");
            if (lane_ < 16) {
                const LAS float* lg = scr + lane_ * 49; const int m = rb * 16 + lane_;
                const float rstd = 1.0f / sqrtf(lg[48] * (1.0f / DM) + RMS_EPS); WSP(float, WS_RSTD)[m] = rstd;
                float gl[NGRP]; int gi = 0;
#pragma unroll
                for (int g = 0; g < NGRP; ++g) gl[g] = lg[g] * rstd + F.in[14][l * NGRP + g];
#pragma unroll
                for (int g = 1; g < NGRP; ++g) if (gl[g] > gl[gi]) gi = g;
                float gmax = gl[0];
#pragma unroll
                for (int g = 1; g < NGRP; ++g) gmax = fmaxf(gmax, gl[g]);
                float den = 0.f;
#pragma unroll
                for (int g = 0; g < NGRP; ++g) den += expf(gl[g] - gmax);
                const float gw = 1.0f / den;
                float ev[EPG];
#pragma unroll
                for (int i = 0; i < EPG; ++i) ev[i] = lg[NGRP + gi * EPG + i] * rstd + F.in[16][l * NE + gi * EPG + i];
                int i0 = 0;
#pragma unroll
                for (int i = 1; i < EPG; ++i) if (ev[i] > ev[i0]) i0 = i;
                float v0 = ev[0];
#pragma unroll
                for (int i = 1; i < EPG; ++i) v0 = fmaxf(v0, ev[i]);
                int i1 = (i0 == 0) ? 1 : 0; float v1 = -INFINITY;
#pragma unroll
                for (int i = 0; i < EPG; ++i) if (i != i0 && ev[i] > v1) { v1 = ev[i]; i1 = i; }
                const float w0 = gw / (1.0f + expf(v1 - v0)), w1 = gw - w0;
                unsigned* cnt = (unsigned*)(F.ctl + CW_CNT + l * 64); int* perm = WSP(int, WS_PERM); float* wts = WSP(float, WS_WTS);
                const int e0 = gi * EPG + i0, e1 = gi * EPG + i1;
                const unsigned q0 = __hip_atomic_fetch_add(cnt + e0, 1u, RLX_AGENT), q1 = __hip_atomic_fetch_add(cnt + e1, 1u, RLX_AGENT);
                perm[(size_t)e0 * PCAP + q0] = 2 * m; perm[(size_t)e1 * PCAP + q1] = 2 * m + 1; wts[2 * m] = w0; wts[2 * m + 1] = w1;
            }
        }
        __syncthreads();
    }
}
__device__ __forceinline__ void moe_tables(Frame& F, int l) {
    OPAQUE_IDS();
    LAS int* tb = (LAS int*)(F.lds + TAB_OFF); LAS int* cn = tb + 40;
    if (wave_ == 0) { const int c = (lane_ < NE) ? (int)__hip_atomic_load((unsigned*)(F.ctl + CW_CNT + l * 64 + lane_), RLX_AGENT) : 0; int nt = (c + 255) >> 8, inc = nt;
#pragma unroll
        for (int o = 1; o < 64; o <<= 1) { const int t = shfl_idx_i(inc, lane_ - o); if (lane_ >= o) inc += t; }
        if (lane_ < NE) { tb[lane_] = inc - nt; cn[lane_] = c; } if (lane_ == NE) tb[NE] = inc; }
    LDS_WAIT(); __syncthreads();
}
__device__ __forceinline__ void moe_gather_table(Frame& F, int npn, int l) {
    OPAQUE_IDS();
    LAS float* rst = (LAS float*)(F.lds + RSTAB_OFF); const float* rstd = WSP(float, WS_RSTD); (void)l;
    const LAS int* tb = (const LAS int*)(F.lds + TAB_OFF); const LAS int* cn = tb + 40; LAS unsigned* gt = (LAS unsigned*)(F.lds + GTAB_OFF);
    const int* perm = WSP(int, WS_PERM);
    for (int i = 0; i < GTAB_UNITS; ++i) { const int L = i * F.G + (int)blockIdx.x, T = L / npn; if (T >= tb[NE]) break;
        int e = 0;
#pragma unroll 1
        for (int q = 1; q < NE; ++q) e += (tb[q] <= T) ? 1 : 0;
        if (tid_ < 256) { const int r = (T - tb[e]) * 256 + tid_; const int tok = (r < cn[e]) ? (perm[(size_t)e * PCAP + r] >> 1) : 0; gt[i * 256 + tid_] = (unsigned)tok * (unsigned)(DM * 2);
            rst[i * 256 + tid_] = rstd[tok]; } }
    LDS_WAIT(); __syncthreads();
}

struct Args { const float* in[20]; float* out; unsigned char* ws; int ph_lo, ph_hi; };
constexpr int N_PHASES = 22;
__global__ void __launch_bounds__(NWAVES * 64, 2) fox_fwd(Args args) {
    extern __shared__ __attribute__((aligned(16))) unsigned char lds[];
#ifdef USE_AGPR_HINT
    { float dummy_ = 0.f; asm volatile("" :: "a"(dummy_)); }
#endif
    Frame F;
    F.lds = (LAS unsigned char*)lds; F.MISC = (volatile LAS unsigned*)(F.lds + MISC_OFF);
    F.tid = threadIdx.x; F.lane = F.tid & 63; F.wave = __builtin_amdgcn_readfirstlane(F.tid >> 6);
    F.G = gridDim.x; { const int bx = blockIdx.x; F.vcu = (F.G % 8 == 0) ? (bx % 8) * (F.G / 8) + bx / 8 : bx; }
    F.gw = F.vcu * NWAVES + F.wave; F.NGW = F.G * NWAVES;
    F.ws = args.ws; F.in = args.in; F.ctl = (gu32*)(args.ws + WS_CTL);
    for (int u = F.tid; u < (LDS_BYTES - MISC_OFF) / 4; u += NWAVES * 64) ((LAS unsigned*)(F.lds + MISC_OFF))[u] = 0u;
    __syncthreads();
    const int lo = args.ph_lo, hi = args.ph_hi;
    const bool one_launch = (hi - lo) > 1;
    XcdBarrier bar; bar.bar = (unsigned*)(F.ctl + CW_BAR); bar.x = 0; bar.st = nullptr;
    if (one_launch) bar = xcd_barrier_post((unsigned*)(F.ctl + CW_BAR), F.MISC + 8);
#ifndef PH_MASK
#define PH_MASK 0xffffffffu
#endif
#define IN(k) (((PH_MASK >> ((k) > 10 ? (k) - 10 : (k))) & 1u) && lo <= (k) && (k) < hi)
#define SEAM(k) do { if (IN(k) && IN((k) + 1)) xcd_barrier(bar); } while (0)
#define REPS(j) (((REP_PHASE) == (j)) ? 2 : 1)
#define REPBAR(rep) do { if ((rep) == 0 && one_launch) xcd_barrier(bar); } while (0)
    LAS unsigned char* ring = F.lds + RING_OFF;
    const int bx = (int)blockIdx.x;

    if (IN(0)) for (int rep = 0; rep < REPS(0); ++rep) { p0_convert(F); norm_phase<0>(F, F.in[2], WSP(bf16, WS_XN), nullptr); if (REPS(0) > 1) REPBAR(rep); }
    SEAM(0);
#pragma unroll 1
    for (int l = 0; l < DEPTH; ++l) {
        const int P = 1 + 10 * l;
        const unsigned char* wl = F.ws + WS_W + (size_t)l * W_LSTRIDE;
        if (l > 0) { if (IN(P)) norm_phase<1>(F, F.in[2] + (size_t)l * DM, WSP(bf16, WS_XN), nullptr); SEAM(P); }
        if (IN(P + 1)) for (int rep = 0; rep < REPS(2); ++rep) {
            if (rep > 0) REPBAR(0);
#ifndef NO_PBSIDE
            pb_side(F, l); VM_WAIT(); __syncthreads();
#endif
            GridSched S; S.go.init(MR / 256, 36, F.G, bx); S.A = (const char*)(F.ws + WS_XN8); S.B = (const char*)(wl + WO_IN); S.tstep = (size_t)256 * DM;
            EpiIn E{WSP(bf16, WS_QO), WSP(bf16, WS_KB), WSP(bf16, WS_VB), WSP(bf16, WS_ZG), WSP(bf16, WS_SGA), WSP(bf16, WS_SGC)};
#ifndef NO_PBGEMM
            pg8::gemm_phase<EpiIn, GridSched, true, true>(ring, DM, S, E);
#endif
        }
        SEAM(P + 1);
        if (IN(P + 2)) pc_phase(F, l, (char*)lds);
        SEAM(P + 2);
        if (IN(P + 3)) for (int rep = 0; rep < REPS(4); ++rep) {
            if (rep > 0) REPBAR(0);
            pd_side(F, l); VM_WAIT(); __syncthreads();
            DualSched S; S.go.init(MR / 256, DM / 256, F.G, bx); S.A0 = (const char*)WSP(bf16, WS_O); S.B0 = (const char*)(wl + WO_AO); S.A1 = (const char*)WSP(bf16, WS_CV); S.B1 = (const char*)(wl + WO_CO); S.tstep = (size_t)256 * ATTW * 2;
            EpiDual E{WSP(bf16, WS_SGA), WSP(bf16, WS_SGC), WSP(bf16, WS_MG)};
            pg8::gemm_phase<EpiDual, DualSched, true>(ring, ATTW * 2, S, E);
        }
        SEAM(P + 3);
        if (IN(P + 4)) for (int rep = 0; rep < ((l == 0) ? REPS(5) : 1); ++rep) {
            if (rep > 0) REPBAR(0);
            pe_side(F, l); VM_WAIT(); __syncthreads();
            GridSched S; S.go.init(MR / 256, DM / 256, F.G, bx); S.A = (const char*)WSP(bf16, WS_MG); S.B = (const char*)(wl + WO_O); S.tstep = (size_t)256 * DM * 2;
            EpiRes E{(l == 0) ? F.in[0] : nullptr, WSP(bf16, WS_RES)};
            pg8::gemm_phase<EpiRes, GridSched, true>(ring, DM * 2, S, E);
        }
        SEAM(P + 4);
        if (IN(P + 6)) pg_router(F, l);
        SEAM(P + 6);
        if (IN(P + 8)) for (int rep = 0; rep < REPS(9); ++rep) {
            if (rep > 0) REPBAR(0);
            moe_tables(F, l); moe_gather_table(F, DE / 128, l);
            MoeSched S; S.tb = (const LAS int*)(F.lds + TAB_OFF); S.npn = DE / 128; S.G = F.G; S.c = bx; S.A = (const char*)WSP(bf16, WS_RES); S.W = (const char*)(wl + WO_GU);
            S.a_tstep = 0; S.w_estride = (size_t)(2 * DE) * DM * 2; S.w_tstep = (size_t)256 * DM * 2; S.gtab = (const LAS unsigned*)(F.lds + GTAB_OFF);
            EpiGlu E{WSP(bf16, WS_H), (const LAS float*)(F.lds + RSTAB_OFF)};
            pg8::gemm_phase<EpiGlu, MoeSched, true, false, true>(ring, DM * 2, S, E);
        }
        SEAM(P + 8);
        if (IN(P + 9)) for (int rep = 0; rep < REPS(10); ++rep) {
            if (rep > 0) REPBAR(0);
            moe_tables(F, l);
            MoeSched S; S.tb = (const LAS int*)(F.lds + TAB_OFF); S.npn = DM / 256; S.G = F.G; S.c = bx; S.A = (const char*)WSP(bf16, WS_H); S.W = (const char*)(wl + WO_DN);
            S.a_tstep = (size_t)256 * DE * 2; S.w_estride = (size_t)DM * DE * 2; S.w_tstep = (size_t)256 * DE * 2; S.gtab = nullptr;
            EpiDown E{(const LAS int*)(F.lds + TAB_OFF), (const LAS int*)(F.lds + TAB_OFF) + 40, WSP(int, WS_PERM), WSP(float, WS_WTS), WSP(bf16, WS_Y0), WSP(bf16, WS_Y1)};
            pg8::gemm_phase<EpiDown, MoeSched, true>(ring, DE * 2, S, E);
        }
        SEAM(P + 9);
    }
#if DBG_DUMP == 0
    if (IN(21)) for (int rep = 0; rep < REPS(21); ++rep) { if (rep > 0) REPBAR(0); norm_phase<3>(F, F.in[19], nullptr, args.out); }
#else
    if (IN(21)) {
        for (size_t i = (size_t)blockIdx.x * 512 + threadIdx.x; i < (size_t)MR * DM; i += (size_t)gridDim.x * 512) { const size_t m = i / DM, c = i % DM; float v = 0.f;
            if (DBG_DUMP == 1) v = bf_lo(WSP(bf16, WS_RES)[i]);
            else if (DBG_DUMP == 2) v = bf_lo(WSP(bf16, WS_Y0)[i]) + bf_lo(WSP(bf16, WS_Y1)[i]);
            else if (DBG_DUMP == 3) v = bf_lo(WSP(bf16, WS_MG)[i]);
            else if (DBG_DUMP == 4) v = (c < 1024) ? bf_lo(WSP(bf16, WS_O)[m * 1024 + c]) : bf_lo(WSP(bf16, WS_CV)[m * 1024 + c - 1024]);
            else if (DBG_DUMP == 5) v = bf_lo(WSP(bf16, WS_XN)[i]);
            else if (DBG_DUMP == 6) v = bf_lo(WSP(bf16, WS_SGA)[i]) + bf_lo(WSP(bf16, WS_SGC)[i]);
            else if (DBG_DUMP == 7) v = bf_lo(WSP(bf16, WS_N2)[i]);
            else if (DBG_DUMP == 8) { const size_t b = m >> 11, t = m & 2047; v = (c < 1024) ? bf_lo(WSP(bf16, WS_KB)[(b * KSEQ + 64 + t) * 1024 + c]) : bf_lo(WSP(bf16, WS_ZG)[(b * ZSEQ + 16 + t) * 1024 + c - 1024]); }
            args.out[i] = v; }
    }
#endif
#undef IN
#undef SEAM
}

extern "C" void kernel_launch(void* const* d_in, const int* in_sizes, int n_in, void* d_out, int out_size, void* d_ws, size_t ws_size, hipStream_t stream) {
    static int grid = 0;
    if (grid == 0) {
        if (n_in != 20 || out_size != MR * DM || ws_size < WS_END) { fprintf(stderr, "kernel_launch: unexpected problem (n_in %d, out %d, ws %zu); nothing launched\n", n_in, out_size, ws_size); grid = -1; return; }
        int dev = 0, cus = 0, per_cu = 0;
        if (hipGetDevice(&dev) != hipSuccess || hipDeviceGetAttribute(&cus, hipDeviceAttributeMultiprocessorCount, dev) != hipSuccess) { grid = -1; return; }
        if (hipFuncSetAttribute((const void*)fox_fwd, hipFuncAttributeMaxDynamicSharedMemorySize, LDS_BYTES) != hipSuccess) { fprintf(stderr, "kernel_launch: hipFuncSetAttribute failed\n"); grid = -1; return; }
        if (hipOccupancyMaxActiveBlocksPerMultiprocessor(&per_cu, (const void*)fox_fwd, NWAVES * 64, LDS_BYTES) != hipSuccess || per_cu < 1) { fprintf(stderr, "kernel_launch: occupancy query says %d\n", per_cu); }
        (void)hipGetLastError();
        grid = cus;
    }
    if (grid < 0) return;
    if (hipMemsetAsync((char*)d_ws + WS_CTL, 0, CTL_ZERO_BYTES, stream) != hipSuccess) return;
    Args a{};
    for (int i = 0; i < 20; ++i) a.in[i] = (const float*)d_in[i];
    a.out = (float*)d_out; a.ws = (unsigned char*)d_ws;
#if MK_N_LAUNCHES == 1
    a.ph_lo = 0; a.ph_hi = N_PHASES;
    hipLaunchKernelGGL(fox_fwd, dim3(grid), dim3(NWAVES * 64), LDS_BYTES, stream, a);
#else
    for (int p = 0; p < N_PHASES; ++p) { if (p == 1 || p == 6 || p == 16 || p == 8 || p == 18 || (p > DBG_STOP && p != N_PHASES - 1)) continue; a.ph_lo = p; a.ph_hi = p + 1; hipLaunchKernelGGL(fox_fwd, dim3(grid), dim3(NWAVES * 64), LDS_BYTES, stream, a); }
#endif
}
```

```cpp
#include <hip/hip_runtime.h>
#include <hip/hip_bf16.h>
#include <cstdio>
#include <cstdint>
#include <cmath>

#ifndef MK_N_LAUNCHES
#define MK_N_LAUNCHES 1
#endif

#ifndef DBG_DUMP
#define DBG_DUMP 0
#endif
#ifndef DBG_STOP
#define DBG_STOP 100
#endif
#ifndef QK_BF16
#define QK_BF16 0
#endif
#ifndef REP_PHASE
#define REP_PHASE -1
#endif
#define LAS __attribute__((address_space(3)))
#define GAS __attribute__((address_space(1)))
typedef unsigned short bf16;
typedef unsigned v4u __attribute__((ext_vector_type(4)));
typedef unsigned v2u __attribute__((ext_vector_type(2)));
typedef float f32x4 __attribute__((ext_vector_type(4)));
typedef float f32x2 __attribute__((ext_vector_type(2)));
typedef short bf16x8 __attribute__((ext_vector_type(8)));
typedef float f32x16 __attribute__((ext_vector_type(16)));
typedef short s16x4 __attribute__((ext_vector_type(4)));
typedef GAS unsigned gu32;

constexpr int NB = 8, SEQ = 2048, DM = 2048, NMETA = 16, NH = 16, HD = 64, ATTW = 1024, CONVC = 1024, CONVK = 31;
constexpr int NGRP = 4, EPG = 8, NE = 32, DE = 768, INCOLS = 9232, DEPTH = 2;
constexpr int MR = NB * SEQ;
constexpr int MT = MR + NMETA;
constexpr int MALLOC = 16640;
constexpr int KSEQ = 64 + SEQ;
constexpr int ZSEQ = NMETA + SEQ;
constexpr int PCAP = MT;
constexpr int MAXT = 162;
constexpr float RMS_EPS = 1e-6f, LN_EPS = 1e-5f;
constexpr float LOG2E = 1.4426950408889634f;
constexpr float C2 = 0.125f * 1.4426950408889634f;
constexpr float W8S = 32.0f, W8I = 1.0f / 32.0f;

constexpr size_t MiB = 1u << 20;
constexpr size_t WS_CTL = 0, CTL_ZERO_BYTES = 64 * 1024;
constexpr size_t WS_RSTD = 256 * 1024;
constexpr size_t WS_WF = 1 * MiB, WS_WR = 2 * MiB, WS_LOGF = 3 * MiB, WS_PERM = 6 * MiB, WS_WTS = 9 * MiB;
constexpr size_t WS_W = 16 * MiB, W_LSTRIDE = 340 * MiB;
constexpr size_t WO_IN16 = 18 * MiB;
constexpr size_t WO_IN = 0, WO_AO = 36 * MiB, WO_CO = 40 * MiB, WO_O = 44 * MiB, WO_GU = 52 * MiB, WO_DN = 244 * MiB;
constexpr size_t WS_XN = 696 * MiB, WS_QO = 761 * MiB, WS_KB = 794 * MiB, WS_VB = 827 * MiB, WS_ZG = 860 * MiB, WS_SGA = 893 * MiB, WS_SGC = 958 * MiB;
constexpr size_t WS_CV = 1023 * MiB, WS_MG = 1056 * MiB, WS_RES = 1121 * MiB, WS_N2 = 1251 * MiB, WS_XS = 1316 * MiB, WS_H = 1478 * MiB, WS_Y0 = 1539 * MiB, WS_Y1 = 1604 * MiB;
constexpr size_t WS_XN8 = 1669 * MiB;
constexpr size_t WS_O = 1702 * MiB;
constexpr size_t WS_END = 1735 * MiB;
constexpr int CW_TMO = 0, CW_BAR = 4096, CW_CNT = 8192;

#define RLX_AGENT __ATOMIC_RELAXED, __HIP_MEMORY_SCOPE_AGENT
#define LDS_WAIT() asm volatile("s_waitcnt lgkmcnt(0)" ::: "memory")
#define VM_WAIT() asm volatile("s_waitcnt vmcnt(0)" ::: "memory")
typedef __bf16 bf16x2_t __attribute__((ext_vector_type(2)));
__device__ __forceinline__ unsigned cvt_pk_bf16(float lo, float hi) { f32x2 v = {lo, hi}; bf16x2_t b = __builtin_convertvector(v, bf16x2_t); return __builtin_bit_cast(unsigned, b); }
__device__ __forceinline__ float bf_lo(unsigned u) { return __uint_as_float(u << 16); }
__device__ __forceinline__ float bf_hi(unsigned u) { return __uint_as_float(u & 0xffff0000u); }
__device__ __forceinline__ float sigmoidf_fast(float x) { return __builtin_amdgcn_rcpf(1.0f + __builtin_amdgcn_exp2f(-x * LOG2E)); }
template <int X> __device__ __forceinline__ float swz_xor(float v) { return __int_as_float(__builtin_amdgcn_ds_swizzle(__float_as_int(v), 0x1f | (X << 10))); }
__device__ __forceinline__ float xor32_sum(float v) { auto rr = __builtin_amdgcn_permlane32_swap(__float_as_uint(v), __float_as_uint(v), false, false); return __uint_as_float(rr[0]) + __uint_as_float(rr[1]); }
__device__ __forceinline__ float wave_sum(float v) {
    v += swz_xor<1>(v); v += swz_xor<2>(v); v += swz_xor<4>(v); v += swz_xor<8>(v); v += swz_xor<16>(v);
    return xor32_sum(v);
}
__device__ __forceinline__ float shfl_idx(float v, int src_lane) { return __int_as_float(__builtin_amdgcn_ds_bpermute(src_lane << 2, __float_as_int(v))); }
__device__ __forceinline__ int shfl_idx_i(int v, int src_lane) { return __builtin_amdgcn_ds_bpermute(src_lane << 2, v); }

namespace pg8 {
constexpr int BM = 256, BK = 64, HALF = 128, HTB = HALF * BK * 2, STAGE_BYTES = 8 * HTB, NXCD = 8, WGM = 8;
__host__ __device__ __forceinline__ int lds_byte(int r, int c) { const int st = (r >> 4) * 2 + (c >> 5), rr = r & 15, cc = c & 31, ob = rr * 64 + cc * 2; return st * 1024 + (ob ^ (((ob >> 9) & 1) << 5)); }
__host__ __device__ __forceinline__ void stage_rc(int b, int& R, int& C) { const int st = b / 1024, sb = b % 1024, swz = sb ^ (((sb >> 9) & 1) << 5); R = (st >> 1) * 16 + swz / 64; C = (st & 1) * 32 + (swz % 64) / 2; }
__host__ __device__ __forceinline__ int perm32(int rho) { const int n = rho >> 4, i = rho & 15; return 8 * (i >> 2) + 4 * n + (i & 3); }

struct Unit { int pm, pn, aux, idx; };

struct GridOrder {
    int nM, nN, nwg, G, c;
    __device__ __forceinline__ void init(int nM_, int nN_, int G_, int c_) { nM = nM_; nN = nN_; nwg = nM * nN; G = G_; c = c_; }
    __device__ __forceinline__ bool tile(int i, int& pm, int& pn) const {
        const long L = (long)i * G + c; if (L >= nwg) return false;
        int wgid = (int)L; { const int q = nwg / NXCD, r = nwg % NXCD, xcd = wgid % NXCD, off = wgid / NXCD; wgid = (xcd < r ? xcd * (q + 1) : r * (q + 1) + (xcd - r) * q) + off; }
        const int nig = WGM * nN, gid = wgid / nig, fm = gid * WGM, gsz = (nM - fm) < WGM ? (nM - fm) : WGM;
        pm = fm + ((wgid % nig) % gsz); pn = (wgid % nig) / gsz; return true;
    }
};

typedef int v8i_t __attribute__((ext_vector_type(8)));
template <class Epi, class Sched, bool ALIGN_EPI, bool FP8 = false, bool GATHER = false>
__device__ __forceinline__ void gemm_phase(LAS unsigned char* lds, const int KB, const Sched& S, const Epi& E) {
    int tid = threadIdx.x; asm volatile("" : "+v"(tid));
    const int wid = __builtin_amdgcn_readfirstlane(tid >> 6), lane = tid & 63, wr = wid >> 2, wc = wid & 3, fr = lane & 15, fq = lane >> 4;
    const int nt = KB / (BK * 2);
    unsigned voffB[2], cvo[2][2], nvo[2][2]; int RA[2], CA[2];
    const size_t kstep = (size_t)(BK * 2);
    const size_t hstep = (size_t)HALF * KB;
#pragma unroll
    for (int i = 0; i < 2; ++i) { int R, C; stage_rc(tid * 16 + i * 8192, R, C); const int Rb = Epi::PERM ? ((R & ~31) + perm32(R & 31)) : R; RA[i] = R; CA[i] = C * 2;
        voffB[i] = (unsigned)(Rb * KB + C * 2);
#pragma unroll
        for (int h = 0; h < 2; ++h) { cvo[h][i] = GATHER ? 0u : (unsigned)(R * KB + C * 2) + (unsigned)(h * hstep); nvo[h][i] = cvo[h][i]; } }
    const unsigned ldsw = (unsigned)wid * 1024u;
    const int aoff = lds_byte(wr * 64 + fr, fq * 8), boff = lds_byte(wc * 32 + fr, fq * 8);
#define PG8_SA(b, h) (((b) * 2 + (h)) * HTB)
#define PG8_SB(b, h) ((4 + (b) * 2 + (h)) * HTB)
#define PG8_STAGE(bufoff, gbase, voff) do { _Pragma("unroll") for (int _i = 0; _i < 2; ++_i) \
        __builtin_amdgcn_global_load_lds((const unsigned*)((const char*)(gbase) + (voff)[_i]), (LAS unsigned*)(lds + (bufoff) + ldsw + _i * 8192), 16, 0, 0); } while (0)
#define PG8_LD32(off) __builtin_shufflevector(*(const LAS v4u*)(lds + (off)), *(const LAS v4u*)(lds + (off) + 1024), 0, 1, 2, 3, 4, 5, 6, 7)
#define PG8_LDA(dst, b, h) do { _Pragma("unroll") for (int m = 0; m < 4; ++m) { if constexpr (FP8) dst##8[m] = __builtin_bit_cast(v8i_t, PG8_LD32(PG8_SA(b, h) + aoff + m * 2048)); else { _Pragma("unroll") for (int k = 0; k < 2; ++k) dst[m][k] = *(const LAS bf16x8*)(lds + PG8_SA(b, h) + aoff + m * 2048 + k * 1024); } } } while (0)
#define PG8_LDB(dst, b, h) do { _Pragma("unroll") for (int n = 0; n < 2; ++n) { if constexpr (FP8) dst##8[n] = __builtin_bit_cast(v8i_t, PG8_LD32(PG8_SB(b, h) + boff + n * 2048)); else { _Pragma("unroll") for (int k = 0; k < 2; ++k) dst[n][k] = *(const LAS bf16x8*)(lds + PG8_SB(b, h) + boff + n * 2048 + k * 1024); } } } while (0)
#define PG8_CAT(x) __builtin_shufflevector(__builtin_bit_cast(v4u, (x)[0]), __builtin_bit_cast(v4u, (x)[1]), 0, 1, 2, 3, 4, 5, 6, 7)
#define PG8_MMA(ai, bj, At, Bt) do { __builtin_amdgcn_s_setprio(1); _Pragma("unroll") for (int m = 0; m < 4; ++m) _Pragma("unroll") for (int n = 0; n < 2; ++n) { \
        if constexpr (FP8) asm volatile("v_mfma_f32_16x16x128_f8f6f4 %0, %1, %2, %0" : "+v"(acc[ai][bj][m][n]) : "v"(Bt##8[n]), "v"(At##8[m])); \
        else { _Pragma("unroll") for (int k = 0; k < 2; ++k) acc[ai][bj][m][n] = __builtin_amdgcn_mfma_f32_16x16x32_bf16(Bt[n][k], At[m][k], acc[ai][bj][m][n], 0, 0, 0); } } \
        __builtin_amdgcn_s_setprio(0); } while (0)
#define PG8_WAIT_V(n) asm volatile("s_waitcnt vmcnt(" #n ")" ::: "memory")
#define PG8_WAIT_L(n) asm volatile("s_waitcnt lgkmcnt(" #n ")" ::: "memory")
#define PG8_BAR __builtin_amdgcn_s_barrier()
#define PG8_SCHED __builtin_amdgcn_sched_barrier(0)
#define PG8_ZERO() do { float zf_; asm volatile("v_mov_b32 %0, 0" : "=v"(zf_)); const f32x4 z4_ = {zf_, zf_, zf_, zf_}; _Pragma("unroll") for (int a = 0; a < 2; ++a) _Pragma("unroll") for (int b = 0; b < 2; ++b) _Pragma("unroll") for (int m = 0; m < 4; ++m) _Pragma("unroll") for (int n = 0; n < 2; ++n) acc[a][b][m][n] = z4_; } while (0)
    Unit cur, nxt; int ui = 0;
    if (!S.next(0, cur)) return;
    f32x4 acc[2][2][4][2];
    PG8_ZERO();
    bf16x8 At[4][2], B0[2][2], B1[2][2]; v8i_t At8[4], B08[2], B18[2];
    int sc1_ = 0x7f7f7f7f; asm volatile("" : "+v"(sc1_));
    const char* cA = S.opA(cur); const char* cB = S.opB(cur);
    if constexpr (GATHER) {
#pragma unroll
        for (int h = 0; h < 2; ++h)
#pragma unroll
            for (int i = 0; i < 2; ++i) { cvo[h][i] = S.goff(0, h * HALF + RA[i]) + (unsigned)CA[i]; nvo[h][i] = cvo[h][i]; } }
    PG8_STAGE(PG8_SB(0, 0), cB, voffB); PG8_STAGE(PG8_SB(0, 1), cB + hstep, voffB); PG8_STAGE(PG8_SA(0, 0), cA, cvo[0]); PG8_STAGE(PG8_SA(0, 1), cA, cvo[1]);
    if (wr == 1) PG8_BAR;
    PG8_WAIT_V(2); PG8_BAR;
    PG8_STAGE(PG8_SB(1, 0), cB + kstep, voffB); PG8_STAGE(PG8_SA(1, 0), cA + kstep, cvo[0]); PG8_STAGE(PG8_SB(1, 1), cB + hstep + kstep, voffB);
    PG8_WAIT_V(6); PG8_BAR;
    for (;;) {
        const bool has_next = S.next(ui + 1, nxt);
        const char* nA = has_next ? S.opA(nxt) : cA; const char* nB = has_next ? S.opB(nxt) : cB;
        if constexpr (GATHER) { if (has_next) {
#pragma unroll
            for (int h = 0; h < 2; ++h)
#pragma unroll
                for (int i = 0; i < 2; ++i) nvo[h][i] = S.goff(ui + 1, h * HALF + RA[i]) + (unsigned)CA[i]; } }
        for (int t = 0; t < nt; t += 2) {
            const bool last = (t == nt - 2);
            const char* a1 = cA + (size_t)(t + 1) * kstep;
            const char* a2 = last ? nA : cA + (size_t)(t + 2) * kstep; const char* b2 = last ? nB : cB + (size_t)(t + 2) * kstep;
            const char* a3 = a2 + kstep; const char* b3 = b2 + kstep;
            unsigned o2[2][2];
#pragma unroll
            for (int h = 0; h < 2; ++h)
#pragma unroll
                for (int i = 0; i < 2; ++i) o2[h][i] = (GATHER && last) ? nvo[h][i] : cvo[h][i];
            PG8_LDB(B0, 0, 0); PG8_LDB(B1, 0, 1); PG8_SCHED; PG8_LDA(At, 0, 0); PG8_STAGE(PG8_SA(1, 1), a1, cvo[1]);
            PG8_WAIT_V(8); PG8_WAIT_L(0); PG8_BAR; PG8_MMA(0, 0, At, B0); PG8_MMA(0, 1, At, B1); PG8_BAR; PG8_SCHED;
            PG8_LDA(At, 0, 1); PG8_STAGE(PG8_SB(0, 0), b2, voffB); PG8_STAGE(PG8_SB(0, 1), b2 + hstep, voffB); PG8_STAGE(PG8_SA(0, 0), a2, o2[0]);
            PG8_WAIT_V(8); PG8_WAIT_L(0); PG8_BAR; PG8_MMA(1, 0, At, B0); PG8_MMA(1, 1, At, B1); PG8_BAR; PG8_SCHED;
            PG8_LDB(B0, 1, 0); PG8_LDB(B1, 1, 1); PG8_SCHED; PG8_LDA(At, 1, 0); PG8_STAGE(PG8_SA(0, 1), a2, o2[1]);
            PG8_WAIT_V(8); PG8_WAIT_L(0); PG8_BAR; PG8_MMA(0, 0, At, B0); PG8_MMA(0, 1, At, B1); PG8_BAR; PG8_SCHED;
            PG8_LDA(At, 1, 1); PG8_STAGE(PG8_SB(1, 0), b3, voffB); PG8_STAGE(PG8_SB(1, 1), b3 + hstep, voffB); PG8_STAGE(PG8_SA(1, 0), a3, o2[0]);
            PG8_WAIT_V(8); PG8_WAIT_L(0); PG8_BAR; PG8_MMA(1, 0, At, B0); PG8_MMA(1, 1, At, B1); PG8_BAR; PG8_SCHED;
        }
        if constexpr (ALIGN_EPI) { if (wr == 0) PG8_BAR; }
        if constexpr (FP8) asm volatile("s_nop 15\n\ts_nop 15" ::: "memory");
        E(acc, cur, wr, wc, fr, fq);
        if (!has_next) break;
        if (!E.keep(cur)) PG8_ZERO();
        cur = nxt; cA = nA; cB = nB; ++ui;
        if constexpr (GATHER) {
#pragma unroll
            for (int h = 0; h < 2; ++h)
#pragma unroll
                for (int i = 0; i < 2; ++i) cvo[h][i] = nvo[h][i]; }
        if constexpr (ALIGN_EPI) { if (wr == 1) PG8_BAR; }
    }
    PG8_WAIT_V(0);
    if constexpr (!ALIGN_EPI) { if (wr == 0) PG8_BAR; }
    PG8_BAR;
#undef PG8_SA
#undef PG8_SB
#undef PG8_STAGE
#undef PG8_LDA
#undef PG8_LD32
#undef PG8_LDB
#undef PG8_MMA
#undef PG8_CAT
#undef PG8_WAIT_V
#undef PG8_WAIT_L
#undef PG8_BAR
#undef PG8_SCHED
#undef PG8_ZERO
}
}

namespace attn_body {
constexpr int D = 64, DMA_ = NH * D;
constexpr int NW = 8, QBLK = 32, QB = QBLK * NW, KVBLK = 64;
__device__ __forceinline__ int crow(int r, int hi) { return (r & 3) + 8 * (r >> 2) + 4 * hi; }
#define SBAR() __builtin_amdgcn_sched_barrier(0)
__device__ __forceinline__ void cmask(f32x16& p0, f32x16& p1, int jb, int qrel, int hi) {
  const float NEG = -INFINITY; int kb = 64 * jb + 4 * hi;
  #pragma unroll
  for (int r = 0; r < 16; ++r) { int kv = kb + (r & 3) + 8 * (r >> 2); if (kv > qrel) p0[r] = NEG; if (kv + 32 > qrel) p1[r] = NEG; }
}
constexpr int NSLOT = 3, SLOTB = 8192;
constexpr int LDS_K = 0, LDS_V = NSLOT * SLOTB, LDS_WS = 2 * NSLOT * SLOTB, LDS_OST = LDS_WS + NW * 64 * 4, LDS_BYTES = LDS_OST + NW * 4096;
constexpr int LDS_CS = LDS_BYTES, LDS_TOT = LDS_CS + KSEQ * 4, LDS_ALL = LDS_TOT + 256;
__device__ __forceinline__ void glds16(const void* gsrc, unsigned lds_dst) { unsigned keep;
  asm volatile("s_mov_b32 %0, m0\n\ts_mov_b32 m0, %2\n\ts_nop 0\n\tglobal_load_lds_dwordx4 %1, off\n\ts_mov_b32 m0, %0" : "=&s"(keep) : "v"(gsrc), "s"(lds_dst) : "memory"); }
__device__ __forceinline__ float max3f(float a, float b, float c) { float r; asm("v_max3_f32 %0, %1, %2, %3" : "=v"(r) : "v"(a), "v"(b), "v"(c)); return r; }
__device__ __forceinline__ float max2f(float a, float b) { float r; asm("v_max_f32_e32 %0, %1, %2" : "=v"(r) : "v"(a), "v"(b)); return r; }
__device__ __forceinline__ float fadd_s(float a, float b) { float r; asm("v_add_f32_e32 %0, %1, %2" : "=v"(r) : "v"(a), "v"(b)); return r; }
__device__ __forceinline__ float fsub_s(float a, float b) { float r; asm("v_sub_f32_e32 %0, %1, %2" : "=v"(r) : "v"(a), "v"(b)); return r; }
__device__ __forceinline__ unsigned cvtpk_s(float lo, float hi) { f32x2 v = {lo, hi}; bf16x2_t b = __builtin_convertvector(v, bf16x2_t); return __builtin_bit_cast(unsigned, b); }
#define WAIT_BAR(N) asm volatile("s_waitcnt vmcnt(" #N ") lgkmcnt(0)\n\ts_barrier" ::: "memory")

__device__ __forceinline__ void qkt(f32x16& p0, f32x16& p1, const char* Kslot, const bf16x8* qr, const f32x16& negm, int r32, int hi) {
  const char* kb = Kslot + hi * 1024 + r32 * 16;
  #pragma unroll
  for (int d0 = 0; d0 < 4; ++d0) {
    const bf16x8 b0 = *reinterpret_cast<const bf16x8*>(kb + d0 * 2048);
    const bf16x8 b1 = *reinterpret_cast<const bf16x8*>(kb + d0 * 2048 + 512);
    if (d0 == 0) { p0 = __builtin_amdgcn_mfma_f32_32x32x16_bf16(b0, qr[0], negm, 0, 0, 0); p1 = __builtin_amdgcn_mfma_f32_32x32x16_bf16(b1, qr[0], negm, 0, 0, 0); }
    else { p0 = __builtin_amdgcn_mfma_f32_32x32x16_bf16(b0, qr[d0], p0, 0, 0, 0); p1 = __builtin_amdgcn_mfma_f32_32x32x16_bf16(b1, qr[d0], p1, 0, 0, 0); } }
}
typedef LAS const char* lds_cptr;
typedef short v4i16_t __attribute__((ext_vector_type(4)));
__device__ __forceinline__ void kload8(bf16x8* kf, lds_cptr kp) {
  kf[0] = *(const LAS bf16x8*)(kp);        kf[1] = *(const LAS bf16x8*)(kp + 512);
  kf[2] = *(const LAS bf16x8*)(kp + 2048); kf[3] = *(const LAS bf16x8*)(kp + 2560);
  kf[4] = *(const LAS bf16x8*)(kp + 4096); kf[5] = *(const LAS bf16x8*)(kp + 4608);
  kf[6] = *(const LAS bf16x8*)(kp + 6144); kf[7] = *(const LAS bf16x8*)(kp + 6656);
}
__device__ __forceinline__ void kload2(bf16x8* kf, lds_cptr kp, int j) { kf[2 * j] = *(const LAS bf16x8*)(kp + j * 2048); kf[2 * j + 1] = *(const LAS bf16x8*)(kp + j * 2048 + 512); }
__device__ __forceinline__ s16x4 vtr(lds_cptr p) { return __builtin_bit_cast(s16x4, __builtin_amdgcn_ds_read_tr16_b64_v4i16((LAS v4i16_t*)p)); }
__device__ __forceinline__ float rowmax(const f32x16& p0, const f32x16& p1) {
  float a = max3f(p0[0], p0[1], p1[0]), b = max3f(p0[2], p0[3], p1[1]); a = max3f(a, p1[2], p1[3]);
  #pragma unroll
  for (int r = 4; r < 16; r += 4) { a = max3f(a, p0[r], p0[r + 1]); b = max3f(b, p0[r + 2], p0[r + 3]); a = max3f(a, p1[r], p1[r + 1]); b = max3f(b, p1[r + 2], p1[r + 3]); }
  const float m = max2f(a, b);
  auto rr = __builtin_amdgcn_permlane32_swap(__float_as_uint(m), __float_as_uint(m), false, false);
  return max2f(__uint_as_float(rr[0]), __uint_as_float(rr[1]));
}
__device__ __forceinline__ void pv(f32x16* o, int vb, bf16x8 pa0, bf16x8 pa1, bf16x8 pa2, bf16x8 pa3) {
  #pragma unroll
  for (int d0 = 0; d0 < 2; ++d0) { s16x4 lo[4], hi[4];
    #pragma unroll
    for (int ks = 0; ks < 4; ++ks) {
      asm volatile("ds_read_b64_tr_b16 %0,%1 offset:%c2" : "=&v"(lo[ks]) : "v"(vb), "i"(d0 * 4096 + ks * 1024) : "memory");
      asm volatile("ds_read_b64_tr_b16 %0,%1 offset:%c2" : "=&v"(hi[ks]) : "v"(vb), "i"(d0 * 4096 + ks * 1024 + 512) : "memory"); }
    asm volatile("s_waitcnt lgkmcnt(0)" ::: "memory"); SBAR();
    #define PK(k) (bf16x8){lo[k][0], lo[k][1], lo[k][2], lo[k][3], hi[k][0], hi[k][1], hi[k][2], hi[k][3]}
    o[d0] = __builtin_amdgcn_mfma_f32_32x32x16_bf16(pa0, PK(0), o[d0], 0, 0, 0);
    o[d0] = __builtin_amdgcn_mfma_f32_32x32x16_bf16(pa1, PK(1), o[d0], 0, 0, 0);
    o[d0] = __builtin_amdgcn_mfma_f32_32x32x16_bf16(pa2, PK(2), o[d0], 0, 0, 0);
    o[d0] = __builtin_amdgcn_mfma_f32_32x32x16_bf16(pa3, PK(3), o[d0], 0, 0, 0);
    #undef PK
  }
}
__device__ __forceinline__ void kbias(f32x16& p0, f32x16& p1, const LAS float* csl, int t, int hi) {
  const LAS f32x4* cb = (const LAS f32x4*)(csl + 64 * t + 4 * hi);
  #pragma unroll
  for (int g = 0; g < 4; ++g) { const f32x4 u0 = cb[2 * g], u1 = cb[8 + 2 * g];
    p0[4 * g + 0] -= u0[0]; p0[4 * g + 1] -= u0[1]; p0[4 * g + 2] -= u0[2]; p0[4 * g + 3] -= u0[3];
    p1[4 * g + 0] -= u1[0]; p1[4 * g + 1] -= u1[1]; p1[4 * g + 2] -= u1[2]; p1[4 * g + 3] -= u1[3]; }
}

template <int THRL> __device__ __forceinline__ void attn_unit(int b, int h, int qb, const __hip_bfloat16* Q, const __hip_bfloat16* __restrict__ K, const __hip_bfloat16* __restrict__ V, __hip_bfloat16* O, char* shm) {
  using bf16h = __hip_bfloat16;
  int tid = threadIdx.x; asm volatile("" : "+v"(tid));
  const int lane = tid & 63, r32 = lane & 31, hi = lane >> 5; const int wid = __builtin_amdgcn_readfirstlane(tid >> 6);
  const long rowbaseQ = (long)b * SEQ, rowbaseK = (long)b * KSEQ; const int q0 = qb * QB;
  const bf16h* Qw = Q + (rowbaseQ + q0 + wid * QBLK) * DMA_ + h * D;
  const bf16h* Kh = K + rowbaseK * DMA_ + h * D, *Vh = V + rowbaseK * DMA_ + h * D;
  const unsigned lds0 = (unsigned)(uintptr_t)shm;
  float* wsf = (float*)(shm + LDS_WS) + wid * 64;
  const LAS float* csl = (const LAS float*)((LAS const char*)shm + LDS_CS);
  const bf16h* ksrc = Kh + (long)lane * DMA_ + wid * 8;
  const bf16h* vsrc = Vh + (long)(16 * (wid & 3) + (lane >> 2)) * DMA_ + (wid >> 2) * 32 + (lane & 3) * 8;
  const unsigned kdst = lds0 + LDS_K + wid * 1024, vdst = lds0 + LDS_V + wid * 1024;
  #define DMA_K(t, slot) glds16(ksrc + (long)(t) * KVBLK * DMA_, (unsigned)__builtin_amdgcn_readfirstlane(kdst + (slot)))
  #define DMA_V(t, slot) glds16(vsrc + (long)(t) * KVBLK * DMA_, (unsigned)__builtin_amdgcn_readfirstlane(vdst + (slot)))
  const int vb0 = (int)(lds0 + LDS_V) + ((lane >> 4) & 1) * 32 + (lane & 3) * 8 + (4 * hi + ((lane & 15) >> 2)) * 64;
  const char* Kbase = shm + LDS_K; bf16x8 kf[8];
  const lds_cptr shm3 = (lds_cptr)shm; const lds_cptr kp0 = shm3 + LDS_K + hi * 1024 + r32 * 16; const lds_cptr vp0 = shm3 + LDS_V + ((lane >> 4) & 1) * 32 + (lane & 3) * 8 + (4 * hi + ((lane & 15) >> 2)) * 64;
  const int NT = (q0 + QB) / KVBLK + 1;
  DMA_K(0, 0); DMA_V(0, 0); DMA_K(1, SLOTB);
  bf16x8 qr[4];
  #pragma unroll
  for (int d0 = 0; d0 < 4; ++d0) qr[d0] = *reinterpret_cast<const bf16x8*>(&Qw[(long)r32 * DMA_ + d0 * 16 + hi * 8]);
  const float cq = csl[64 + q0 + wid * QBLK + r32];
  float mhat = 0.f, l_reg = 0.f; f32x16 o[2]; o[0] = f32x16{}; o[1] = f32x16{}; f32x16 negm;
  #pragma unroll
  for (int r = 0; r < 16; ++r) negm[r] = cq;
  asm volatile("" : "+v"(negm));
  const int qrel = wid * QBLK + r32;
  #define CMASK(P0, P1, t) do { int jb_ = (t) - (NT - 4); if (jb_ >= 0) cmask(P0, P1, jb_, qrel, hi); } while (0)
  bool resc = false;
  #define START(P0, P1) do { const float rm = rowmax(P0, P1); resc = false; \
    { const float dl = rm; mhat = fadd_s(mhat, dl); \
      _Pragma("unroll") for (int r = 0; r < 16; ++r) { P0[r] = fsub_s(P0[r], dl); P1[r] = fsub_s(P1[r], dl); } \
      _Pragma("unroll") for (int r = 0; r < 16; ++r) negm[r] = cq - mhat; asm volatile("" : "+v"(negm)); } \
    _Pragma("unroll") for (int r = 0; r < 16; ++r) P0[r] = __builtin_amdgcn_exp2f(P0[r]); } while (0)
  #define RESC() do { if (resc) { asm volatile("s_waitcnt lgkmcnt(0)" ::: "memory"); \
      _Pragma("unroll") for (int d_ = 0; d_ < 2; ++d_) _Pragma("unroll") for (int r = 0; r < 16; ++r) o[d_][r] *= wsf[crow(r, hi)]; } } while (0)
  f32x16 pA0, pA1, pB0, pB1;
  int sl_prev = 0, sl_cur = 0, sl_next = SLOTB;
  #define ROT() do { sl_prev = sl_cur; sl_cur = sl_next; sl_next = (sl_next == (NSLOT - 1) * SLOTB) ? 0 : sl_next + SLOTB; } while (0)
  DMA_K(2, 2 * SLOTB);
  WAIT_BAR(3);
  qkt(pA0, pA1, Kbase, qr, negm, r32, hi); asm volatile("s_nop 15\n\ts_nop 7" : "+v"(pA0), "+v"(pA1)); kbias(pA0, pA1, csl, 0, hi);
  START(pA0, pA1);
  _Pragma("unroll") for (int r = 0; r < 16; ++r) pA1[r] = __builtin_amdgcn_exp2f(pA1[r]);
  WAIT_BAR(0);
  DMA_K(3, 0); DMA_V(1, SLOTB);
  ROT();
  kload8(kf, kp0 + sl_cur);
  WAIT_BAR(2);
  s16x4 vlo[8], vhi[8]; v4u pw0, pw1, pw2, pw3;
  #define PKW(P, B) cvtpk_s(P[B], P[B + 1])
  #define PAF(k) __builtin_bit_cast(bf16x8, pw##k)
  #define VFR(i) (bf16x8){vlo[i][0], vlo[i][1], vlo[i][2], vlo[i][3], vhi[i][0], vhi[i][1], vhi[i][2], vhi[i][3]}
  #define PIN(x) asm volatile("" : "+v"(x))
  #define MX3(a, b, c) __builtin_fmaxf(__builtin_fmaxf((a), (b)), (c))
  #define GAPA(MF, A0, A1, A2, A3, W0, W1, PW) do { MF; sacc += A0; sacc += A1; sacc += A2; sacc += A3; PIN(sacc); W0; W1; PIN(PW); SBAR(); } while (0)
  #define EX(v) __builtin_amdgcn_exp2f(v)
  #define GAPB(MF, X, B) do { MF; X[B] = EX(X[B]); X[B + 1] = EX(X[B + 1]); X[B + 2] = EX(X[B + 2]); X[B + 3] = EX(X[B + 3]); PIN(X); SBAR(); } while (0)
  #define VRD(i) do { vlo[i] = vtr(vp_ + (((i) >> 2) * 4096 + ((i) & 3) * 1024)); vhi[i] = vtr(vp_ + (((i) >> 2) * 4096 + ((i) & 3) * 1024 + 512)); } while (0)
  #define KRD(G, j) do { if (G) { kload2(kf, kp0 + sl_next, j); SBAR(); } } while (0)
  #define STEP(C0, C1, P0, P1, t, GK, GV, GL) do { SBAR(); \
    const lds_cptr vp_ = vp0 + sl_prev; \
    VRD(0); SBAR(); float sacc = (P0[0] + P0[1]); \
    GAPA(C0 = __builtin_amdgcn_mfma_f32_32x32x16_bf16(kf[0], qr[0], negm, 0, 0, 0), P0[2], P0[3], P0[4], P0[5],     pw0[0] = PKW(P0, 0), pw0[1] = PKW(P0, 2), pw0); \
    VRD(4); SBAR(); GAPA(C1 = __builtin_amdgcn_mfma_f32_32x32x16_bf16(kf[1], qr[0], negm, 0, 0, 0), P0[6], P0[7], P0[8], P0[9],     pw0[2] = PKW(P0, 4), pw0[3] = PKW(P0, 6), pw0); \
    VRD(1); SBAR(); GAPA(C0 = __builtin_amdgcn_mfma_f32_32x32x16_bf16(kf[2], qr[1], C0, 0, 0, 0),   P0[10], P0[11], P0[12], P0[13], pw1[0] = PKW(P0, 8), pw1[1] = PKW(P0, 10), pw1); \
    VRD(5); SBAR(); GAPA(C1 = __builtin_amdgcn_mfma_f32_32x32x16_bf16(kf[3], qr[1], C1, 0, 0, 0),   P0[14], P0[15], P1[0], P1[1],   pw1[2] = PKW(P0, 12), pw1[3] = PKW(P0, 14), pw1); \
    VRD(2); SBAR(); GAPA(C0 = __builtin_amdgcn_mfma_f32_32x32x16_bf16(kf[4], qr[2], C0, 0, 0, 0),   P1[2], P1[3], P1[4], P1[5],     pw2[0] = PKW(P1, 0), pw2[1] = PKW(P1, 2), pw2); \
    VRD(6); SBAR(); GAPA(C1 = __builtin_amdgcn_mfma_f32_32x32x16_bf16(kf[5], qr[2], C1, 0, 0, 0),   P1[6], P1[7], P1[8], P1[9],     pw2[2] = PKW(P1, 4), pw2[3] = PKW(P1, 6), pw2); \
    VRD(3); SBAR(); GAPA(C0 = __builtin_amdgcn_mfma_f32_32x32x16_bf16(kf[6], qr[3], C0, 0, 0, 0),   P1[10], P1[11], P1[12], P1[13], pw3[0] = PKW(P1, 8), pw3[1] = PKW(P1, 10), pw3); \
    VRD(7); SBAR(); GAPA(C1 = __builtin_amdgcn_mfma_f32_32x32x16_bf16(kf[7], qr[3], C1, 0, 0, 0),   P1[14], P1[15], 0.f, 0.f,       pw3[2] = PKW(P1, 12), pw3[3] = PKW(P1, 14), pw3); \
    l_reg += sacc; \
    if (GK) { DMA_K((t) + 3, sl_cur); } if (GV) { DMA_V((t) + 1, sl_next); } \
    kbias(C0, C1, csl, (t), hi); \
    CMASK(C0, C1, t); \
    { float a = MX3(C0[0], C0[1], C1[0]), b = MX3(C0[2], C0[3], C1[1]); a = MX3(a, C1[2], C1[3]); \
      _Pragma("unroll") for (int r = 4; r < 16; r += 4) { a = MX3(a, C0[r], C0[r + 1]); b = MX3(b, C0[r + 2], C0[r + 3]); a = MX3(a, C1[r], C1[r + 1]); b = MX3(b, C1[r + 2], C1[r + 3]); } \
      float rm = __builtin_fmaxf(a, b); { auto rr = __builtin_amdgcn_permlane32_swap(__float_as_uint(rm), __float_as_uint(rm), false, false); rm = __builtin_fmaxf(__uint_as_float(rr[0]), __uint_as_float(rr[1])); } \
      resc = false; \
      if (__builtin_expect(__any(rm > (float)THRL), 0)) { const float dl = __builtin_fmaxf(rm, 0.f); mhat += dl; \
        _Pragma("unroll") for (int r = 0; r < 16; ++r) { C0[r] -= dl; C1[r] -= dl; } \
        _Pragma("unroll") for (int r = 0; r < 16; ++r) negm[r] = cq - mhat; asm volatile("" : "+v"(negm)); \
        const float f = __builtin_amdgcn_exp2f(-dl); l_reg *= f; if (hi == 0) wsf[r32] = f; resc = true; } } \
    SBAR(); \
    GAPB(o[0] = __builtin_amdgcn_mfma_f32_32x32x16_bf16(PAF(0), VFR(0), o[0], 0, 0, 0), C0, 0); \
    GAPB(o[1] = __builtin_amdgcn_mfma_f32_32x32x16_bf16(PAF(0), VFR(4), o[1], 0, 0, 0), C0, 4); \
    KRD(GL, 0); GAPB(o[0] = __builtin_amdgcn_mfma_f32_32x32x16_bf16(PAF(1), VFR(1), o[0], 0, 0, 0), C0, 8); \
    KRD(GL, 1); GAPB(o[1] = __builtin_amdgcn_mfma_f32_32x32x16_bf16(PAF(1), VFR(5), o[1], 0, 0, 0), C0, 12); \
    KRD(GL, 2); GAPB(o[0] = __builtin_amdgcn_mfma_f32_32x32x16_bf16(PAF(2), VFR(2), o[0], 0, 0, 0), C1, 0); \
    KRD(GL, 3); GAPB(o[1] = __builtin_amdgcn_mfma_f32_32x32x16_bf16(PAF(2), VFR(6), o[1], 0, 0, 0), C1, 4); \
    GAPB(o[0] = __builtin_amdgcn_mfma_f32_32x32x16_bf16(PAF(3), VFR(3), o[0], 0, 0, 0), C1, 8); \
    GAPB(o[1] = __builtin_amdgcn_mfma_f32_32x32x16_bf16(PAF(3), VFR(7), o[1], 0, 0, 0), C1, 12); \
    } while (0)
  int t = 1;
  #undef CMASK
  #define CMASK(P0, P1, t) do {} while (0)
  for (; t + 5 < NT; t += 2) {
    STEP(pB0, pB1, pA0, pA1, t, true, true, true);     WAIT_BAR(2); RESC(); ROT();
    STEP(pA0, pA1, pB0, pB1, t + 1, true, true, true); WAIT_BAR(2); RESC(); ROT();
  }
  #undef CMASK
  #define CMASK(P0, P1, t) do { int jb_ = (t) - (NT - 4); if (jb_ >= 0) cmask(P0, P1, jb_, qrel, hi); } while (0)
  #define ENDW(tt) do { if ((tt) + 3 < NT) { WAIT_BAR(2); } else if ((tt) + 2 < NT) { WAIT_BAR(1); } else { WAIT_BAR(0); } } while (0)
  for (; t + 1 < NT; t += 2) {
    STEP(pB0, pB1, pA0, pA1, t, (t + 3 < NT), (t + 1 < NT), (t + 1 < NT));       ENDW(t);     RESC(); ROT();
    STEP(pA0, pA1, pB0, pB1, t + 1, (t + 4 < NT), (t + 2 < NT), (t + 2 < NT));   ENDW(t + 1); RESC(); ROT();
  }
  { float sacc = pA0[0] + pA0[1]; _Pragma("unroll") for (int r = 2; r < 16; ++r) sacc += pA0[r]; _Pragma("unroll") for (int r = 0; r < 16; ++r) sacc += pA1[r]; l_reg += sacc;
    pw0 = (v4u){PKW(pA0, 0), PKW(pA0, 2), PKW(pA0, 4), PKW(pA0, 6)}; pw1 = (v4u){PKW(pA0, 8), PKW(pA0, 10), PKW(pA0, 12), PKW(pA0, 14)}; pw2 = (v4u){PKW(pA1, 0), PKW(pA1, 2), PKW(pA1, 4), PKW(pA1, 6)}; pw3 = (v4u){PKW(pA1, 8), PKW(pA1, 10), PKW(pA1, 12), PKW(pA1, 14)};
    SBAR(); pv(o, vb0 + sl_prev, PAF(0), PAF(1), PAF(2), PAF(3)); }
  #undef PKW
  #undef PAF
  #undef VFR
  #undef PIN
  #undef MX3
  #undef GAPA
  #undef GAPB
  #undef EX
  #undef VRD
  #undef KRD
  #undef STEP
  #undef ENDW
  { auto rr = __builtin_amdgcn_permlane32_swap(__float_as_uint(l_reg), __float_as_uint(l_reg), false, false); l_reg = __uint_as_float(rr[0]) + __uint_as_float(rr[1]); }
  if (hi == 0) wsf[32 + r32] = l_reg; asm volatile("s_waitcnt lgkmcnt(0)" ::: "memory");
  float rli[16];
  #pragma unroll
  for (int r = 0; r < 16; ++r) rli[r] = __builtin_amdgcn_rcpf(wsf[32 + crow(r, hi)]);
  bf16h* Ow = O + (rowbaseQ + q0 + wid * QBLK) * DMA_ + h * D;
  { bf16h* stg = (bf16h*)(shm + LDS_OST) + wid * 2048;
    #pragma unroll
    for (int r = 0; r < 16; ++r) { const int orow = crow(r, hi);
      #pragma unroll
      for (int d0 = 0; d0 < 2; ++d0) stg[orow * 64 + d0 * 32 + r32] = __float2bfloat16(o[d0][r] * rli[r]); }
    asm volatile("s_waitcnt lgkmcnt(0)" ::: "memory");
    #pragma unroll
    for (int i = 0; i < 4; ++i) { const int row = i * 8 + (lane >> 3), ch = lane & 7; const v4u v = *(const v4u*)(stg + row * 64 + ch * 8); *(v4u*)(Ow + (long)row * DMA_ + ch * 8) = v; } }
  asm volatile("s_waitcnt lgkmcnt(0)\n\ts_barrier" ::: "memory");
  #undef DMA_K
  #undef DMA_V
  #undef CMASK
  #undef START
  #undef RESC
  #undef ROT
}
#undef SBAR
#undef WAIT_BAR
}

#define XB_TMO      128
#define XB_XCNT(j)  (256  + 64 * (j))
#define XB_XSUB(j)  (1280 + 64 * (j))
#define XB_XGEN(j)  (2304 + 64 * (j))
#define XB_TOP      3328
#define XB_TOPGEN   3392
#define XCD_BAR_WORDS 3456
#define XB_SPIN_CAP (1u << 18)
__device__ __forceinline__ unsigned xb_ld(unsigned* p)              { return __hip_atomic_load(p, __ATOMIC_RELAXED, __HIP_MEMORY_SCOPE_AGENT); }
__device__ __forceinline__ unsigned xb_add(unsigned* p, unsigned v) { return __hip_atomic_fetch_add(p, v, __ATOMIC_RELAXED, __HIP_MEMORY_SCOPE_AGENT); }
__device__ __forceinline__ unsigned xb_xcc_id() { return (unsigned)__builtin_amdgcn_s_getreg((3 << 11) | 20) & 0xFu; }
#define XB_SPIN(cond, bar) do { unsigned _sp = 0; while (cond) { __builtin_amdgcn_s_sleep(1); \
    if ((++_sp & 255u) == 0u) { if (xb_ld(&(bar)[XB_TMO])) break; if (_sp > XB_SPIN_CAP) { atomicAdd(&(bar)[XB_TMO], 1u); break; } } } } while (0)
struct XcdBarrier { unsigned* bar; unsigned x; volatile LAS unsigned* st; };
__device__ __forceinline__ XcdBarrier xcd_barrier_post(unsigned* bar, volatile LAS unsigned* st) {
    XcdBarrier b; b.bar = bar; b.x = xb_xcc_id(); b.st = st;
    if (threadIdx.x == 0) (void)xb_add(&bar[XB_XCNT(b.x)], 1u);
    return b;
}
__device__ __forceinline__ void xcd_barrier_complete(unsigned* bar, unsigned x, unsigned& nloc, unsigned& nx) {
    const unsigned G = gridDim.x * gridDim.y * gridDim.z;
    unsigned sum, cnt, mine, sp = 0u;
    for (;;) {
        sum = 0u; cnt = 0u; mine = 0u;
#pragma unroll
        for (unsigned j = 0; j < 16; ++j) { const unsigned c = xb_ld(&bar[XB_XCNT(j)]); sum += c; cnt += (c > 0u) ? 1u : 0u; mine = (j == x) ? c : mine; }
        if (sum == G) break;
        __builtin_amdgcn_s_sleep(1);
        if ((++sp & 255u) == 0u) { if (xb_ld(&bar[XB_TMO])) break; if (sp > XB_SPIN_CAP) { atomicAdd(&bar[XB_TMO], 1u); break; } }
    }
    nloc = mine > 0u ? mine : 1u; nx = cnt > 0u ? cnt : 1u;
}
__device__ __forceinline__ void xcd_barrier(const XcdBarrier& b) {
    asm volatile("s_waitcnt vmcnt(0)" ::: "memory");
    __syncthreads();
    if (threadIdx.x == 0) {
        unsigned* bar = b.bar;
        __builtin_amdgcn_s_waitcnt(0);
        unsigned nloc = b.st[0], nx = b.st[1];
        if (nloc == 0u) { xcd_barrier_complete(bar, b.x, nloc, nx); b.st[0] = nloc; b.st[1] = nx; }
        const unsigned old = xb_add(&bar[XB_XSUB(b.x)], 1u);
        const unsigned gen = old / nloc;
        if (old + 1u == (gen + 1u) * nloc) {
            __builtin_amdgcn_fence(__ATOMIC_RELEASE, "agent");
            asm volatile("s_waitcnt vmcnt(0)" ::: "memory");
            const unsigned og = xb_add(&bar[XB_TOP], 1u);
            const unsigned tg = og / nx;
            if (og + 1u == (tg + 1u) * nx) xb_add(&bar[XB_TOPGEN], 1u);
            else XB_SPIN(xb_ld(&bar[XB_TOPGEN]) == tg, bar);
            __builtin_amdgcn_fence(__ATOMIC_ACQUIRE, "agent");
            xb_add(&bar[XB_XGEN(b.x)], 1u);
            asm volatile("s_waitcnt vmcnt(0)" ::: "memory");
        } else {
            XB_SPIN(xb_ld(&bar[XB_XGEN(b.x)]) == gen, bar);
            __builtin_amdgcn_fence(__ATOMIC_ACQUIRE, "agent");
            asm volatile("s_waitcnt vmcnt(0)" ::: "memory");
        }
    }
    __syncthreads();
}

constexpr int RING_OFF = 0, RING_BYTES = 131072;
constexpr int MISC_OFF = RING_BYTES;
constexpr int TAB_OFF = MISC_OFF + 512;
constexpr int GTAB_OFF = TAB_OFF + 512, GTAB_UNITS = 4;
constexpr int RSTAB_OFF = GTAB_OFF + GTAB_UNITS * 1024;
constexpr int LDS_BYTES = RING_BYTES + 12288;
static_assert(RSTAB_OFF + GTAB_UNITS * 1024 <= LDS_BYTES && (MAXT * 6 + 255) / 256 <= GTAB_UNITS, "LDS map");
constexpr int NWAVES = 8;

struct Frame {
    LAS unsigned char* lds;
    volatile LAS unsigned* MISC;
    gu32* ctl;
    int tid, lane, wave, vcu, G, gw, NGW;
    unsigned char* ws;
    const float* const* in;
};
#define WSP(T, off) ((T*)(F.ws + (off)))
#define OPAQUE_IDS() int tid_ = F.tid; asm volatile("" : "+v"(tid_)); const int lane_ = tid_ & 63; const int wave_ = __builtin_amdgcn_readfirstlane(tid_ >> 6); (void)lane_; (void)wave_

__device__ __forceinline__ f32x4 mm16(const bf16* X, size_t ldx, const bf16* Y, size_t ldy, int K, f32x4 acc, int lane) {
    const int r = lane & 15, kg = lane >> 4;
    const GAS bf16* xp = (const GAS bf16*)X + (size_t)r * ldx + kg * 8; const GAS bf16* yp = (const GAS bf16*)Y + (size_t)r * ldy + kg * 8;
#pragma unroll 1
    for (int k = 0; k < K; k += 256) {
        bf16x8 xa[8], ya[8];
#pragma unroll
        for (int s = 0; s < 8; ++s) { xa[s] = *(const GAS bf16x8*)(xp + k + 32 * s); ya[s] = *(const GAS bf16x8*)(yp + k + 32 * s); }
#pragma unroll
        for (int s = 0; s < 8; ++s) acc = __builtin_amdgcn_mfma_f32_16x16x32_bf16(xa[s], ya[s], acc, 0, 0, 0);
    }
    return acc;
}

__device__ __forceinline__ f32x4 mm16_gram(const bf16* X, size_t ldx, const bf16* Y, size_t ldy, int K, f32x4 acc, f32x4& gram, int lane) {
    const int r = lane & 15, kg = lane >> 4;
    const GAS bf16* xp = (const GAS bf16*)X + (size_t)r * ldx + kg * 8; const GAS bf16* yp = (const GAS bf16*)Y + (size_t)r * ldy + kg * 8;
#pragma unroll 1
    for (int k = 0; k < K; k += 256) {
        bf16x8 xa[8], ya[8];
#pragma unroll
        for (int s = 0; s < 8; ++s) { xa[s] = *(const GAS bf16x8*)(xp + k + 32 * s); ya[s] = *(const GAS bf16x8*)(yp + k + 32 * s); }
#pragma unroll
        for (int s = 0; s < 8; ++s) { acc = __builtin_amdgcn_mfma_f32_16x16x32_bf16(xa[s], ya[s], acc, 0, 0, 0); gram = __builtin_amdgcn_mfma_f32_16x16x32_bf16(ya[s], ya[s], gram, 0, 0, 0); }
    }
    return acc;
}
__device__ __forceinline__ f32x4 mm16_f8(const unsigned char* X, size_t ldx, const unsigned char* Y, size_t ldy, int K, f32x4 acc, int lane) {
    const int r = lane & 15, kg = lane >> 4;
    const GAS unsigned char* xp = (const GAS unsigned char*)X + (size_t)r * ldx + kg * 32; const GAS unsigned char* yp = (const GAS unsigned char*)Y + (size_t)r * ldy + kg * 32;
#pragma unroll 1
    for (int k = 0; k < K; k += 512) {
        pg8::v8i_t xa[4], ya[4];
#pragma unroll
        for (int s = 0; s < 4; ++s) { xa[s] = *(const GAS pg8::v8i_t*)(xp + k + 128 * s); ya[s] = *(const GAS pg8::v8i_t*)(yp + k + 128 * s); }
#pragma unroll
        for (int s = 0; s < 4; ++s) acc = __builtin_amdgcn_mfma_scale_f32_16x16x128_f8f6f4(xa[s], ya[s], acc, 0, 0, 0, 0x7f7f7f7f, 0, 0x7f7f7f7f);
    }
    return acc;
}

template <int NX, int NY, int BS, bool GRAM>
__device__ __forceinline__ void skinny_slice(const bf16* X, size_t ldx, size_t xstride, const bf16* Y, size_t ldy, size_t ystride, int k0, int nsteps, f32x4 (&acc)[NX * NY], f32x4 (&gram)[NY], int lane) {
    const int r = lane & 15, kg = lane >> 4;
    const GAS bf16* xp = (const GAS bf16*)X + (size_t)r * ldx + k0 + kg * 8; const GAS bf16* yp = (const GAS bf16*)Y + (size_t)r * ldy + k0 + kg * 8;
#pragma unroll 1
    for (int s0 = 0; s0 < nsteps; s0 += BS) {
        bf16x8 xa[BS][NX], ya[BS][NY];
#pragma unroll
        for (int s = 0; s < BS; ++s) {
#pragma unroll
            for (int x = 0; x < NX; ++x) xa[s][x] = *(const GAS bf16x8*)(xp + x * xstride + (s0 + s) * 32);
#pragma unroll
            for (int y = 0; y < NY; ++y) ya[s][y] = *(const GAS bf16x8*)(yp + y * ystride + (s0 + s) * 32); }
#pragma unroll
        for (int s = 0; s < BS; ++s)
#pragma unroll
            for (int y = 0; y < NY; ++y) {
#pragma unroll
                for (int x = 0; x < NX; ++x) acc[x * NY + y] = __builtin_amdgcn_mfma_f32_16x16x32_bf16(xa[s][x], ya[s][y], acc[x * NY + y], 0, 0, 0);
                if (GRAM) gram[y] = __builtin_amdgcn_mfma_f32_16x16x32_bf16(ya[s][y], ya[s][y], gram[y], 0, 0, 0); }
    }
}
template <int NACC> __device__ __forceinline__ void put_part(LAS f32x4* part, const f32x4* v, int n, int base, int wave, int lane) {
#pragma unroll
    for (int a = 0; a < n; ++a) part[(wave * NACC + base + a) * 64 + lane] = v[a];
}
template <int NACC> __device__ __forceinline__ f32x4 sum_part(const LAS f32x4* part, int a, int lane) {
    f32x4 t = part[a * 64 + lane];
#pragma unroll
    for (int w = 1; w < NWAVES; ++w) t += part[(w * NACC + a) * 64 + lane];
    return t;
}

__device__ __forceinline__ void transpose_item(const float* W, size_t ldw, int K, bf16* WT, int csrc, int drow, int k0, LAS float* scr, int lane, const float* kgain = nullptr) {
    const GAS float* Wg = (const GAS float*)W;
    const int c = lane & 7;
    f32x4 g0 = {1.f, 1.f, 1.f, 1.f}, g1 = g0;
    if (kgain) { g0 = *(const GAS f32x4*)(kgain + k0 + 8 * c); g1 = *(const GAS f32x4*)(kgain + k0 + 8 * c + 4); }
#pragma unroll
    for (int i = 0; i < 32; ++i) { const int kk = 2 * i + (lane >> 5); scr[kk * 33 + (lane & 31)] = Wg[(size_t)(k0 + kk) * ldw + csrc + (lane & 31)]; }
    LDS_WAIT(); asm volatile("" ::: "memory");
#pragma unroll
    for (int j = 0; j < 4; ++j) { const int n = (lane >> 3) + 8 * j; const LAS float* s = scr + (8 * c) * 33 + n;
        v4u o; o.x = cvt_pk_bf16(s[0 * 33] * g0[0], s[1 * 33] * g0[1]); o.y = cvt_pk_bf16(s[2 * 33] * g0[2], s[3 * 33] * g0[3]); o.z = cvt_pk_bf16(s[4 * 33] * g1[0], s[5 * 33] * g1[1]); o.w = cvt_pk_bf16(s[6 * 33] * g1[2], s[7 * 33] * g1[3]);
        *(GAS v4u*)(WT + (size_t)(drow + n) * K + k0 + 8 * c) = o; }
    LDS_WAIT(); asm volatile("" ::: "memory");
}
__device__ __forceinline__ unsigned pk4_fp8(float a, float b, float c, float d) { int p = __builtin_amdgcn_cvt_pk_fp8_f32(a, b, 0, false); p = __builtin_amdgcn_cvt_pk_fp8_f32(c, d, p, true); return (unsigned)p; }
__device__ __forceinline__ void transpose_item_f8(const float* W, size_t ldw, int K, unsigned char* WT8, int csrc, int drow, int k0, LAS float* scr, int lane, float scale) {
    const GAS float* Wg = (const GAS float*)W;
#pragma unroll
    for (int i = 0; i < 32; ++i) { const int kk = 2 * i + (lane >> 5); scr[kk * 33 + (lane & 31)] = Wg[(size_t)(k0 + kk) * ldw + csrc + (lane & 31)] * scale; }
    LDS_WAIT(); asm volatile("" ::: "memory");
    const int c = lane & 3;
#pragma unroll
    for (int j = 0; j < 2; ++j) { const int n = (lane >> 2) + 16 * j; const LAS float* s = scr + (16 * c) * 33 + n;
        v4u o; o.x = pk4_fp8(s[0 * 33], s[1 * 33], s[2 * 33], s[3 * 33]); o.y = pk4_fp8(s[4 * 33], s[5 * 33], s[6 * 33], s[7 * 33]);
        o.z = pk4_fp8(s[8 * 33], s[9 * 33], s[10 * 33], s[11 * 33]); o.w = pk4_fp8(s[12 * 33], s[13 * 33], s[14 * 33], s[15 * 33]);
        *(GAS v4u*)(WT8 + (size_t)(drow + n) * K + k0 + 16 * c) = o; }
    LDS_WAIT(); asm volatile("" ::: "memory");
}
constexpr int IT_INA = 32 * 96, IT_INB = 32 * 192, IT_AO = 16 * 64, IT_CO = 16 * 64, IT_O = 32 * 64, IT_GU1 = 32 * 48, IT_GU = NE * IT_GU1, IT_DN1 = 12 * 64, IT_DN = NE * IT_DN1;
constexpr int IT_LAYER = IT_INA + IT_INB + IT_AO + IT_CO + IT_O + IT_GU + IT_DN;
__device__ __forceinline__ void p0_convert(Frame& F) {
    OPAQUE_IDS();
    LAS float* scr = (LAS float*)(F.lds + RING_OFF + wave_ * 16384);
    for (int it = F.gw; it < DEPTH * IT_LAYER; it += F.NGW) {
        const int l = it / IT_LAYER; int r = it % IT_LAYER;
        unsigned char* wl = F.ws + WS_W + (size_t)l * W_LSTRIDE;
        if (r < IT_INA) { const int kb = r / 96, nb = r % 96;
#if QK_BF16
            if (nb < 64) transpose_item(F.in[3] + (size_t)l * DM * INCOLS, INCOLS, DM, (bf16*)(wl + WO_IN16), 32 * nb, 32 * nb, 64 * kb, scr, lane_);
#endif
            transpose_item_f8(F.in[3] + (size_t)l * DM * INCOLS, INCOLS, DM, wl + WO_IN, 32 * nb, 32 * nb, 64 * kb, scr, lane_, W8S); continue; } r -= IT_INA;
        if (r < IT_INB) { const int kb = r / 192, nb = r % 192, c = 32 * nb; int drow;
            if (c < 2048) drow = 3072 + ((c & 1023) >> 7) * 256 + (c >> 10) * 128 + (c & 127); else drow = 5120 + (c - 2048);
            transpose_item_f8(F.in[3] + (size_t)l * DM * INCOLS, INCOLS, DM, wl + WO_IN, 3088 + c, drow, 64 * kb, scr, lane_, W8S); continue; } r -= IT_INB;
        if (r < IT_AO) { const int kb = r / 64, nb = r % 64; transpose_item(F.in[5] + (size_t)l * ATTW * DM, DM, ATTW, (bf16*)(wl + WO_AO), 32 * nb, 32 * nb, 64 * kb, scr, lane_); continue; } r -= IT_AO;
        if (r < IT_CO) { const int kb = r / 64, nb = r % 64; transpose_item(F.in[10] + (size_t)l * CONVC * DM, DM, CONVC, (bf16*)(wl + WO_CO), 32 * nb, 32 * nb, 64 * kb, scr, lane_); continue; } r -= IT_CO;
        if (r < IT_O) { const int kb = r / 64, nb = r % 64; transpose_item(F.in[11] + (size_t)l * DM * DM, DM, DM, (bf16*)(wl + WO_O), 32 * nb, 32 * nb, 64 * kb, scr, lane_); continue; } r -= IT_O;
        if (r < IT_GU) { const int e = r / IT_GU1, q = r % IT_GU1, kb = q / 48, nb = q % 48, c = 32 * nb; int drow;
            if (c < DE) drow = (c >> 7) * 256 + (c & 127); else drow = ((c - DE) >> 7) * 256 + 128 + ((c - DE) & 127);
            transpose_item(F.in[17] + ((size_t)l * NE + e) * DM * (2 * DE), 2 * DE, DM, (bf16*)(wl + WO_GU) + (size_t)e * (2 * DE) * DM, c, drow, 64 * kb, scr, lane_, F.in[12] + (size_t)l * DM); continue; } r -= IT_GU;
        { const int e = r / IT_DN1, q = r % IT_DN1, kb = q / 64, nb = q % 64;
            transpose_item(F.in[18] + ((size_t)l * NE + e) * DE * DM, DM, DE, (bf16*)(wl + WO_DN) + (size_t)e * DM * DE, 32 * nb, 32 * nb, 64 * kb, scr, lane_); }
    }
    const int gt = F.vcu * 512 + tid_, NGT = F.G * 512;
    bf16* WfT = WSP(bf16, WS_WF); bf16* WrT = WSP(bf16, WS_WR);
    for (int i = gt; i < DEPTH * 16 * DM; i += NGT) { const int l = i / (16 * DM), h = (i / DM) % 16, k = i % DM;
        WfT[i] = (bf16)(cvt_pk_bf16(F.in[3][((size_t)l * DM + k) * INCOLS + 3072 + h], 0.f) & 0xffffu); }
    for (int i = gt; i < DEPTH * 48 * DM; i += NGT) { const int l = i / (48 * DM), c = (i / DM) % 48, k = i % DM; float v = 0.f;
        if (c < NGRP) v = F.in[13][((size_t)l * DM + k) * NGRP + c]; else if (c < NGRP + NE) v = F.in[15][((size_t)l * DM + k) * NE + (c - NGRP)];
        v *= F.in[12][(size_t)l * DM + k];
        WrT[i] = (bf16)(cvt_pk_bf16(v, 0.f) & 0xffffu); }
    { v4u* kb = WSP(v4u, WS_KB); v4u* vb = WSP(v4u, WS_VB);
        for (int i = gt; i < NB * 6144; i += NGT) { const int b = i / 6144, q = i % 6144; const size_t o = (size_t)b * KSEQ * 128 + q; kb[o] = (v4u){0u, 0u, 0u, 0u}; vb[o] = (v4u){0u, 0u, 0u, 0u}; } }
}

template <int MODE> __device__ __forceinline__ void norm_phase(Frame& F, const float* gain, bf16* dst, float* outf) {
    OPAQUE_IDS();
    bf16* RES = WSP(bf16, WS_RES); const bf16* Y0 = WSP(bf16, WS_Y0); const bf16* Y1 = WSP(bf16, WS_Y1);
    f32x4 g[8];
#pragma unroll
    for (int j = 0; j < 8; ++j) g[j] = ((const GAS f32x4*)gain)[lane_ + 64 * j];
    const int mend = (MODE == 3) ? MR : MT;
    for (int m = F.gw; m < mend; m += F.NGW) {
        f32x4 v[8]; float ss = 0.f;
        if (MODE == 0) { const float* src = (m < MR) ? F.in[0] + (size_t)m * DM : F.in[1] + (size_t)(m - MR) * DM; const GAS f32x4* sp = (const GAS f32x4*)src + lane_;
#pragma unroll
            for (int j = 0; j < 8; ++j) v[j] = sp[64 * j];
        } else { const GAS v2u* rp = (const GAS v2u*)(RES + (size_t)m * DM) + lane_;
#pragma unroll
            for (int j = 0; j < 8; ++j) { const v2u a = rp[64 * j]; v[j] = (f32x4){bf_lo(a.x), bf_hi(a.x), bf_lo(a.y), bf_hi(a.y)}; } }
        if (MODE == 1 || MODE == 3) {
            const GAS v2u* y0 = (const GAS v2u*)(Y0 + (size_t)m * DM) + lane_; const GAS v2u* y1 = (const GAS v2u*)(Y1 + (size_t)m * DM) + lane_;
#pragma unroll
            for (int j = 0; j < 8; ++j) { const v2u a = y0[64 * j], b = y1[64 * j];
                v[j].x += bf_lo(a.x) + bf_lo(b.x); v[j].y += bf_hi(a.x) + bf_hi(b.x); v[j].z += bf_lo(a.y) + bf_lo(b.y); v[j].w += bf_hi(a.y) + bf_hi(b.y); }
        }
#pragma unroll
        for (int j = 0; j < 8; ++j) ss += (v[j].x * v[j].x + v[j].y * v[j].y) + (v[j].z * v[j].z + v[j].w * v[j].w);
        const float rstd = 1.0f / sqrtf(wave_sum(ss) * (1.0f / DM) + RMS_EPS);
        if (MODE == 1) { GAS v2u* rp = (GAS v2u*)(RES + (size_t)m * DM) + lane_;
#pragma unroll
            for (int j = 0; j < 8; ++j) { v2u w; w.x = cvt_pk_bf16(v[j].x, v[j].y); w.y = cvt_pk_bf16(v[j].z, v[j].w); rp[64 * j] = w; } }
        if (MODE == 3) { GAS f32x4* op = (GAS f32x4*)(outf + (size_t)m * DM) + lane_;
#pragma unroll
            for (int j = 0; j < 8; ++j) op[64 * j] = v[j] * rstd * g[j];
        } else { GAS v2u* op = (GAS v2u*)(dst + (size_t)m * DM) + lane_;
#pragma unroll
            for (int j = 0; j < 8; ++j) { const f32x4 o = v[j] * rstd * g[j]; v2u w; w.x = cvt_pk_bf16(o.x, o.y); w.y = cvt_pk_bf16(o.z, o.w); op[64 * j] = w; }
            if (MODE == 0 || MODE == 1) { GAS unsigned* o8 = (GAS unsigned*)(F.ws + WS_XN8 + (size_t)m * DM) + lane_;
#pragma unroll
                for (int j = 0; j < 8; ++j) { const f32x4 o = v[j] * rstd * g[j]; o8[64 * j] = pk4_fp8(o.x, o.y, o.z, o.w); } } }
    }
}

__device__ __forceinline__ void pb_side(Frame& F, int l) {
    OPAQUE_IDS();
    const bf16* XN = WSP(bf16, WS_XN); const unsigned char* WinT = F.ws + WS_W + (size_t)l * W_LSTRIDE + WO_IN;
    const int g4 = (lane_ >> 4) * 4, y = lane_ & 15;
    LAS f32x4* part = (LAS f32x4*)(F.lds + RING_OFF);
    for (int rnd = F.vcu; rnd * 4 < MT / 16; rnd += F.G) {
        const int b0 = rnd * 4, nblk = (MT / 16 - b0) < 4 ? (MT / 16 - b0) : 4;
        f32x4 acc[4] = {{0.f, 0.f, 0.f, 0.f}, {0.f, 0.f, 0.f, 0.f}, {0.f, 0.f, 0.f, 0.f}, {0.f, 0.f, 0.f, 0.f}}, gdummy[4];
        skinny_slice<1, 4, 4, false>(WSP(bf16, WS_WF) + (size_t)l * 16 * DM, DM, 0, XN + (size_t)b0 * 16 * DM, DM, (nblk == 4) ? (size_t)16 * DM : 0, wave_ * 256, 8, acc, gdummy, lane_);
        put_part<4>(part, acc, 4, 0, wave_, lane_);
        LDS_WAIT(); __syncthreads();
        if (wave_ < nblk) {
            const f32x4 a = sum_part<4>(part, wave_, lane_); const int rb = b0 + wave_;
            float* LOGF = WSP(float, WS_LOGF);
#pragma unroll 1
            for (int r = 0; r < 4; ++r) { const int h = g4 + r; const float x = a[r] + F.in[4][l * NH + h];
                const float lf = (fminf(x, 0.f) - log1pf(expf(-fabsf(x)))) * LOG2E;
                if (rb < MR / 16) { const int m = rb * 16 + y, b = m >> 11, t = m & 2047; LOGF[(size_t)(b * NH + h) * KSEQ + 64 + t] = lf; }
                else { float* lp = LOGF + (size_t)h * KSEQ + 48 + y;
#pragma unroll 1
                    for (int bb = 0; bb < NB; ++bb) { *lp = lf; lp += (size_t)NH * KSEQ; } } }
        }
        __syncthreads();
    }
    const unsigned char* Ym = F.ws + WS_XN8 + (size_t)MR * DM;
    for (int rnd = F.vcu; rnd * 2 < 576; rnd += F.G) {
        const int j = rnd * 2 + (wave_ >> 2), tile = j >> 4, sub = j & 15, ks = (wave_ & 3) * 512;
        const bool glu = (tile >= 12 && tile < 20), live = !(glu && sub >= 8);
        f32x4 acc[2] = {{0.f, 0.f, 0.f, 0.f}, {0.f, 0.f, 0.f, 0.f}};
        if (live) { acc[0] = mm16_f8(WinT + (size_t)(tile * 256 + sub * 16) * DM + ks, DM, Ym + ks, DM, 512, acc[0], lane_);
            if (glu) acc[1] = mm16_f8(WinT + (size_t)(tile * 256 + 128 + sub * 16) * DM + ks, DM, Ym + ks, DM, 512, acc[1], lane_); }
        put_part<2>(part, acc, 2, 0, wave_, lane_);
        LDS_WAIT(); __syncthreads();
        if ((wave_ & 3) == 0 && live) {
            const int w0 = wave_;
            f32x4 a = part[(w0 * 2) * 64 + lane_], bq = part[(w0 * 2 + 1) * 64 + lane_];
#pragma unroll
            for (int w = 1; w < 4; ++w) { a += part[((w0 + w) * 2) * 64 + lane_]; bq += part[((w0 + w) * 2 + 1) * 64 + lane_]; }
            a = a * W8I; bq = bq * W8I;
            const int n = sub * 16 + g4;
            if (glu) { v2u w; w.x = cvt_pk_bf16(a[0] * sigmoidf_fast(bq[0]), a[1] * sigmoidf_fast(bq[1])); w.y = cvt_pk_bf16(a[2] * sigmoidf_fast(bq[2]), a[3] * sigmoidf_fast(bq[3]));
                bf16* zp = WSP(bf16, WS_ZG) + (size_t)y * CONVC + (tile - 12) * 128 + n;
#pragma unroll 1
                for (int bb = 0; bb < NB; ++bb) { *(v2u*)zp = w; zp += (size_t)ZSEQ * CONVC; }
            } else if (tile < 4) { a = a * C2; v2u w; w.x = cvt_pk_bf16(a[0], a[1]); w.y = cvt_pk_bf16(a[2], a[3]); *(v2u*)(WSP(bf16, WS_QO) + (size_t)(MR + y) * ATTW + tile * 256 + n) = w; }
            else if (tile < 12) { v2u w; w.x = cvt_pk_bf16(a[0], a[1]); w.y = cvt_pk_bf16(a[2], a[3]); bf16* kp = ((tile < 8) ? WSP(bf16, WS_KB) : WSP(bf16, WS_VB)) + (size_t)(48 + y) * ATTW + (tile & 3) * 256 + n;
#pragma unroll 1
                for (int bb = 0; bb < NB; ++bb) { *(v2u*)kp = w; kp += (size_t)KSEQ * ATTW; } }
            else { v2u w; w.x = cvt_pk_bf16(sigmoidf_fast(a[0]), sigmoidf_fast(a[1])); w.y = cvt_pk_bf16(sigmoidf_fast(a[2]), sigmoidf_fast(a[3]));
                bf16* SG = (tile < 28) ? WSP(bf16, WS_SGA) : WSP(bf16, WS_SGC); *(v2u*)(SG + (size_t)(MR + y) * DM + ((tile - 20) & 7) * 256 + n) = w; }
        }
        __syncthreads();
    }
}

struct GridSched {
    pg8::GridOrder go; const char* A; const char* B; size_t tstep; int pn0;
    __device__ __forceinline__ unsigned goff(int, int) const { return 0u; }
    __device__ __forceinline__ bool next(int i, pg8::Unit& u) const { u.aux = 0; u.idx = i; const bool ok = go.tile(i, u.pm, u.pn); u.pn += pn0; return ok; }
    __device__ __forceinline__ const char* opA(const pg8::Unit& u) const { return A + (size_t)u.pm * tstep; }
    __device__ __forceinline__ const char* opB(const pg8::Unit& u) const { return B + (size_t)u.pn * tstep; }
};
struct DualSched {
    pg8::GridOrder go; const char *A0, *B0, *A1, *B1; size_t tstep;
    __device__ __forceinline__ unsigned goff(int, int) const { return 0u; }
    __device__ __forceinline__ bool next(int i, pg8::Unit& u) const { u.aux = i & 1; u.idx = i; return go.tile(i >> 1, u.pm, u.pn); }
    __device__ __forceinline__ const char* opA(const pg8::Unit& u) const { return (u.aux ? A1 : A0) + (size_t)u.pm * tstep; }
    __device__ __forceinline__ const char* opB(const pg8::Unit& u) const { return (u.aux ? B1 : B0) + (size_t)u.pn * tstep; }
};
struct MoeSched {
    const LAS int* tb; int npn, G, c; const char* A; const char* W; size_t a_tstep, w_estride, w_tstep; const LAS unsigned* gtab;
    __device__ __forceinline__ unsigned goff(int ui, int row) const { return gtab[ui * 256 + row]; }
    __device__ __forceinline__ bool next(int i, pg8::Unit& u) const {
        const int L = i * G + c, T = L / npn; if (T >= tb[32]) return false;
        int e = 0;
#pragma unroll 1
        for (int q = 1; q < 32; ++q) e += (tb[q] <= T) ? 1 : 0;
        u.pm = T; u.pn = L - T * npn; u.aux = e; u.idx = i; return true; }
    __device__ __forceinline__ const char* opA(const pg8::Unit& u) const { return A + (size_t)u.pm * a_tstep; }
    __device__ __forceinline__ const char* opB(const pg8::Unit& u) const { return W + (size_t)u.aux * w_estride + (size_t)u.pn * w_tstep; }
};
typedef f32x4 Acc[2][2][4][2];
__device__ __forceinline__ v4u pack8(const f32x4 a, const f32x4 b) { v4u w; w.x = cvt_pk_bf16(a[0], a[1]); w.y = cvt_pk_bf16(a[2], a[3]); w.z = cvt_pk_bf16(b[0], b[1]); w.w = cvt_pk_bf16(b[2], b[3]); return w; }
__device__ __forceinline__ f32x4 sig4(const f32x4 a) { return (f32x4){sigmoidf_fast(a[0]), sigmoidf_fast(a[1]), sigmoidf_fast(a[2]), sigmoidf_fast(a[3])}; }
struct EpiIn {
    static constexpr bool PERM = true;
    bf16 *Q, *KB, *VB, *ZG, *SGA, *SGC; float wsc;
    __device__ __forceinline__ bool keep(const pg8::Unit&) const { return false; }
    __device__ __forceinline__ void operator()(Acc& acc, const pg8::Unit& u, int wr, int wc, int fr, int fq) const {
        const int pn = u.pn, m0 = u.pm * 256, b = m0 >> 11, rl = wr * 64 + fr, cw = wc * 32 + 8 * fq;
        if (pn < 12) {
            const int which = pn >> 2; bf16* base; size_t row0; float sc = wsc;
            if (which == 0) { base = Q; row0 = (size_t)m0; sc = C2 * wsc; } else { base = (which == 1) ? KB : VB; row0 = (size_t)m0 + 64 * (b + 1); }
            base += (pn & 3) * 256 + cw;
#pragma unroll
            for (int ai = 0; ai < 2; ++ai)
#pragma unroll
                for (int m = 0; m < 4; ++m) { bf16* rowp = base + (row0 + rl + ai * 128 + m * 16) * ATTW;
#pragma unroll
                    for (int bj = 0; bj < 2; ++bj) *(GAS v4u*)(rowp + bj * 128) = pack8(acc[ai][bj][m][0] * sc, acc[ai][bj][m][1] * sc); }
        } else if (pn < 20) {
            bf16* base = ZG + (pn - 12) * 128 + cw; const size_t row0 = (size_t)m0 + 16 * (b + 1);
#pragma unroll
            for (int ai = 0; ai < 2; ++ai)
#pragma unroll
                for (int m = 0; m < 4; ++m) { bf16* rowp = base + (row0 + rl + ai * 128 + m * 16) * CONVC;
                    *(GAS v4u*)rowp = pack8(acc[ai][0][m][0] * wsc * sig4(acc[ai][1][m][0] * wsc), acc[ai][0][m][1] * wsc * sig4(acc[ai][1][m][1] * wsc)); }
        } else {
            bf16* base = ((pn < 28) ? SGA : SGC) + ((pn - 20) & 7) * 256 + cw;
#pragma unroll
            for (int ai = 0; ai < 2; ++ai)
#pragma unroll
                for (int m = 0; m < 4; ++m) { bf16* rowp = base + (size_t)(m0 + rl + ai * 128 + m * 16) * DM;
#pragma unroll
                    for (int bj = 0; bj < 2; ++bj) *(GAS v4u*)(rowp + bj * 128) = pack8(sig4(acc[ai][bj][m][0] * wsc), sig4(acc[ai][bj][m][1] * wsc)); }
        }
    }
};
struct EpiDual {
    static constexpr bool PERM = true;
    const bf16 *SGA, *SGC; bf16* MG;
    __device__ __forceinline__ bool keep(const pg8::Unit& u) const { return u.aux == 0; }
    __device__ __forceinline__ void operator()(Acc& acc, const pg8::Unit& u, int wr, int wc, int fr, int fq) const {
        const size_t off0 = (size_t)(u.pm * 256 + wr * 64 + fr) * DM + u.pn * 256 + wc * 32 + 8 * fq;
        if (u.aux == 0) {
#pragma unroll
            for (int ai = 0; ai < 2; ++ai)
#pragma unroll
                for (int m = 0; m < 4; ++m)
#pragma unroll
                    for (int bj = 0; bj < 2; ++bj) { const size_t off = off0 + (size_t)(ai * 128 + m * 16) * DM + bj * 128;
                        const v4u c = *(const GAS v4u*)(SGC + off), a = *(const GAS v4u*)(SGA + off);
                        const f32x4 c0 = {bf_lo(c.x), bf_hi(c.x), bf_lo(c.y), bf_hi(c.y)}, c1 = {bf_lo(c.z), bf_hi(c.z), bf_lo(c.w), bf_hi(c.w)};
                        const f32x4 a0 = {bf_lo(a.x), bf_hi(a.x), bf_lo(a.y), bf_hi(a.y)}, a1 = {bf_lo(a.z), bf_hi(a.z), bf_lo(a.w), bf_hi(a.w)};
#pragma unroll
                        for (int q = 0; q < 4; ++q) { acc[ai][bj][m][0][q] *= a0[q] * __builtin_amdgcn_rcpf(c0[q]); acc[ai][bj][m][1][q] *= a1[q] * __builtin_amdgcn_rcpf(c1[q]); } }
        } else {
#pragma unroll
            for (int ai = 0; ai < 2; ++ai)
#pragma unroll
                for (int m = 0; m < 4; ++m)
#pragma unroll
                    for (int bj = 0; bj < 2; ++bj) { const size_t off = off0 + (size_t)(ai * 128 + m * 16) * DM + bj * 128;
                        const v4u c = *(const GAS v4u*)(SGC + off);
                        const f32x4 c0 = {bf_lo(c.x), bf_hi(c.x), bf_lo(c.y), bf_hi(c.y)}, c1 = {bf_lo(c.z), bf_hi(c.z), bf_lo(c.w), bf_hi(c.w)};
                        *(GAS v4u*)(MG + off) = pack8(acc[ai][bj][m][0] * c0, acc[ai][bj][m][1] * c1); }
        }
    }
};
struct EpiRes {
    static constexpr bool PERM = true;
    const float* basef; bf16* res;
    __device__ __forceinline__ bool keep(const pg8::Unit&) const { return false; }
    __device__ __forceinline__ void operator()(Acc& acc, const pg8::Unit& u, int wr, int wc, int fr, int fq) const {
        const size_t off0 = (size_t)(u.pm * 256 + wr * 64 + fr) * DM + u.pn * 256 + wc * 32 + 8 * fq;
#pragma unroll
        for (int ai = 0; ai < 2; ++ai)
#pragma unroll
            for (int m = 0; m < 4; ++m)
#pragma unroll
                for (int bj = 0; bj < 2; ++bj) { const size_t off = off0 + (size_t)(ai * 128 + m * 16) * DM + bj * 128; f32x4 b0, b1;
                    if (basef) { b0 = *(const GAS f32x4*)(basef + off); b1 = *(const GAS f32x4*)(basef + off + 4); }
                    else { const v4u c = *(const GAS v4u*)(res + off); b0 = (f32x4){bf_lo(c.x), bf_hi(c.x), bf_lo(c.y), bf_hi(c.y)}; b1 = (f32x4){bf_lo(c.z), bf_hi(c.z), bf_lo(c.w), bf_hi(c.w)}; }
                    *(GAS v4u*)(res + off) = pack8(b0 + acc[ai][bj][m][0], b1 + acc[ai][bj][m][1]); }
    }
};
struct EpiGlu {
    static constexpr bool PERM = true;
    bf16* H; const LAS float* rst;
    __device__ __forceinline__ bool keep(const pg8::Unit&) const { return false; }
    __device__ __forceinline__ void operator()(Acc& acc, const pg8::Unit& u, int wr, int wc, int fr, int fq) const {
        bf16* base = H + (size_t)(u.pm * 256 + wr * 64 + fr) * DE + u.pn * 128 + wc * 32 + 8 * fq;
#pragma unroll
        for (int ai = 0; ai < 2; ++ai)
#pragma unroll
            for (int m = 0; m < 4; ++m) { const float rs = rst[u.idx * 256 + wr * 64 + fr + ai * 128 + m * 16];
                const f32x4 g0 = acc[ai][0][m][0] * rs, g1 = acc[ai][0][m][1] * rs;
                *(GAS v4u*)(base + (size_t)(ai * 128 + m * 16) * DE) = pack8(g0 * sig4(g0) * (acc[ai][1][m][0] * rs), g1 * sig4(g1) * (acc[ai][1][m][1] * rs)); }
    }
};
struct EpiDown {
    static constexpr bool PERM = true;
    const LAS int* tb; const LAS int* cn; const int* perm; const float* wts; bf16 *Y0, *Y1;
    __device__ __forceinline__ bool keep(const pg8::Unit&) const { return false; }
    __device__ __forceinline__ void operator()(Acc& acc, const pg8::Unit& u, int wr, int wc, int fr, int fq) const {
        const int e = u.aux, r0 = (u.pm - tb[e]) * 256 + wr * 64 + fr, cnt = cn[e], col = u.pn * 256 + wc * 32 + 8 * fq;
#pragma unroll
        for (int ai = 0; ai < 2; ++ai)
#pragma unroll
            for (int m = 0; m < 4; ++m) { const int r = r0 + ai * 128 + m * 16;
                if (r < cnt) { const int id = perm[(size_t)e * PCAP + r]; const float w = wts[id]; bf16* rowp = ((id & 1) ? Y1 : Y0) + (size_t)(id >> 1) * DM + col;
#pragma unroll
                    for (int bj = 0; bj < 2; ++bj) *(GAS v4u*)(rowp + bj * 128) = pack8(acc[ai][bj][m][0] * w, acc[ai][bj][m][1] * w); } }
    }
};

__device__ __forceinline__ void cum_table(Frame& F, int bh) {
    int tid_ = F.tid; asm volatile("" : "+v"(tid_)); const int lane = tid_ & 63, wave = __builtin_amdgcn_readfirstlane(tid_ >> 6);
    LAS float* cs = (LAS float*)(F.lds + RING_OFF + attn_body::LDS_CS); LAS float* tot = (LAS float*)(F.lds + RING_OFF + attn_body::LDS_TOT);
    const GAS float* lf = (const GAS float*)WSP(float, WS_LOGF) + (size_t)bh * KSEQ;
    constexpr int NCH = KSEQ / 64;
    for (int c = wave; c < NCH; c += NWAVES) { const int row = 64 * c + lane; float v = (row >= 48) ? lf[row] : 0.f;
#pragma unroll
        for (int o = 1; o < 64; o <<= 1) { const float t = shfl_idx(v, lane - o); if (lane >= o) v += t; }
        cs[row] = v; if (lane == 63) tot[c] = v; }
    LDS_WAIT(); __syncthreads();
    float tv = (lane < NCH) ? tot[lane] : 0.f, inc = tv;
#pragma unroll
    for (int o = 1; o < 64; o <<= 1) { const float t = shfl_idx(inc, lane - o); if (lane >= o) inc += t; }
    const float exc = inc - tv;
    for (int c = wave; c < NCH; c += NWAVES) { const int row = 64 * c + lane; const float off = __int_as_float(__builtin_amdgcn_readlane(__float_as_int(exc), c));
        cs[row] = (row >= 48) ? cs[row] + off : INFINITY; }
    LDS_WAIT(); __syncthreads();
}
__device__ __forceinline__ void meta_attn_head(Frame& F, int h) {
    OPAQUE_IDS();
    const bf16* Qm = WSP(bf16, WS_QO) + (size_t)MR * ATTW + h * HD; const bf16* Km = WSP(bf16, WS_KB) + (size_t)48 * ATTW + h * HD; const bf16* Vm = WSP(bf16, WS_VB) + (size_t)48 * ATTW + h * HD;
    const float* lf = WSP(float, WS_LOGF) + (size_t)h * KSEQ + 48;
    const int i = lane_ & 15, qd = (lane_ >> 4) * 16;
    float q[16];
#pragma unroll
    for (int d = 0; d < 16; ++d) q[d] = bf_lo((unsigned)Qm[(size_t)i * ATTW + qd + d]);
    float cum[16]; { float c = 0.f;
#pragma unroll
        for (int j = 0; j < 16; ++j) { c += lf[j]; cum[j] = c; } }
    float ci = 0.f;
#pragma unroll
    for (int j = 0; j < 16; ++j) ci = (j == i) ? cum[j] : ci;
    float s[16], mx = -INFINITY;
#pragma unroll
    for (int j = 0; j < 16; ++j) { float p = 0.f;
#pragma unroll
        for (int d = 0; d < 16; ++d) p += q[d] * bf_lo((unsigned)Km[(size_t)j * ATTW + qd + d]);
        p += swz_xor<16>(p); p = xor32_sum(p);
        s[j] = (j <= i) ? p + ci - cum[j] : -INFINITY; mx = fmaxf(mx, s[j]); }
    float den = 0.f, o[16];
#pragma unroll
    for (int d = 0; d < 16; ++d) o[d] = 0.f;
#pragma unroll
    for (int j = 0; j < 16; ++j) { const float p = __builtin_amdgcn_exp2f(s[j] - mx); den += p;
#pragma unroll
        for (int d = 0; d < 16; ++d) o[d] += p * bf_lo((unsigned)Vm[(size_t)j * ATTW + qd + d]); }
    const float inv = 1.0f / den;
    bf16* Om = WSP(bf16, WS_O) + (size_t)(MR + i) * ATTW + h * HD + qd;
#pragma unroll
    for (int d = 0; d < 16; d += 2) *(unsigned*)(Om + d) = cvt_pk_bf16(o[d] * inv, o[d + 1] * inv);
}
__device__ __forceinline__ void conv_item(Frame& F, int l, int b, int p0, int out_row0) {
    int tid_ = F.tid; asm volatile("" : "+v"(tid_));
    const int c2 = tid_ * 2;
    const float* cw = F.in[6] + (size_t)l * CONVK * CONVC; const float cb0 = F.in[7][l * CONVC + c2], cb1 = F.in[7][l * CONVC + c2 + 1];
    LAS float* zb = (LAS float*)(F.lds + RING_OFF);
    f32x2 w[CONVK];
#pragma unroll
    for (int j = 0; j < CONVK; ++j) w[j] = *(const GAS f32x2*)(cw + (size_t)j * CONVC + c2);
    LAS unsigned char* win = F.lds + RING_OFF;
    { const GAS char* zsrc = (const GAS char*)WSP(bf16, WS_ZG) + ((size_t)b * ZSEQ + p0 - 30) * (CONVC * 2);
#pragma unroll
      for (int k = 0; k < 12; ++k) { const int q = tid_ + 512 * k; if (q < 46 * 128) { v4u v = {0u, 0u, 0u, 0u}; if (p0 - 30 + (q >> 7) >= 0) v = *(const GAS v4u*)(zsrc + (size_t)q * 16); *(LAS v4u*)(win + q * 16) = v; } } }
    LDS_WAIT(); __syncthreads();
    f32x2 a[16];
#pragma unroll
    for (int o = 0; o < 16; ++o) a[o] = (f32x2){cb0, cb1};
#pragma unroll
    for (int i = 0; i < 46; ++i) { const unsigned u = *(const LAS unsigned*)(win + i * (CONVC * 2) + tid_ * 4);
        const f32x2 x = {bf_lo(u), bf_hi(u)};
#pragma unroll
        for (int o = 0; o < 16; ++o) if (i - o >= 0 && i - o < CONVK) a[o] += w[i - o] * x; }
    LDS_WAIT(); __syncthreads();
#pragma unroll
    for (int o = 0; o < 16; ++o) *(LAS f32x2*)(zb + o * CONVC + c2) = a[o];
    LDS_WAIT(); __syncthreads();
    const int ln = tid_ & 63, wv_ = tid_ >> 6;
    const float* lg = F.in[8] + (size_t)l * CONVC; const float* lb = F.in[9] + (size_t)l * CONVC;
#pragma unroll
    for (int rr = 0; rr < 2; ++rr) { const int o = wv_ * 2 + rr;
        f32x4 v[4]; float s = 0.f;
#pragma unroll
        for (int j = 0; j < 4; ++j) { v[j] = *(const LAS f32x4*)(zb + o * CONVC + 4 * (ln + 64 * j)); s += (v[j].x + v[j].y) + (v[j].z + v[j].w); }
        const float mu = wave_sum(s) * (1.0f / CONVC); float q = 0.f;
#pragma unroll
        for (int j = 0; j < 4; ++j) { v[j] = v[j] - mu; q += (v[j].x * v[j].x + v[j].y * v[j].y) + (v[j].z * v[j].z + v[j].w * v[j].w); }
        const float rstd = 1.0f / sqrtf(wave_sum(q) * (1.0f / CONVC) + LN_EPS);
        bf16* op = WSP(bf16, WS_CV) + (size_t)(out_row0 + o) * CONVC;
#pragma unroll
        for (int j = 0; j < 4; ++j) { const int c = 4 * (ln + 64 * j); const f32x4 gg = *(const GAS f32x4*)(lg + c), bb = *(const GAS f32x4*)(lb + c);
            f32x4 z = v[j] * rstd * gg + bb; z = z * sig4(z); v2u wv; wv.x = cvt_pk_bf16(z.x, z.y); wv.y = cvt_pk_bf16(z.z, z.w); *(GAS v2u*)(op + c) = wv; } }
    __syncthreads();
}
__device__ __forceinline__ void pc_phase(Frame& F, int l, char* ldsg) {
    for (int rep3 = 0; rep3 < ((REP_PHASE == 3) ? 2 : 1); ++rep3)
    for (int v = F.vcu; v < 2 * NB * NH; v += F.G) {
        const int bh = v >> 1, s0 = 2 * (v & 1);
        cum_table(F, bh);
        const __hip_bfloat16* Q = (const __hip_bfloat16*)WSP(bf16, WS_QO); const __hip_bfloat16* K = (const __hip_bfloat16*)WSP(bf16, WS_KB); const __hip_bfloat16* V = (const __hip_bfloat16*)WSP(bf16, WS_VB);
#pragma unroll 1
        for (int i = 0; i < 4; ++i) { const int qb = (i == 0) ? s0 : (i == 1) ? 7 - s0 : (i == 2) ? s0 + 1 : 6 - s0;
#ifndef NO_ATTN
            attn_body::attn_unit<8>(bh / NH, bh % NH, qb, Q, K, V, (__hip_bfloat16*)WSP(bf16, WS_O), ldsg + RING_OFF);
#endif
        }
        __syncthreads();
    }
#ifndef NO_MATTN
    if (F.vcu >= F.G - 2) meta_attn_head(F, (F.vcu - (F.G - 2)) * 8 + F.wave);
#endif
    __syncthreads();
#ifndef NO_CONV
    for (int rep30 = 0; rep30 < ((REP_PHASE == 30) ? 2 : 1); ++rep30)
    for (int it = F.vcu; it < MR / 16 + 1; it += F.G) {
        const bool real = it < MR / 16; const int b = real ? it >> 7 : 0, t0 = (it & 127) * 16;
        conv_item(F, l, b, real ? NMETA + t0 : 0, real ? b * SEQ + t0 : MR);
    }
#endif
}
__device__ __forceinline__ void pd_side(Frame& F, int l) {
    OPAQUE_IDS();
    const int j = F.vcu; if (j >= DM / 16) return;
    const unsigned char* wl = F.ws + WS_W + (size_t)l * W_LSTRIDE; const int g4 = (lane_ >> 4) * 4, y = lane_ & 15;
    LAS f32x4* part = (LAS f32x4*)(F.lds + RING_OFF);
    f32x4 acc[2] = {{0.f, 0.f, 0.f, 0.f}, {0.f, 0.f, 0.f, 0.f}}, gd[1];
    { f32x4 (&a0)[1] = *(f32x4(*)[1])&acc[0]; f32x4 (&a1)[1] = *(f32x4(*)[1])&acc[1];
      skinny_slice<1, 1, 4, false>((const bf16*)(wl + WO_AO) + (size_t)j * 16 * ATTW, ATTW, 0, WSP(bf16, WS_O) + (size_t)MR * ATTW, ATTW, 0, wave_ * 128, 4, a0, gd, lane_);
      skinny_slice<1, 1, 4, false>((const bf16*)(wl + WO_CO) + (size_t)j * 16 * CONVC, CONVC, 0, WSP(bf16, WS_CV) + (size_t)MR * CONVC, CONVC, 0, wave_ * 128, 4, a1, gd, lane_); }
    put_part<2>(part, acc, 2, 0, wave_, lane_);
    LDS_WAIT(); __syncthreads();
    if (wave_ == 0) {
        const f32x4 a1 = sum_part<2>(part, 0, lane_), a2 = sum_part<2>(part, 1, lane_);
        const size_t off = (size_t)(MR + y) * DM + j * 16 + g4;
        const v2u ga = *(const GAS v2u*)(WSP(bf16, WS_SGA) + off), gc = *(const GAS v2u*)(WSP(bf16, WS_SGC) + off);
        v2u w; w.x = cvt_pk_bf16(bf_lo(ga.x) * a1[0] + bf_lo(gc.x) * a2[0], bf_hi(ga.x) * a1[1] + bf_hi(gc.x) * a2[1]);
        w.y = cvt_pk_bf16(bf_lo(ga.y) * a1[2] + bf_lo(gc.y) * a2[2], bf_hi(ga.y) * a1[3] + bf_hi(gc.y) * a2[3]);
        *(GAS v2u*)(WSP(bf16, WS_MG) + off) = w;
    }
    __syncthreads();
}
__device__ __forceinline__ void pe_side(Frame& F, int l) {
    OPAQUE_IDS();
    const int j = F.vcu; if (j >= DM / 16) return;
    const unsigned char* wl = F.ws + WS_W + (size_t)l * W_LSTRIDE; const int g4 = (lane_ >> 4) * 4, y = lane_ & 15;
    LAS f32x4* part = (LAS f32x4*)(F.lds + RING_OFF);
    f32x4 acc[1] = {{0.f, 0.f, 0.f, 0.f}}, gd[1];
    skinny_slice<1, 1, 8, false>((const bf16*)(wl + WO_O) + (size_t)j * 16 * DM, DM, 0, WSP(bf16, WS_MG) + (size_t)MR * DM, DM, 0, wave_ * 256, 8, acc, gd, lane_);
    put_part<1>(part, acc, 1, 0, wave_, lane_);
    LDS_WAIT(); __syncthreads();
    if (wave_ == 0) {
        const f32x4 a = sum_part<1>(part, 0, lane_);
        bf16* rp = WSP(bf16, WS_RES) + (size_t)(MR + y) * DM + j * 16 + g4; f32x4 bv;
        if (l == 0) bv = *(const GAS f32x4*)(F.in[1] + (size_t)y * DM + j * 16 + g4);
        else { const v2u c = *(const GAS v2u*)rp; bv = (f32x4){bf_lo(c.x), bf_hi(c.x), bf_lo(c.y), bf_hi(c.y)}; }
        bv = bv + a; v2u w; w.x = cvt_pk_bf16(bv[0], bv[1]); w.y = cvt_pk_bf16(bv[2], bv[3]); *(GAS v2u*)rp = w;
    }
    __syncthreads();
}
__device__ __forceinline__ void pg_router(Frame& F, int l) {
    OPAQUE_IDS();
    const int g4 = (lane_ >> 4) * 4, y = lane_ & 15;
    LAS f32x4* part = (LAS f32x4*)(F.lds + RING_OFF);
    const bf16* WrT = WSP(bf16, WS_WR) + (size_t)l * 48 * DM;
    for (int rnd = F.vcu; rnd * 4 < MT / 16; rnd += F.G) {
        const int b0 = rnd * 4, nblk = (MT / 16 - b0) < 4 ? (MT / 16 - b0) : 4;
        f32x4 acc[12], gram[4];
#pragma unroll
        for (int a = 0; a < 12; ++a) acc[a] = (f32x4){0.f, 0.f, 0.f, 0.f};
#pragma unroll
        for (int a = 0; a < 4; ++a) gram[a] = (f32x4){0.f, 0.f, 0.f, 0.f};
        skinny_slice<3, 4, 4, true>(WrT, DM, (size_t)16 * DM, WSP(bf16, WS_RES) + (size_t)b0 * 16 * DM, DM, (nblk == 4) ? (size_t)16 * DM : 0, wave_ * 256, 8, acc, gram, lane_);
        put_part<16>(part, acc, 12, 0, wave_, lane_); put_part<16>(part, gram, 4, 12, wave_, lane_);
        LDS_WAIT(); __syncthreads();
        f32x4 lgt[3], gr;
        if (wave_ < nblk) {
#pragma unroll
            for (int x = 0; x < 3; ++x) lgt[x] = sum_part<16>(part, x * 4 + wave_, lane_);
            gr = sum_part<16>(part, 12 + wave_, lane_); }
        __syncthreads();
        if (wave_ < nblk) {
            const int rb = b0 + wave_;
            LAS float* scr = (LAS float*)(F.lds + RING_OFF) + wave_ * (16 * 49);
#pragma unroll
            for (int blk = 0; blk < 3; ++blk)
#pragma unroll
                for (int r = 0; r < 4; ++r) scr[y * 49 + blk * 16 + g4 + r] = lgt[blk][r];
            if ((lane_ >> 4) == (y >> 2)) scr[y * 49 + 48] = (y & 3) == 0 ? gr[0] : (y & 3) == 1 ? gr[1] : (y & 3) == 2 ? gr[2] : gr[3];
            LDS_WAIT(); asm volatile("" ::: "memory");
            if (lane_ < 16) {
                const LAS float* lg = scr + lane_ * 49; const int m = rb * 16 + lane_;
                const float rstd = 1.0f / sqrtf(lg[48] * (1.0f / DM) + RMS_EPS); WSP(float, WS_RSTD)[m] = rstd;
                float gl[NGRP]; int gi = 0;
#pragma unroll
                for (int g = 0; g < NGRP; ++g) gl[g] = lg[g] * rstd + F.in[14][l * NGRP + g];
#pragma unroll
                for (int g = 1; g < NGRP; ++g) if (gl[g] > gl[gi]) gi = g;
                float gmax = gl[0];
#pragma unroll
                for (int g = 1; g < NGRP; ++g) gmax = fmaxf(gmax, gl[g]);
                float den = 0.f;
#pragma unroll
                for (int g = 0; g < NGRP; ++g) den += expf(gl[g] - gmax);
                const float gw = 1.0f / den;
                float ev[EPG];
#pragma unroll
                for (int i = 0; i < EPG; ++i) ev[i] = lg[NGRP + gi * EPG + i] * rstd + F.in[16][l * NE + gi * EPG + i];
                int i0 = 0;
#pragma unroll
                for (int i = 1; i < EPG; ++i) if (ev[i] > ev[i0]) i0 = i;
                float v0 = ev[0];
#pragma unroll
                for (int i = 1; i < EPG; ++i) v0 = fmaxf(v0, ev[i]);
                int i1 = (i0 == 0) ? 1 : 0; float v1 = -INFINITY;
#pragma unroll
                for (int i = 0; i < EPG; ++i) if (i != i0 && ev[i] > v1) { v1 = ev[i]; i1 = i; }
                const float w0 = gw / (1.0f + expf(v1 - v0)), w1 = gw - w0;
                unsigned* cnt = (unsigned*)(F.ctl + CW_CNT + l * 64); int* perm = WSP(int, WS_PERM); float* wts = WSP(float, WS_WTS);
                const int e0 = gi * EPG + i0, e1 = gi * EPG + i1;
                const unsigned q0 = __hip_atomic_fetch_add(cnt + e0, 1u, RLX_AGENT), q1 = __hip_atomic_fetch_add(cnt + e1, 1u, RLX_AGENT);
                perm[(size_t)e0 * PCAP + q0] = 2 * m; perm[(size_t)e1 * PCAP + q1] = 2 * m + 1; wts[2 * m] = w0; wts[2 * m + 1] = w1;
            }
        }
        __syncthreads();
    }
}
__device__ __forceinline__ void moe_tables(Frame& F, int l) {
    OPAQUE_IDS();
    LAS int* tb = (LAS int*)(F.lds + TAB_OFF); LAS int* cn = tb + 40;
    if (wave_ == 0) { const int c = (lane_ < NE) ? (int)__hip_atomic_load((unsigned*)(F.ctl + CW_CNT + l * 64 + lane_), RLX_AGENT) : 0; int nt = (c + 255) >> 8, inc = nt;
#pragma unroll
        for (int o = 1; o < 64; o <<= 1) { const int t = shfl_idx_i(inc, lane_ - o); if (lane_ >= o) inc += t; }
        if (lane_ < NE) { tb[lane_] = inc - nt; cn[lane_] = c; } if (lane_ == NE) tb[NE] = inc; }
    LDS_WAIT(); __syncthreads();
}
__device__ __forceinline__ void moe_gather_table(Frame& F, int npn, int l) {
    OPAQUE_IDS();
    LAS float* rst = (LAS float*)(F.lds + RSTAB_OFF); const float* rstd = WSP(float, WS_RSTD); (void)l;
    const LAS int* tb = (const LAS int*)(F.lds + TAB_OFF); const LAS int* cn = tb + 40; LAS unsigned* gt = (LAS unsigned*)(F.lds + GTAB_OFF);
    const int* perm = WSP(int, WS_PERM);
    for (int i = 0; i < GTAB_UNITS; ++i) { const int L = i * F.G + F.vcu, T = L / npn; if (T >= tb[NE]) break;
        int e = 0;
#pragma unroll 1
        for (int q = 1; q < NE; ++q) e += (tb[q] <= T) ? 1 : 0;
        if (tid_ < 256) { const int r = (T - tb[e]) * 256 + tid_; const int tok = (r < cn[e]) ? (perm[(size_t)e * PCAP + r] >> 1) : 0; gt[i * 256 + tid_] = (unsigned)tok * (unsigned)(DM * 2);
            rst[i * 256 + tid_] = rstd[tok]; } }
    LDS_WAIT(); __syncthreads();
}

struct Args { const float* in[20]; float* out; unsigned char* ws; int ph_lo, ph_hi; };
constexpr int N_PHASES = 22;
__global__ void __launch_bounds__(NWAVES * 64, 2) fox_fwd(Args args) {
    extern __shared__ __attribute__((aligned(16))) unsigned char lds[];
#ifdef USE_AGPR_HINT
    { float dummy_ = 0.f; asm volatile("" :: "a"(dummy_)); }
#endif
    Frame F;
    F.lds = (LAS unsigned char*)lds; F.MISC = (volatile LAS unsigned*)(F.lds + MISC_OFF);
    F.tid = threadIdx.x; F.lane = F.tid & 63; F.wave = __builtin_amdgcn_readfirstlane(F.tid >> 6);
    F.G = gridDim.x; { const int bx = blockIdx.x; F.vcu = (F.G % 8 == 0) ? (bx % 8) * (F.G / 8) + bx / 8 : bx; }
    F.gw = F.vcu * NWAVES + F.wave; F.NGW = F.G * NWAVES;
    F.ws = args.ws; F.in = args.in; F.ctl = (gu32*)(args.ws + WS_CTL);
    for (int u = F.tid; u < (LDS_BYTES - MISC_OFF) / 4; u += NWAVES * 64) ((LAS unsigned*)(F.lds + MISC_OFF))[u] = 0u;
    __syncthreads();
    const int lo = args.ph_lo, hi = args.ph_hi;
    const bool one_launch = (hi - lo) > 1;
    XcdBarrier bar; bar.bar = (unsigned*)(F.ctl + CW_BAR); bar.x = 0; bar.st = nullptr;
    if (one_launch) bar = xcd_barrier_post((unsigned*)(F.ctl + CW_BAR), F.MISC + 8);
#ifndef PH_MASK
#define PH_MASK 0xffffffffu
#endif
#define IN(k) (((PH_MASK >> ((k) > 10 ? (k) - 10 : (k))) & 1u) && lo <= (k) && (k) < hi)
#define SEAM(k) do { if (IN(k) && IN((k) + 1)) xcd_barrier(bar); } while (0)
#define REPS(j) (((REP_PHASE) == (j)) ? 2 : 1)
#define REPBAR(rep) do { if ((rep) == 0 && one_launch) xcd_barrier(bar); } while (0)
    LAS unsigned char* ring = F.lds + RING_OFF;
    const int bx = (int)blockIdx.x;

    if (IN(0)) for (int rep = 0; rep < REPS(0); ++rep) { p0_convert(F); norm_phase<0>(F, F.in[2], WSP(bf16, WS_XN), nullptr); if (REPS(0) > 1) REPBAR(rep); }
    SEAM(0);
#pragma unroll 1
    for (int l = 0; l < DEPTH; ++l) {
        const int P = 1 + 10 * l;
        const unsigned char* wl = F.ws + WS_W + (size_t)l * W_LSTRIDE;
        if (l > 0) { if (IN(P)) norm_phase<1>(F, F.in[2] + (size_t)l * DM, WSP(bf16, WS_XN), nullptr); SEAM(P); }
        if (IN(P + 1)) for (int rep = 0; rep < REPS(2); ++rep) {
            if (rep > 0) REPBAR(0);
#ifndef NO_PBSIDE
            pb_side(F, l); VM_WAIT(); __syncthreads();
#endif
#if QK_BF16
            { GridSched S; S.go.init(MR / 256, 8, F.G, bx); S.A = (const char*)WSP(bf16, WS_XN); S.B = (const char*)(wl + WO_IN16); S.tstep = (size_t)256 * DM * 2; S.pn0 = 0;
              EpiIn E{WSP(bf16, WS_QO), WSP(bf16, WS_KB), WSP(bf16, WS_VB), WSP(bf16, WS_ZG), WSP(bf16, WS_SGA), WSP(bf16, WS_SGC), 1.0f};
              pg8::gemm_phase<EpiIn, GridSched, true>(ring, DM * 2, S, E); }
            { GridSched S; S.go.init(MR / 256, 28, F.G, bx); S.A = (const char*)(F.ws + WS_XN8); S.B = (const char*)(wl + WO_IN); S.tstep = (size_t)256 * DM; S.pn0 = 8;
              EpiIn E{WSP(bf16, WS_QO), WSP(bf16, WS_KB), WSP(bf16, WS_VB), WSP(bf16, WS_ZG), WSP(bf16, WS_SGA), WSP(bf16, WS_SGC), W8I};
              pg8::gemm_phase<EpiIn, GridSched, true, true>(ring, DM, S, E); }
#else
            { GridSched S; S.go.init(MR / 256, 36, F.G, bx); S.A = (const char*)(F.ws + WS_XN8); S.B = (const char*)(wl + WO_IN); S.tstep = (size_t)256 * DM; S.pn0 = 0;
              EpiIn E{WSP(bf16, WS_QO), WSP(bf16, WS_KB), WSP(bf16, WS_VB), WSP(bf16, WS_ZG), WSP(bf16, WS_SGA), WSP(bf16, WS_SGC), W8I};
              pg8::gemm_phase<EpiIn, GridSched, true, true>(ring, DM, S, E); }
#endif
        }
        SEAM(P + 1);
        if (IN(P + 2)) pc_phase(F, l, (char*)lds);
        SEAM(P + 2);
        if (IN(P + 3)) for (int rep = 0; rep < REPS(4); ++rep) {
            if (rep > 0) REPBAR(0);
            pd_side(F, l); VM_WAIT(); __syncthreads();
            DualSched S; S.go.init(MR / 256, DM / 256, F.G, bx); S.A0 = (const char*)WSP(bf16, WS_O); S.B0 = (const char*)(wl + WO_AO); S.A1 = (const char*)WSP(bf16, WS_CV); S.B1 = (const char*)(wl + WO_CO); S.tstep = (size_t)256 * ATTW * 2;
            EpiDual E{WSP(bf16, WS_SGA), WSP(bf16, WS_SGC), WSP(bf16, WS_MG)};
            pg8::gemm_phase<EpiDual, DualSched, true>(ring, ATTW * 2, S, E);
        }
        SEAM(P + 3);
        if (IN(P + 4)) for (int rep = 0; rep < ((l == 0) ? REPS(5) : 1); ++rep) {
            if (rep > 0) REPBAR(0);
            pe_side(F, l); VM_WAIT(); __syncthreads();
            GridSched S; S.go.init(MR / 256, DM / 256, F.G, bx); S.A = (const char*)WSP(bf16, WS_MG); S.B = (const char*)(wl + WO_O); S.tstep = (size_t)256 * DM * 2; S.pn0 = 0;
            EpiRes E{(l == 0) ? F.in[0] : nullptr, WSP(bf16, WS_RES)};
            pg8::gemm_phase<EpiRes, GridSched, true>(ring, DM * 2, S, E);
        }
        SEAM(P + 4);
        if (IN(P + 6)) pg_router(F, l);
        SEAM(P + 6);
        if (IN(P + 8)) for (int rep = 0; rep < REPS(9); ++rep) {
            if (rep > 0) REPBAR(0);
            moe_tables(F, l); moe_gather_table(F, DE / 128, l);
            MoeSched S; S.tb = (const LAS int*)(F.lds + TAB_OFF); S.npn = DE / 128; S.G = F.G; S.c = F.vcu; S.A = (const char*)WSP(bf16, WS_RES); S.W = (const char*)(wl + WO_GU);
            S.a_tstep = 0; S.w_estride = (size_t)(2 * DE) * DM * 2; S.w_tstep = (size_t)256 * DM * 2; S.gtab = (const LAS unsigned*)(F.lds + GTAB_OFF);
            EpiGlu E{WSP(bf16, WS_H), (const LAS float*)(F.lds + RSTAB_OFF)};
            pg8::gemm_phase<EpiGlu, MoeSched, true, false, true>(ring, DM * 2, S, E);
        }
        SEAM(P + 8);
        if (IN(P + 9)) for (int rep = 0; rep < REPS(10); ++rep) {
            if (rep > 0) REPBAR(0);
            moe_tables(F, l);
            MoeSched S; S.tb = (const LAS int*)(F.lds + TAB_OFF); S.npn = DM / 256; S.G = F.G; S.c = F.vcu; S.A = (const char*)WSP(bf16, WS_H); S.W = (const char*)(wl + WO_DN);
            S.a_tstep = (size_t)256 * DE * 2; S.w_estride = (size_t)DM * DE * 2; S.w_tstep = (size_t)256 * DE * 2; S.gtab = nullptr;
            EpiDown E{(const LAS int*)(F.lds + TAB_OFF), (const LAS int*)(F.lds + TAB_OFF) + 40, WSP(int, WS_PERM), WSP(float, WS_WTS), WSP(bf16, WS_Y0), WSP(bf16, WS_Y1)};
            pg8::gemm_phase<EpiDown, MoeSched, true>(ring, DE * 2, S, E);
        }
        SEAM(P + 9);
    }
#if DBG_DUMP == 0
    if (IN(21)) for (int rep = 0; rep < REPS(21); ++rep) { if (rep > 0) REPBAR(0); norm_phase<3>(F, F.in[19], nullptr, args.out); }
#else
    if (IN(21)) {
        for (size_t i = (size_t)blockIdx.x * 512 + threadIdx.x; i < (size_t)MR * DM; i += (size_t)gridDim.x * 512) { const size_t m = i / DM, c = i % DM; float v = 0.f;
            if (DBG_DUMP == 1) v = bf_lo(WSP(bf16, WS_RES)[i]);
            else if (DBG_DUMP == 2) v = bf_lo(WSP(bf16, WS_Y0)[i]) + bf_lo(WSP(bf16, WS_Y1)[i]);
            else if (DBG_DUMP == 3) v = bf_lo(WSP(bf16, WS_MG)[i]);
            else if (DBG_DUMP == 4) v = (c < 1024) ? bf_lo(WSP(bf16, WS_O)[m * 1024 + c]) : bf_lo(WSP(bf16, WS_CV)[m * 1024 + c - 1024]);
            else if (DBG_DUMP == 5) v = bf_lo(WSP(bf16, WS_XN)[i]);
            else if (DBG_DUMP == 6) v = bf_lo(WSP(bf16, WS_SGA)[i]) + bf_lo(WSP(bf16, WS_SGC)[i]);
            else if (DBG_DUMP == 7) v = bf_lo(WSP(bf16, WS_N2)[i]);
            else if (DBG_DUMP == 8) { const size_t b = m >> 11, t = m & 2047; v = (c < 1024) ? bf_lo(WSP(bf16, WS_KB)[(b * KSEQ + 64 + t) * 1024 + c]) : bf_lo(WSP(bf16, WS_ZG)[(b * ZSEQ + 16 + t) * 1024 + c - 1024]); }
            args.out[i] = v; }
    }
#endif
#undef IN
#undef SEAM
}

extern "C" void kernel_launch(void* const* d_in, const int* in_sizes, int n_in, void* d_out, int out_size, void* d_ws, size_t ws_size, hipStream_t stream) {
    static int grid = 0;
    if (grid == 0) {
        if (n_in != 20 || out_size != MR * DM || ws_size < WS_END) { fprintf(stderr, "kernel_launch: unexpected problem (n_in %d, out %d, ws %zu); nothing launched\n", n_in, out_size, ws_size); grid = -1; return; }
        int dev = 0, cus = 0, per_cu = 0;
        if (hipGetDevice(&dev) != hipSuccess || hipDeviceGetAttribute(&cus, hipDeviceAttributeMultiprocessorCount, dev) != hipSuccess) { grid = -1; return; }
        if (hipFuncSetAttribute((const void*)fox_fwd, hipFuncAttributeMaxDynamicSharedMemorySize, LDS_BYTES) != hipSuccess) { fprintf(stderr, "kernel_launch: hipFuncSetAttribute failed\n"); grid = -1; return; }
        if (hipOccupancyMaxActiveBlocksPerMultiprocessor(&per_cu, (const void*)fox_fwd, NWAVES * 64, LDS_BYTES) != hipSuccess || per_cu < 1) { fprintf(stderr, "kernel_launch: occupancy query says %d\n", per_cu); }
        (void)hipGetLastError();
        grid = cus;
    }
    if (grid < 0) return;
    if (hipMemsetAsync((char*)d_ws + WS_CTL, 0, CTL_ZERO_BYTES, stream) != hipSuccess) return;
    Args a{};
    for (int i = 0; i < 20; ++i) a.in[i] = (const float*)d_in[i];
    a.out = (float*)d_out; a.ws = (unsigned char*)d_ws;
#if MK_N_LAUNCHES == 1
    a.ph_lo = 0; a.ph_hi = N_PHASES;
    hipLaunchKernelGGL(fox_fwd, dim3(grid), dim3(NWAVES * 64), LDS_BYTES, stream, a);
#else
    for (int p = 0; p < N_PHASES; ++p) { if (p == 1 || p == 6 || p == 16 || p == 8 || p == 18 || (p > DBG_STOP && p != N_PHASES - 1)) continue; a.ph_lo = p; a.ph_hi = p + 1; hipLaunchKernelGGL(fox_fwd, dim3(grid), dim3(NWAVES * 64), LDS_BYTES, stream, a); }
#endif
}
```
